# Optimizing an MI355X kernel written in HIP

```python
import math
import jax
import jax.numpy as jnp
from jax import lax
import numpy as np

D_MODEL = 1024
BATCH = 4
SEQ = 4096
DEPTH = 4

CTX_LEN = 256
GRID_W = 64
N_MIXERS = 3
N_S5 = (DEPTH + 2) // 3
N_GDN = (DEPTH + 1) // 3
N_NA = DEPTH // 3
EPS = 1e-6
F32 = jnp.float32

S5_WIDTH = D_MODEL
S5_GROUP = 16
S5_GROUPS = S5_WIDTH // S5_GROUP
S5_STATE = 64
S5_DT_MIN = 1e-3
S5_DT_MAX = 1e-1

GDN_HEAD_DIM = 128
GDN_HEADS = D_MODEL // GDN_HEAD_DIM
GDN_WIDTH = GDN_HEADS * GDN_HEAD_DIM
GDN_CONV = 5
GDN_CHUNK = 64

NA_HEAD_DIM = 64
NA_HEADS = D_MODEL // NA_HEAD_DIM
NA_WIDTH = NA_HEADS * NA_HEAD_DIM
NA_KH_MAX = 8
NA_KW = 16

kernel_name = 'hybrid_s5_gdn_natten_dit_block'


def rmsnorm(x, g):
    xf = x.astype(F32)
    y = xf * lax.rsqrt(jnp.mean(xf * xf, axis=-1, keepdims=True) + EPS)
    return (y * g.astype(F32)).astype(x.dtype)


def l2norm(t):
    return t * lax.rsqrt(jnp.sum(t * t, axis=-1, keepdims=True) + EPS)


def split_heads(t, n_heads):
    b, n, _ = t.shape
    return t.reshape(b, n, n_heads, -1).transpose(0, 2, 1, 3)


def merge_heads(t):
    b, h, n, d = t.shape
    return t.transpose(0, 2, 1, 3).reshape(b, n, h * d)


def adaln(cond, w, b):
    m = jax.nn.silu(cond) @ w + b
    return jnp.split(m, 3, axis=-1)


def s5_discretize(lam_re, lam_im, log_dt, b_re, b_im):
    lr = lam_re.astype(F32)
    li = lam_im.astype(F32)
    dt = jnp.exp(log_dt.astype(F32))[:, None]
    mag = jnp.exp(lr * dt)
    a_re = mag * jnp.cos(li * dt)
    a_im = mag * jnp.sin(li * dt)
    den = lr * lr + li * li
    f_re = ((a_re - 1.0) * lr + a_im * li) / den
    f_im = (a_im * lr - (a_re - 1.0) * li) / den
    br = b_re.astype(F32)
    bi = b_im.astype(F32)
    bb_re = f_re[..., None] * br - f_im[..., None] * bi
    bb_im = f_re[..., None] * bi + f_im[..., None] * br
    return a_re, a_im, bb_re, bb_im


def _complex_affine_combine(e1, e2):
    a1r, a1i, b1r, b1i = e1
    a2r, a2i, b2r, b2i = e2
    ar = a1r * a2r - a1i * a2i
    ai = a1r * a2i + a1i * a2r
    br = a2r * b1r - a2i * b1i + b2r
    bi = a2r * b1i + a2i * b1r + b2i
    return ar, ai, br, bi


def s5_scan(a_re, a_im, bu_re, bu_im, s0_re=None, s0_im=None, reverse=False):
    n = bu_re.shape[0]
    ar = jnp.broadcast_to(a_re[None, None], (n, 1) + a_re.shape)
    ai = jnp.broadcast_to(a_im[None, None], (n, 1) + a_im.shape)
    cum_re, cum_im, s_re, s_im = lax.associative_scan(
        _complex_affine_combine, (ar, ai, bu_re, bu_im), reverse=reverse, axis=0)
    if s0_re is not None:
        s_re, s_im = (s_re + cum_re * s0_re - cum_im * s0_im,
                      s_im + cum_re * s0_im + cum_im * s0_re)
    return s_re, s_im


def s5_group_time_major(u):
    b, n, _ = u.shape
    return u.astype(F32).transpose(1, 0, 2).reshape(n, b, S5_GROUPS, S5_GROUP)


def s5_drive(ug, bb_re, bb_im):
    return (jnp.einsum('tbgc,gpc->tbgp', ug, bb_re),
            jnp.einsum('tbgc,gpc->tbgp', ug, bb_im))


def s5_readout(s_re, s_im, cr, ci):
    return jnp.einsum('tbgp,gcp->tbgc', s_re, cr) - jnp.einsum('tbgp,gcp->tbgc', s_im, ci)


def s5_output(yg, z, glu_w, glu_b, out_w):
    n, b = yg.shape[:2]
    y = yg.reshape(n, b, S5_WIDTH).transpose(1, 0, 2)
    gl = jax.nn.gelu(y)
    ga, gb = jnp.split(gl @ glu_w.astype(F32) + glu_b.astype(F32), 2, axis=-1)
    y = ga * jax.nn.sigmoid(gb) * jax.nn.silu(z.astype(F32))
    return y.astype(z.dtype) @ out_w


def s5_mixer(a_lat, a_ctx, in_w, lam_re, lam_im, log_dt, b_re, b_im, c_re, c_im,
             d_skip, glu_w, glu_b, out_w, need_ctx_out):
    u_l, z_l = jnp.split(a_lat @ in_w, 2, axis=-1)
    u_c, z_c = jnp.split(a_ctx @ in_w, 2, axis=-1)
    ug_l = s5_group_time_major(u_l)
    ug_c = s5_group_time_major(u_c)
    d_g = d_skip.astype(F32).reshape(S5_GROUPS, S5_GROUP)
    y_l = ug_l * d_g
    y_c = ug_c * d_g
    for dr in range(2):
        rev = dr == 1
        a_re, a_im, bb_re, bb_im = s5_discretize(lam_re[dr], lam_im[dr], log_dt[dr], b_re[dr], b_im[dr])
        cr = c_re[dr].astype(F32)
        ci = c_im[dr].astype(F32)
        bc_re, bc_im = s5_drive(ug_c, bb_re, bb_im)
        sc_re, sc_im = s5_scan(a_re, a_im, bc_re, bc_im, reverse=rev)
        last = 0 if rev else -1
        bl_re, bl_im = s5_drive(ug_l, bb_re, bb_im)
        sl_re, sl_im = s5_scan(a_re, a_im, bl_re, bl_im, sc_re[last], sc_im[last], reverse=rev)
        y_l = y_l + s5_readout(sl_re, sl_im, cr, ci)
        if need_ctx_out:
            y_c = y_c + s5_readout(sc_re, sc_im, cr, ci)
    out_l = s5_output(y_l, z_l, glu_w, glu_b, out_w)
    out_c = s5_output(y_c, z_c, glu_w, glu_b, out_w) if need_ctx_out else None
    return out_l, out_c


def short_conv_silu(t, w):
    ch = t.shape[-1]
    k = w.shape[0]
    y = lax.conv_general_dilated(t, w[:, None, :].astype(t.dtype), window_strides=(1,),
                                 padding=[(k // 2, k // 2)],
                                 dimension_numbers=('NWC', 'WIO', 'NWC'),
                                 feature_group_count=ch)
    return jax.nn.silu(y)


def gated_delta_chunked(q, k, v, g, beta, s0):
    bsz, nh, n, dk = q.shape
    dv = v.shape[-1]
    cs = GDN_CHUNK
    nc = n // cs

    def chunks(t):
        return t.reshape((bsz, nh, nc, cs) + t.shape[3:])

    q = chunks(q * dk ** -0.5)
    k = chunks(k)
    v = chunks(v)
    g = jnp.cumsum(chunks(g), axis=-1)
    beta = chunks(beta)
    causal = jnp.tril(jnp.ones((cs, cs), dtype=bool))
    strict = jnp.tril(jnp.ones((cs, cs), dtype=bool), -1)
    decay = jnp.exp(jnp.where(causal, g[..., :, None] - g[..., None, :], -jnp.inf))
    kb = k * beta[..., None]
    lower = jnp.where(strict, jnp.einsum('bhncd,bhnsd->bhncs', kb, k) * decay, 0.0)
    eye = jnp.eye(cs, dtype=F32)
    rhs = jnp.concatenate([v * beta[..., None], kb * jnp.exp(g)[..., None]], axis=-1)
    uw = lax.linalg.triangular_solve(lower + eye, rhs, left_side=True, lower=True,
                                     unit_diagonal=True)
    u = uw[..., :dv]
    w = uw[..., dv:]
    a_qk = jnp.einsum('bhncd,bhnsd->bhncs', q, k) * decay

    def step(state, blk):
        q_i, k_i, u_i, w_i, g_i, a_i = blk
        v_new = u_i - jnp.einsum('bhcd,bhde->bhce', w_i, state)
        o_i = (jnp.einsum('bhcd,bhde->bhce', q_i * jnp.exp(g_i)[..., None], state)
               + jnp.einsum('bhcs,bhse->bhce', a_i, v_new))
        g_last = g_i[..., -1]
        k_dec = k_i * jnp.exp(g_last[..., None] - g_i)[..., None]
        state = state * jnp.exp(g_last)[..., None, None] + jnp.einsum('bhcd,bhce->bhde', k_dec, v_new)
        return state, o_i

    blocks = tuple(jnp.moveaxis(t, 2, 0) for t in (q, k, u, w, g, a_qk))
    state, o = lax.scan(step, s0, blocks)
    o = jnp.moveaxis(o, 0, 2).reshape(bsz, nh, n, dv)
    return state, o


def gdn_project(h, in_w, conv_w, a_log, dt_bias):
    b, n, _ = h.shape
    wd, nh = GDN_WIDTH, GDN_HEADS
    p = h @ in_w
    qkv = short_conv_silu(p[..., :3 * wd], conv_w)
    q, k, v = [split_heads(t, nh).astype(F32) for t in jnp.split(qkv, 3, axis=-1)]
    z = p[..., 3 * wd:4 * wd]
    ab = p[..., 4 * wd:].astype(F32)
    a_raw = ab[..., :2 * nh].reshape(b, n, 2, nh).transpose(2, 0, 3, 1)
    b_raw = ab[..., 2 * nh:].reshape(b, n, 2, nh).transpose(2, 0, 3, 1)
    g = -jnp.exp(a_log.astype(F32))[:, None, :, None] * jax.nn.softplus(
        a_raw + dt_bias.astype(F32)[:, None, :, None])
    beta = jax.nn.sigmoid(b_raw)
    return l2norm(q), l2norm(k), v, z, g, beta


def tflip(t, rev):
    return jnp.flip(t, axis=2) if rev else t


def gdn_output(o, z, norm_g, out_w):
    y = rmsnorm(o.transpose(0, 2, 1, 3), norm_g)
    b, n = z.shape[:2]
    y = y.reshape(b, n, GDN_WIDTH) * jax.nn.silu(z.astype(F32))
    return y.astype(z.dtype) @ out_w


def gdn_mixer(a_lat, a_ctx, in_w, conv_w, a_log, dt_bias, norm_g, out_w, need_ctx_out):
    ql, kl, vl, zl, gl, bl = gdn_project(a_lat, in_w, conv_w, a_log, dt_bias)
    qc, kc, vc, zc, gc, bc = gdn_project(a_ctx, in_w, conv_w, a_log, dt_bias)
    bsz = a_lat.shape[0]
    s0 = jnp.zeros((bsz, GDN_HEADS, GDN_HEAD_DIM, GDN_HEAD_DIM), F32)
    o_l = jnp.zeros_like(vl)
    o_c = jnp.zeros_like(vc)
    for dr in range(2):
        rev = dr == 1
        s_c, oc = gated_delta_chunked(tflip(qc, rev), tflip(kc, rev), tflip(vc, rev),
                                      tflip(gc[dr], rev), tflip(bc[dr], rev), s0)
        _, ol = gated_delta_chunked(tflip(ql, rev), tflip(kl, rev), tflip(vl, rev),
                                    tflip(gl[dr], rev), tflip(bl[dr], rev), s_c)
        o_l = o_l + tflip(ol, rev)
        if need_ctx_out:
            o_c = o_c + tflip(oc, rev)
    out_l = gdn_output(o_l, zl, norm_g, out_w)
    out_c = gdn_output(o_c, zc, norm_g, out_w) if need_ctx_out else None
    return out_l, out_c


def na_mixer(a_lat, a_ctx, in_w, rpb, out_w, need_ctx_out):
    bsz, n, _ = a_lat.shape
    rows = n // GRID_W
    kh = min(NA_KH_MAX, rows)
    scale = NA_HEAD_DIM ** -0.5
    q, k, v, z = jnp.split(a_lat @ in_w, 4, axis=-1)
    qc, kc, vc, zc = jnp.split(a_ctx @ in_w, 4, axis=-1)
    q, k, v = [split_heads(t, NA_HEADS) for t in (q, k, v)]
    qc, kc, vc = [split_heads(t, NA_HEADS) for t in (qc, kc, vc)]
    grid_shape = (bsz, NA_HEADS, rows, GRID_W, NA_HEAD_DIM)
    q_g, k_g, v_g = q.reshape(grid_shape), k.reshape(grid_shape), v.reshape(grid_shape)
    cols = np.arange(GRID_W)
    col_start = np.clip(cols - NA_KW // 2, 0, GRID_W - NA_KW)
    col_idx = col_start[:, None] + np.arange(NA_KW)[None, :]
    col_off = col_idx - cols[:, None] + (NA_KW - 1)
    rpb_cols = rpb.astype(F32)[:, :, col_off]
    n_win = kh * NA_KW

    def row_block(r):
        r0 = jnp.clip(r - kh // 2, 0, rows - kh)
        k_win = lax.dynamic_slice_in_dim(k_g, r0, kh, axis=2)[:, :, :, col_idx]
        v_win = lax.dynamic_slice_in_dim(v_g, r0, kh, axis=2)[:, :, :, col_idx]
        q_r = lax.dynamic_index_in_dim(q_g, r, axis=2, keepdims=False)
        row_off = r0 + jnp.arange(kh) - r + (NA_KH_MAX - 1)
        bias = rpb_cols[:, row_off].transpose(0, 2, 1, 3)
        s_win = jnp.einsum('bhwd,bhrwjd->bhwrj', q_r, k_win).astype(F32) * scale + bias[None]
        s_ctx = jnp.einsum('bhwd,bhnd->bhwn', q_r, kc).astype(F32) * scale
        s = jnp.concatenate([s_win.reshape(bsz, NA_HEADS, GRID_W, n_win), s_ctx], axis=-1)
        p = jax.nn.softmax(s, axis=-1).astype(v.dtype)
        p_win = p[..., :n_win].reshape(bsz, NA_HEADS, GRID_W, kh, NA_KW)
        return (jnp.einsum('bhwrj,bhrwjd->bhwd', p_win, v_win)
                + jnp.einsum('bhwn,bhnd->bhwd', p[..., n_win:], vc))

    o = lax.map(row_block, jnp.arange(rows))
    o = o.transpose(1, 0, 3, 2, 4).reshape(bsz, n, NA_WIDTH)
    out_l = (o * jax.nn.silu(z)) @ out_w
    out_c = None
    if need_ctx_out:
        s = jnp.einsum('bhqd,bhkd->bhqk', qc, kc).astype(F32) * scale
        oc = merge_heads(jnp.einsum('bhqk,bhkd->bhqd', jax.nn.softmax(s, axis=-1).astype(vc.dtype), vc))
        out_c = (oc * jax.nn.silu(zc)) @ out_w
    return out_l, out_c


def setup_inputs(seed: int = 0) -> dict:
    key = jax.random.key(seed)
    keys = iter(jax.random.split(key, 32))

    def nrm(shape, std):
        return jax.random.normal(next(keys), shape, F32) * std

    def unif(shape, lo, hi):
        return jax.random.uniform(next(keys), shape, F32, lo, hi)

    D = D_MODEL
    G, P, Cg, E = S5_GROUPS, S5_STATE, S5_GROUP, S5_WIDTH
    Wg, Hg = GDN_WIDTH, GDN_HEADS
    x = nrm((BATCH, SEQ, D), 1.0)
    c = nrm((BATCH, D), 1.0)
    ctx = nrm((BATCH, CTX_LEN, D), 1.0)
    c_ctx = nrm((D,), 1.0)
    ada_w = nrm((DEPTH, D, 3 * D), 0.5 * D ** -0.5)
    ada_b = nrm((DEPTH, 3 * D), 0.01)
    pre_g = 1.0 + nrm((DEPTH, D), 0.02)
    post_g = 1.0 + nrm((DEPTH, D), 0.02)
    s5_in_w = nrm((N_S5, D, 2 * E), D ** -0.5)
    s5_lam_re = -0.5 + nrm((N_S5, 2, G, P), 0.01)
    s5_lam_im = math.pi * jnp.arange(P, dtype=F32) + nrm((N_S5, 2, G, P), 0.01)
    s5_log_dt = unif((N_S5, 2, G), math.log(S5_DT_MIN), math.log(S5_DT_MAX))
    s5_b_re = nrm((N_S5, 2, G, P, Cg), (2 * Cg) ** -0.5)
    s5_b_im = nrm((N_S5, 2, G, P, Cg), (2 * Cg) ** -0.5)
    s5_c_re = nrm((N_S5, 2, G, Cg, P), P ** -0.5)
    s5_c_im = nrm((N_S5, 2, G, Cg, P), P ** -0.5)
    s5_d = nrm((N_S5, E), 1.0)
    s5_glu_w = nrm((N_S5, E, 2 * E), E ** -0.5)
    s5_glu_b = nrm((N_S5, 2 * E), 0.01)
    s5_out_w = nrm((N_S5, E, D), E ** -0.5)
    gdn_in_w = nrm((N_GDN, D, 4 * Wg + 4 * Hg), D ** -0.5)
    gdn_conv_w = nrm((N_GDN, GDN_CONV, 3 * Wg), GDN_CONV ** -0.5)
    gdn_a_log = jnp.log(unif((N_GDN, 2, Hg), 1.0, 16.0))
    dt = jnp.exp(unif((N_GDN, 2, Hg), math.log(1e-3), math.log(1e-1)))
    gdn_dt_bias = dt + jnp.log(-jnp.expm1(-dt))
    gdn_norm_g = 1.0 + nrm((N_GDN, GDN_HEAD_DIM), 0.02)
    gdn_out_w = nrm((N_GDN, Wg, D), Wg ** -0.5)
    na_in_w = nrm((N_NA, D, 4 * NA_WIDTH), D ** -0.5)
    na_rpb = nrm((N_NA, NA_HEADS, 2 * NA_KH_MAX - 1, 2 * NA_KW - 1), 0.1)
    na_out_w = nrm((N_NA, NA_WIDTH, D), NA_WIDTH ** -0.5)
    return {'x': x, 'c': c, 'ctx': ctx, 'c_ctx': c_ctx,
            'ada_w': ada_w, 'ada_b': ada_b, 'pre_g': pre_g, 'post_g': post_g,
            's5_in_w': s5_in_w, 's5_lam_re': s5_lam_re, 's5_lam_im': s5_lam_im,
            's5_log_dt': s5_log_dt, 's5_b_re': s5_b_re, 's5_b_im': s5_b_im,
            's5_c_re': s5_c_re, 's5_c_im': s5_c_im, 's5_d': s5_d,
            's5_glu_w': s5_glu_w, 's5_glu_b': s5_glu_b, 's5_out_w': s5_out_w,
            'gdn_in_w': gdn_in_w, 'gdn_conv_w': gdn_conv_w, 'gdn_a_log': gdn_a_log,
            'gdn_dt_bias': gdn_dt_bias, 'gdn_norm_g': gdn_norm_g, 'gdn_out_w': gdn_out_w,
            'na_in_w': na_in_w, 'na_rpb': na_rpb, 'na_out_w': na_out_w}


def reference(x, c, ctx, c_ctx, ada_w, ada_b, pre_g, post_g,
              s5_in_w, s5_lam_re, s5_lam_im, s5_log_dt, s5_b_re, s5_b_im,
              s5_c_re, s5_c_im, s5_d, s5_glu_w, s5_glu_b, s5_out_w,
              gdn_in_w, gdn_conv_w, gdn_a_log, gdn_dt_bias, gdn_norm_g, gdn_out_w,
              na_in_w, na_rpb, na_out_w):
    h_lat, h_ctx = x, ctx
    for i in range(DEPTH):
        kind, j = i % N_MIXERS, i // N_MIXERS
        need_ctx_out = i < DEPTH - 1
        sh_l, sc_l, gt_l = adaln(c, ada_w[i], ada_b[i])
        sh_c, sc_c, gt_c = adaln(c_ctx, ada_w[i], ada_b[i])
        a_lat = rmsnorm(h_lat, pre_g[i]) * (1.0 + sc_l[:, None]) + sh_l[:, None]
        a_ctx = rmsnorm(h_ctx, pre_g[i]) * (1.0 + sc_c) + sh_c
        if kind == 0:
            o_lat, o_ctx = s5_mixer(a_lat, a_ctx, s5_in_w[j], s5_lam_re[j], s5_lam_im[j],
                                    s5_log_dt[j], s5_b_re[j], s5_b_im[j], s5_c_re[j], s5_c_im[j],
                                    s5_d[j], s5_glu_w[j], s5_glu_b[j], s5_out_w[j], need_ctx_out)
        elif kind == 1:
            o_lat, o_ctx = gdn_mixer(a_lat, a_ctx, gdn_in_w[j], gdn_conv_w[j], gdn_a_log[j],
                                     gdn_dt_bias[j], gdn_norm_g[j], gdn_out_w[j], need_ctx_out)
        else:
            o_lat, o_ctx = na_mixer(a_lat, a_ctx, na_in_w[j], na_rpb[j], na_out_w[j], need_ctx_out)
        h_lat = h_lat + gt_l[:, None] * rmsnorm(o_lat, post_g[i])
        if need_ctx_out:
            h_ctx = h_ctx + gt_c * rmsnorm(o_ctx, post_g[i])
    return h_lat
```

```cpp
#include <hip/hip_runtime.h>
#include <hip/hip_cooperative_groups.h>
#include <cstdio>
namespace cg = cooperative_groups;

typedef unsigned short bf16_t;
typedef __attribute__((ext_vector_type(8))) short bf16x8;
typedef __attribute__((ext_vector_type(4))) short bf16x4;
typedef __attribute__((ext_vector_type(16))) float f32x16;
typedef __attribute__((ext_vector_type(4))) float f32x4;
#define DI __device__ __forceinline__
typedef __attribute__((address_space(3))) unsigned lds_u32;

constexpr int D = 1024;
constexpr int NB = 4;
constexpr int SEQ = 4096;
constexpr int CTX = 256;
constexpr int TPB = SEQ + CTX;
constexpr int NT = NB * TPB;
constexpr int NTHREADS = 256;
constexpr int GDN_R = 8;
constexpr int GDN_NCH = 68;
constexpr int GDN_ROUNDS = (GDN_NCH + GDN_R - 1) / GDN_R;

constexpr size_t MiB = 1024 * 1024;
constexpr size_t UNIT = (size_t)NT * 1024 * 2;
constexpr size_t WS_MOD = 0;
constexpr size_t WS_BAR = 245760;
constexpr size_t WS_HCTX = 262144;
constexpr size_t WS_AB = WS_HCTX + 4 * MiB;
constexpr size_t WS_SST = WS_AB + (size_t)NT * 32 * 4;
constexpr size_t WS_WT = WS_SST + 4 * MiB;
constexpr size_t WT_S5_IN = 0;
constexpr size_t WT_S5_GLU = WT_S5_IN + 4 * MiB;
constexpr size_t WT_S5_OUT = WT_S5_GLU + 4 * MiB;
constexpr size_t WT_S5_APOW = WT_S5_OUT + 2 * MiB;
constexpr size_t WT_S5_BBAR = WT_S5_APOW + 2 * 64 * 17 * 64 * 8;
constexpr size_t WT_S5_KTAB = WT_S5_BBAR + 2 * 64 * 64 * 16 * 8;
constexpr size_t WT_S5_OPT = WT_S5_KTAB + 2 * 64 * 16 * 256 * 4;
constexpr size_t WT_S5_BPT = WT_S5_OPT + (size_t)64 * 256 * 512 * 2;
constexpr size_t WT_S5_END = WT_S5_BPT + (size_t)64 * 256 * 256 * 2;
constexpr size_t WT_G_IN = 0;
constexpr size_t WT_G_OUT = WT_G_IN + (size_t)4352 * 1024 * 2;
constexpr size_t WT_G_HALO = WT_G_OUT + 2 * MiB;
constexpr size_t WT_G_W = WT_G_HALO + (size_t)272 * 4 * 3072 * 2;
constexpr size_t WT_G_AQK = WT_G_W + (size_t)2 * 64 * GDN_R * 64 * 128 * 2;
constexpr size_t WT_G_GC = WT_G_AQK + (size_t)64 * GDN_R * 64 * 64 * 2;
constexpr size_t WT_G_END = WT_G_GC + (size_t)2 * 64 * GDN_R * 64 * 4;
static_assert((size_t)64 * GDN_R * 64 * 64 * 2 <= (size_t)272 * 4 * 3072 * 2, "Aqk set 1 must fit the halo region");
constexpr size_t WT_N_IN = 0;
constexpr size_t WT_N_OUT = 8 * MiB;
constexpr size_t WT_SIZE = (WT_S5_END > WT_G_END ? WT_S5_END : WT_G_END);
constexpr size_t WS_BIG = (WS_WT + WT_SIZE + 255) / 256 * 256;
constexpr size_t WS_END = WS_BIG + 6 * UNIT;
static_assert(WS_END <= 256 * MiB, "workspace too large");

struct Params {
  const float *x, *c, *ctx, *c_ctx, *ada_w, *ada_b, *pre_g, *post_g;
  const float *s5_in_w, *s5_lam_re, *s5_lam_im, *s5_log_dt, *s5_b_re, *s5_b_im, *s5_c_re, *s5_c_im, *s5_d, *s5_glu_w, *s5_glu_b, *s5_out_w;
  const float *gdn_in_w, *gdn_conv_w, *gdn_a_log, *gdn_dt_bias, *gdn_norm_g, *gdn_out_w;
  const float *na_in_w, *na_rpb, *na_out_w;
  float* out;
  unsigned char* ws;
  int ph_lo, ph_hi;
};

DI bf16_t f2bf(float x) { return __builtin_bit_cast(unsigned short, (__bf16)x); }
DI float bf2f(bf16_t b) { return __uint_as_float(((unsigned)b) << 16); }
DI float wsum(float v) {
#pragma unroll
  for (int o = 32; o > 0; o >>= 1) v += __shfl_xor(v, o);
  return v;
}
DI float sigmoidf_(float x) { return __builtin_amdgcn_rcpf(1.f + __expf(-x)); }
DI float siluf_(float x) { return x * __builtin_amdgcn_rcpf(1.f + __expf(-x)); }
DI float geluf_(float x) { float u = 1.5957691216057308f * (x + 0.044715f * x * x * x); return x * __builtin_amdgcn_rcpf(1.f + __expf(-u)); }
DI int crow(int i, int h) { return (i & 3) + 8 * (i >> 2) + 4 * h; }
DI void lds_barrier() { asm volatile("s_waitcnt lgkmcnt(0)" ::: "memory"); __builtin_amdgcn_s_barrier(); asm volatile("" ::: "memory"); }
DI int opaque(int v) { asm volatile("" : "+v"(v)); return v; }
DI int imin(int a, int b) { return a < b ? a : b; }
DI int imax(int a, int b) { return a > b ? a : b; }


#define XB_TMO      128
#define XB_XCNT(j)  (256  + 64 * (j))
#define XB_XSUB(j)  (1280 + 64 * (j))
#define XB_XGEN(j)  (2304 + 64 * (j))
#define XB_TOP      3328
#define XB_TOPGEN   3392
#define XCD_BAR_WORDS 3456
#define XB_SPIN_CAP (1u << 18)
#define LAS __attribute__((address_space(3)))
DI unsigned xb_ld(unsigned* p)              { return __hip_atomic_load(p, __ATOMIC_RELAXED, __HIP_MEMORY_SCOPE_AGENT); }
DI unsigned xb_add(unsigned* p, unsigned v) { return __hip_atomic_fetch_add(p, v, __ATOMIC_RELAXED, __HIP_MEMORY_SCOPE_AGENT); }
DI unsigned xb_xcc_id() { return (unsigned)__builtin_amdgcn_s_getreg((3 << 11) | 20) & 0xFu; }
#define XB_SPIN(cond, bar) do { unsigned _sp = 0; while (cond) { __builtin_amdgcn_s_sleep(1); \
    if ((++_sp & 255u) == 0u) { if (xb_ld(&(bar)[XB_TMO])) break; if (_sp > XB_SPIN_CAP) { atomicAdd(&(bar)[XB_TMO], 1u); break; } } } } while (0)
struct XcdBarrier { unsigned* bar; unsigned x; volatile LAS unsigned* st; };
DI XcdBarrier xcd_barrier_post(unsigned* bar, volatile LAS unsigned* st) {
  XcdBarrier b; b.bar = bar; b.x = xb_xcc_id(); b.st = st;
  if (threadIdx.x == 0) (void)xb_add(&bar[XB_XCNT(b.x)], 1u);
  return b;
}
DI void xcd_barrier_complete(unsigned* bar, unsigned x, unsigned& nloc, unsigned& nx) {
  const unsigned G = gridDim.x * gridDim.y * gridDim.z;
  unsigned sum, cnt, mine, sp = 0u;
  for (;;) {
    sum = 0u; cnt = 0u; mine = 0u;
#pragma unroll
    for (unsigned j = 0; j < 16; ++j) { const unsigned c = xb_ld(&bar[XB_XCNT(j)]); sum += c; cnt += (c > 0u) ? 1u : 0u; mine = (j == x) ? c : mine; }
    if (sum == G) break;
    __builtin_amdgcn_s_sleep(1);
    if ((++sp & 255u) == 0u) { if (xb_ld(&bar[XB_TMO])) break; if (sp > XB_SPIN_CAP) { atomicAdd(&bar[XB_TMO], 1u); break; } }
  }
  nloc = mine > 0u ? mine : 1u; nx = cnt > 0u ? cnt : 1u;
}
DI void xcd_barrier(const XcdBarrier& b) {
  asm volatile("s_waitcnt vmcnt(0)" ::: "memory");
  __syncthreads();
  if (threadIdx.x == 0) {
    unsigned* bar = b.bar;
    __builtin_amdgcn_s_waitcnt(0);
    unsigned nloc = b.st[0], nx = b.st[1];
    if (nloc == 0u) { xcd_barrier_complete(bar, b.x, nloc, nx); b.st[0] = nloc; b.st[1] = nx; }
    const unsigned old = xb_add(&bar[XB_XSUB(b.x)], 1u);
    const unsigned gen = old / nloc;
    if (old + 1u == (gen + 1u) * nloc) {
      __builtin_amdgcn_fence(__ATOMIC_RELEASE, "agent");
      asm volatile("s_waitcnt vmcnt(0)" ::: "memory");
      const unsigned og = xb_add(&bar[XB_TOP], 1u);
      const unsigned tg = og / nx;
      if (og + 1u == (tg + 1u) * nx) xb_add(&bar[XB_TOPGEN], 1u);
      else XB_SPIN(xb_ld(&bar[XB_TOPGEN]) == tg, bar);
      __builtin_amdgcn_fence(__ATOMIC_ACQUIRE, "agent");
      xb_add(&bar[XB_XGEN(b.x)], 1u);
      asm volatile("s_waitcnt vmcnt(0)" ::: "memory");
    } else {
      XB_SPIN(xb_ld(&bar[XB_XGEN(b.x)]) == gen, bar);
      __builtin_amdgcn_fence(__ATOMIC_ACQUIRE, "agent");
      asm volatile("s_waitcnt vmcnt(0)" ::: "memory");
    }
  }
  __syncthreads();
}

DI void convert_wt(const float* __restrict__ W, int K, int N, int Npad, bf16_t* __restrict__ Wt, int mode, float* lds) {
  const int tk = K / 64, tn = Npad / 64;
  for (int t = blockIdx.x; t < tk * tn; t += gridDim.x) {
    const int tid = opaque((int)threadIdx.x);
    const int k0 = (t % tk) * 64, n0 = (t / tk) * 64;
    __syncthreads();
#pragma unroll
    for (int p = 0; p < 16; ++p) {
      int e = tid + p * 256; int kk = e >> 6, nn = e & 63;
      float v = (n0 + nn < N) ? W[(size_t)(k0 + kk) * N + n0 + nn] : 0.f;
      lds[kk * 65 + nn] = v;
    }
    __syncthreads();
#pragma unroll
    for (int p = 0; p < 16; ++p) {
      int e = tid + p * 256; int nn = e >> 6, kk = e & 63;
      int n = n0 + nn; int dst = n;
      if (mode == 1) dst = (n < 1024) ? ((n >> 5) * 64 + (n & 31)) : (((n - 1024) >> 5) * 64 + 32 + ((n - 1024) & 31));
      Wt[(size_t)dst * K + k0 + kk] = f2bf(lds[kk * 65 + nn]);
    }
  }
}

DI void adaln_phase(const Params& P, float* lds) {
  float* part = (float*)(P.ws + WS_BIG);
  float* sc = lds;
  float* red = lds + 5 * 1024;
  bool loaded = false;
  for (int item = blockIdx.x; item < 4 * 48 * 8; item += gridDim.x) {
    const int tid = opaque((int)threadIdx.x);
    if (!loaded) {
      for (int e = tid; e < 5 * 1024; e += 256) {
        int j = e >> 10, k = e & 1023;
        float v = (j < 4) ? P.c[j * 1024 + k] : P.c_ctx[k];
        sc[e] = siluf_(v);
      }
      loaded = true;
    }
    __syncthreads();
    const int ksl = item & 7, cg_ = (item >> 3) % 48, layer = item / (8 * 48);
    const int n0 = cg_ * 64;
    const int col = tid & 63, ks = tid >> 6;
    const int kb = ksl * 128 + ks * 32;
    const float* W = P.ada_w + (size_t)layer * 1024 * 3072 + (size_t)kb * 3072 + n0 + col;
    float wv[32];
#pragma unroll
    for (int i = 0; i < 32; ++i) wv[i] = W[(size_t)i * 3072];
    float a0 = 0, a1 = 0, a2 = 0, a3 = 0, a4 = 0;
#pragma unroll
    for (int i = 0; i < 32; ++i) {
      const int k = kb + i; const float w = wv[i];
      a0 += sc[k] * w; a1 += sc[1024 + k] * w; a2 += sc[2048 + k] * w; a3 += sc[3072 + k] * w; a4 += sc[4096 + k] * w;
    }
    red[(ks * 5 + 0) * 64 + col] = a0; red[(ks * 5 + 1) * 64 + col] = a1; red[(ks * 5 + 2) * 64 + col] = a2;
    red[(ks * 5 + 3) * 64 + col] = a3; red[(ks * 5 + 4) * 64 + col] = a4;
    __syncthreads();
    for (int e = tid; e < 5 * 64; e += 256) {
      int j = e >> 6, cc = e & 63;
      float s = red[(0 * 5 + j) * 64 + cc] + red[(1 * 5 + j) * 64 + cc] + red[(2 * 5 + j) * 64 + cc] + red[(3 * 5 + j) * 64 + cc];
      part[(size_t)ksl * 61440 + (layer * 5 + j) * 3072 + n0 + cc] = s;
    }
  }
}

DI void adaln_reduce(const Params& P) {
  float* mod = (float*)(P.ws + WS_MOD);
  const float* part = (const float*)(P.ws + WS_BIG);
  for (int id = blockIdx.x * 256 + opaque((int)threadIdx.x); id < 61440; id += gridDim.x * 256) {
    float s = P.ada_b[(id / 15360) * 3072 + (id % 3072)];
#pragma unroll
    for (int k = 0; k < 8; ++k) s += part[(size_t)k * 61440 + id];
    mod[id] = s;
  }
}

DI void ew_phase(const Params& P, int prev, int next, const float* __restrict__ O, bf16_t* __restrict__ A) {
  const float* mod = (const float*)(P.ws + WS_MOD);
  float* hctx = (float*)(P.ws + WS_HCTX);
  const int gw = blockIdx.x * 4 + (opaque((int)threadIdx.x) >> 6), nw = gridDim.x * 4;
  for (int tok = gw; tok < NT; tok += nw) {
    const int lane = opaque((int)threadIdx.x) & 63;
    const int b = tok / TPB, pos = tok % TPB;
    const bool isctx = pos < CTX;
    if (isctx && prev == 3) continue;
    const int cj = isctx ? 4 : b;
    const float* hs; float* hd;
    if (isctx) { hd = hctx + (size_t)(b * CTX + pos) * D; hs = (prev <= 0) ? P.ctx + (size_t)(b * CTX + pos) * D : hd; }
    else { hd = P.out + (size_t)(b * SEQ + pos - CTX) * D; hs = (prev <= 0) ? P.x + (size_t)(b * SEQ + pos - CTX) * D : hd; }
    float4 h[4];
#pragma unroll
    for (int j = 0; j < 4; ++j) h[j] = *(const float4*)(hs + j * 256 + lane * 4);
    if (prev >= 0) {
      float4 o[4]; float ss = 0;
#pragma unroll
      for (int j = 0; j < 4; ++j) { o[j] = *(const float4*)(O + (size_t)tok * D + j * 256 + lane * 4); ss += o[j].x * o[j].x + o[j].y * o[j].y + o[j].z * o[j].z + o[j].w * o[j].w; }
      ss = wsum(ss);
      const float rstd = rsqrtf(ss * (1.f / 1024.f) + 1e-6f);
      const float* gt = mod + (prev * 5 + cj) * 3072 + 2048;
      const float* pg = P.post_g + prev * 1024;
#pragma unroll
      for (int j = 0; j < 4; ++j) {
        float4 g4 = *(const float4*)(gt + j * 256 + lane * 4), p4 = *(const float4*)(pg + j * 256 + lane * 4);
        h[j].x += g4.x * o[j].x * rstd * p4.x; h[j].y += g4.y * o[j].y * rstd * p4.y;
        h[j].z += g4.z * o[j].z * rstd * p4.z; h[j].w += g4.w * o[j].w * rstd * p4.w;
        *(float4*)(hd + j * 256 + lane * 4) = h[j];
      }
    }
    if (next >= 0) {
      float ss = 0;
#pragma unroll
      for (int j = 0; j < 4; ++j) ss += h[j].x * h[j].x + h[j].y * h[j].y + h[j].z * h[j].z + h[j].w * h[j].w;
      ss = wsum(ss);
      const float rstd = rsqrtf(ss * (1.f / 1024.f) + 1e-6f);
      const float* sh = mod + (next * 5 + cj) * 3072;
      const float* scl = sh + 1024;
      const float* pg = P.pre_g + next * 1024;
#pragma unroll
      for (int j = 0; j < 4; ++j) {
        float4 s4 = *(const float4*)(sh + j * 256 + lane * 4), c4 = *(const float4*)(scl + j * 256 + lane * 4), p4 = *(const float4*)(pg + j * 256 + lane * 4);
        bf16x4 r;
        r[0] = (short)f2bf(h[j].x * rstd * p4.x * (1.f + c4.x) + s4.x);
        r[1] = (short)f2bf(h[j].y * rstd * p4.y * (1.f + c4.y) + s4.y);
        r[2] = (short)f2bf(h[j].z * rstd * p4.z * (1.f + c4.z) + s4.z);
        r[3] = (short)f2bf(h[j].w * rstd * p4.w * (1.f + c4.w) + s4.w);
        *(bf16x4*)(A + (size_t)tok * D + j * 256 + lane * 4) = r;
      }
    }
  }
}


typedef __attribute__((ext_vector_type(2))) __bf16 bf16v2;
typedef __attribute__((ext_vector_type(2))) float f32v2;
DI unsigned pack2bf(float lo, float hi) { f32v2 v = {lo, hi}; return __builtin_bit_cast(unsigned, __builtin_convertvector(v, bf16v2)); }
DI void st_pair(bf16_t* C, size_t ldc, int row_i, int col, float vi, float vi1, int r) {
  const bool odd = (r & 1) != 0;
  const float recv = __shfl_xor(odd ? vi : vi1, 1);
  const float lo = odd ? recv : vi, hi = odd ? vi1 : recv;
  *(unsigned*)(C + (size_t)(row_i + (odd ? 1 : 0)) * ldc + (col & ~1)) = pack2bf(lo, hi);
}

enum { EPI_BF16 = 0, EPI_F32, EPI_S5Y, EPI_GLU, EPI_NAIN, EPI_GDNIN };
struct Gemm {
  const bf16_t* A; long a_rs, a_kbs, a_bs;
  const bf16_t* A2; long a2_rs, a2_kbs, a2_bs; int K1;
  const bf16_t* Bt; long b_bs;
  int M, N, K, batch, epi;
  void* C; long ldc, c_bs;
  const bf16_t* zsrc; const float* bias; void* C2; void* C3;
};
constexpr int LDS_STRIDE = 72;
constexpr int GEMM_LDS_BYTES = 2 * 2 * 128 * LDS_STRIDE * 2;

DI void gemm_epilogue(const Gemm& g, int bt, int row0, int col0, f32x16 (&acc)[2][2]) {
  const int lane = opaque((int)threadIdx.x) & 63, r = lane & 31, h = lane >> 5;
  const bool full = (g.M & 127) == 0;
  if (g.epi == EPI_BF16) {
    bf16_t* C = (bf16_t*)g.C;
#pragma unroll
    for (int mi = 0; mi < 2; ++mi)
#pragma unroll
      for (int ni = 0; ni < 2; ++ni)
#pragma unroll
        for (int i = 0; i < 16; i += 2) {
          int row = row0 + mi * 32 + crow(i, h), col = col0 + ni * 32 + r;
          if (full) st_pair(C, g.ldc, row, col, acc[mi][ni][i], acc[mi][ni][i + 1], r);
          else {
            if (row < g.M) C[(size_t)row * g.ldc + col] = f2bf(acc[mi][ni][i]);
            if (row + 1 < g.M) C[(size_t)(row + 1) * g.ldc + col] = f2bf(acc[mi][ni][i + 1]);
          }
        }
  } else if (g.epi == EPI_F32) {
    float* C = (float*)g.C + (size_t)bt * g.c_bs;
#pragma unroll
    for (int mi = 0; mi < 2; ++mi)
#pragma unroll
      for (int ni = 0; ni < 2; ++ni)
#pragma unroll
        for (int i = 0; i < 16; ++i) {
          int row = row0 + mi * 32 + crow(i, h), col = col0 + ni * 32 + r;
          if (full || row < g.M) C[(size_t)row * g.ldc + col] = acc[mi][ni][i];
        }
  } else if (g.epi == EPI_S5Y) {
    bf16_t* C = (bf16_t*)g.C;
#pragma unroll
    for (int mi = 0; mi < 2; ++mi)
#pragma unroll
      for (int ni = 0; ni < 2; ++ni)
#pragma unroll
        for (int i = 0; i < 16; ++i) {
          int row = row0 + mi * 32 + crow(i, h), col = col0 + ni * 32 + r;
          if (full || row < g.M) {
            int tok = row * 16 + (col >> 4);
            C[(size_t)tok * D + bt * 16 + (col & 15)] = f2bf(geluf_(acc[mi][ni][i]));
          }
        }
  } else if (g.epi == EPI_GLU) {
    bf16_t* C = (bf16_t*)g.C;
    const int oc = (col0 >> 6) * 32 + r;
    const float ba = g.bias[oc], bb = g.bias[1024 + oc];
#pragma unroll
    for (int mi = 0; mi < 2; ++mi)
#pragma unroll
      for (int i = 0; i < 16; i += 2) {
        const int row = row0 + mi * 32 + crow(i, h);
        float y[2];
#pragma unroll
        for (int u = 0; u < 2; ++u) {
          const float ga = acc[mi][0][i + u] + ba, gb = acc[mi][1][i + u] + bb;
          const float z = bf2f(g.zsrc[(size_t)(row + u) * 2048 + 1024 + oc]);
          y[u] = ga * sigmoidf_(gb) * siluf_(z);
        }
        st_pair(C, D, row, oc, y[0], y[1], r);
      }
  } else if (g.epi == EPI_NAIN) {
    bf16_t* C = (bf16_t*)g.C;
    bf16_t* Vt = (bf16_t*)g.C2;
#pragma unroll
    for (int ni = 0; ni < 2; ++ni) {
      const int col = col0 + ni * 32 + r;
      if (col >= 2048 && col < 3072) {
        const int hh = (col - 2048) >> 6, d = (col - 2048) & 63;
#pragma unroll
        for (int mi = 0; mi < 2; ++mi)
#pragma unroll
          for (int q = 0; q < 4; ++q) {
            int row = row0 + mi * 32 + 8 * q + 4 * h;
            int b = row / TPB, pos = row % TPB;
            bf16x4 v;
            v[0] = (short)f2bf(acc[mi][ni][q * 4 + 0]); v[1] = (short)f2bf(acc[mi][ni][q * 4 + 1]);
            v[2] = (short)f2bf(acc[mi][ni][q * 4 + 2]); v[3] = (short)f2bf(acc[mi][ni][q * 4 + 3]);
            *(bf16x4*)(Vt + ((size_t)((b * 16 + hh) * 64 + d)) * TPB + pos) = v;
          }
      } else {
        const float sc = (col < 1024) ? 0.125f : 1.f;
#pragma unroll
        for (int mi = 0; mi < 2; ++mi)
#pragma unroll
          for (int i = 0; i < 16; i += 2) {
            int row = row0 + mi * 32 + crow(i, h);
            st_pair(C, 4096, row, col, acc[mi][ni][i] * sc, acc[mi][ni][i + 1] * sc, r);
          }
      }
    }
  } else if (g.epi == EPI_GDNIN) {
    bf16_t* C = (bf16_t*)g.C;
    float* AB = (float*)g.C2;
    bf16_t* Hb = (bf16_t*)g.C3;
#pragma unroll
    for (int ni = 0; ni < 2; ++ni) {
      const int col = col0 + ni * 32 + r;
      if (col < 4096) {
#pragma unroll
        for (int mi = 0; mi < 2; ++mi)
#pragma unroll
          for (int i = 0; i < 16; i += 2) {
            const int row = row0 + mi * 32 + crow(i, h);
            st_pair(C, 4096, row, col, acc[mi][ni][i], acc[mi][ni][i + 1], r);
            if (mi == 0 && i == 0) { if (h == 0 && col < 3072) { Hb[((size_t)(row >> 6) * 4 + 0) * 3072 + col] = f2bf(acc[mi][ni][0]); Hb[((size_t)(row >> 6) * 4 + 1) * 3072 + col] = f2bf(acc[mi][ni][1]); } }
            if (mi == 1 && i == 14) { if (h == 1 && col < 3072) { Hb[((size_t)(row >> 6) * 4 + 2) * 3072 + col] = f2bf(acc[mi][ni][14]); Hb[((size_t)(row >> 6) * 4 + 3) * 3072 + col] = f2bf(acc[mi][ni][15]); } }
          }
      } else if (col < 4128) {
#pragma unroll
        for (int mi = 0; mi < 2; ++mi)
#pragma unroll
          for (int i = 0; i < 16; ++i) {
            const int row = row0 + mi * 32 + crow(i, h);
            AB[(size_t)row * 32 + col - 4096] = acc[mi][ni][i];
          }
      }
    }
  }
}

DI void gemm_phase(const Gemm& g, unsigned char* smem) {
  bf16_t* sA = (bf16_t*)smem;
  bf16_t* sB = sA + 2 * 128 * 64;
  const int ntm = (g.M + 127) / 128, ntn = g.N / 128, nk = g.K / 64;
  const int tiles = g.batch * ntm * ntn;
  const int xcd = blockIdx.x & 7, loc = blockIdx.x >> 3, nloc = gridDim.x >> 3;
  const int t_lo = (int)((long)tiles * xcd / 8), t_hi = (int)((long)tiles * (xcd + 1) / 8);
  for (int tile = t_lo + loc; tile < t_hi; tile += nloc) {
    const int tid = opaque((int)threadIdx.x), lane = tid & 63, w = tid >> 6, wm = w >> 1, wn = w & 1;
    int bt = tile / (ntm * ntn); const int rem = tile % (ntm * ntn);
    int tm = rem / ntn, tn = rem % ntn;
    if (g.batch == 1 && ntm == 136) {
      const int li = tile - t_lo;
      const int band = li / (8 * ntn), idx = li - band * 8 * ntn;
      int row, col;
      if (band < 2) {
        const int nb = ntn >> 3, fullt = nb << 6;
        if (idx < fullt) { row = (idx & 63) >> 3; col = (idx >> 6) * 8 + (idx & 7); }
        else { const int wr = ntn - 8 * nb, i2 = idx - fullt; row = i2 / wr; col = 8 * nb + i2 % wr; }
      } else { row = 0; col = idx; }
      if (band == 1) col = ntn - 1 - col;
      bt = 0; tm = xcd * 17 + band * 8 + row; tn = col;
    }
    f32x16 acc[2][2];
#pragma unroll
    for (int mi = 0; mi < 2; ++mi)
#pragma unroll
      for (int ni = 0; ni < 2; ++ni)
#pragma unroll
        for (int i = 0; i < 16; ++i) acc[mi][ni][i] = 0.f;
#define STAGE1(KT, BUF, p) { \
        const int q = p * 256 + tid; \
        const int row = q >> 3, pc = q & 7; \
        const int c = pc ^ ((row >> 1) & 7); \
        const int grow = imin(tm * 128 + row, g.M - 1); \
        const int k = (KT) * 64 + c * 8; \
        const bf16_t* pa; \
        if (k < g.K1) pa = g.A + (long)bt * g.a_bs + (long)grow * g.a_rs + (long)(k >> 4) * g.a_kbs + (k & 15); \
        else { const int k2 = k - g.K1; pa = g.A2 + (long)bt * g.a2_bs + (long)grow * g.a2_rs + (long)(k2 >> 4) * g.a2_kbs + (k2 & 15); } \
        const bf16_t* pb = g.Bt + (long)bt * g.b_bs + (long)(tn * 128 + row) * g.K + k; \
        __builtin_amdgcn_global_load_lds((const unsigned*)pa, (lds_u32*)(sA + (BUF) * 8192 + q * 8), 16, 0, 0); \
        __builtin_amdgcn_global_load_lds((const unsigned*)pb, (lds_u32*)(sB + (BUF) * 8192 + q * 8), 16, 0, 0); }
#define STAGE(KT, BUF) { STAGE1(KT, BUF, 0) STAGE1(KT, BUF, 1) STAGE1(KT, BUF, 2) STAGE1(KT, BUF, 3) }
#define COMPUTE(BUF) { \
      const int ra0_ = wm * 64 + (lane & 31), ra1_ = ra0_ + 32, rb0_ = wn * 64 + (lane & 31), rb1_ = rb0_ + 32; \
      _Pragma("unroll") for (int ks = 0; ks < 4; ++ks) { \
        const int c = ks * 2 + (lane >> 5); \
        bf16x8 af0 = *(const bf16x8*)(sA + (BUF) * 8192 + ra0_ * 64 + ((c ^ ((ra0_ >> 1) & 7)) << 3)); \
        bf16x8 af1 = *(const bf16x8*)(sA + (BUF) * 8192 + ra1_ * 64 + ((c ^ ((ra1_ >> 1) & 7)) << 3)); \
        bf16x8 bf0 = *(const bf16x8*)(sB + (BUF) * 8192 + rb0_ * 64 + ((c ^ ((rb0_ >> 1) & 7)) << 3)); \
        bf16x8 bf1 = *(const bf16x8*)(sB + (BUF) * 8192 + rb1_ * 64 + ((c ^ ((rb1_ >> 1) & 7)) << 3)); \
        acc[0][0] = __builtin_amdgcn_mfma_f32_32x32x16_bf16(af0, bf0, acc[0][0], 0, 0, 0); \
        acc[0][1] = __builtin_amdgcn_mfma_f32_32x32x16_bf16(af0, bf1, acc[0][1], 0, 0, 0); \
        acc[1][0] = __builtin_amdgcn_mfma_f32_32x32x16_bf16(af1, bf0, acc[1][0], 0, 0, 0); \
        acc[1][1] = __builtin_amdgcn_mfma_f32_32x32x16_bf16(af1, bf1, acc[1][1], 0, 0, 0); \
      } }
    lds_barrier();
    STAGE(0, 0);
    asm volatile("s_waitcnt vmcnt(0)" ::: "memory");
    lds_barrier();
    for (int kt = 0; kt < nk; kt += 2) {
      STAGE(kt + 1, 1);
      COMPUTE(0);
      asm volatile("s_waitcnt vmcnt(0)" ::: "memory");
      lds_barrier();
      if (kt + 2 < nk) STAGE(kt + 2, 0);
      COMPUTE(1);
      asm volatile("s_waitcnt vmcnt(0)" ::: "memory");
      lds_barrier();
    }
#undef STAGE
#undef STAGE1
#undef COMPUTE
    gemm_epilogue(g, bt, tm * 128 + wm * 64, tn * 128 + wn * 64, acc);
  }
}

DI void gemm_phase_wide(const Gemm& g, unsigned char* smem) {
  bf16_t* sA = (bf16_t*)smem;
  bf16_t* sB = sA + 2 * 128 * 32;
  const int ntm = g.M / 128, ntn = g.N / 256, nk = g.K / 32;
  const int tiles = ntm * ntn;
  const int xcd = blockIdx.x & 7, loc = blockIdx.x >> 3, nloc = gridDim.x >> 3;
  const int t_lo = (int)((long)tiles * xcd / 8), t_hi = (int)((long)tiles * (xcd + 1) / 8);
  for (int tile = t_lo + loc; tile < t_hi; tile += nloc) {
    const int tid = opaque((int)threadIdx.x), lane = tid & 63, w = tid >> 6, wm = w >> 1, wn = w & 1;
    int tm = tile / ntn, tn = tile % ntn;
    if (ntm == 136) {
      const int li = tile - t_lo;
      const int band = li / (8 * ntn), idx = li - band * 8 * ntn;
      int row, col;
      if (band < 2) {
        const int nb = ntn >> 3, fullt = nb << 6;
        if (idx < fullt) { row = (idx & 63) >> 3; col = (idx >> 6) * 8 + (idx & 7); }
        else { const int wr = ntn - 8 * nb, i2 = idx - fullt; row = i2 / wr; col = 8 * nb + i2 % wr; }
      } else { row = 0; col = idx; }
      if (band == 1) col = ntn - 1 - col;
      tm = xcd * 17 + band * 8 + row; tn = col;
    }
    f32x16 accL[2][2], accR[2][2];
#pragma unroll
    for (int mi = 0; mi < 2; ++mi)
#pragma unroll
      for (int ni = 0; ni < 2; ++ni)
#pragma unroll
        for (int i = 0; i < 16; ++i) { accL[mi][ni][i] = 0.f; accR[mi][ni][i] = 0.f; }
#define WSTAGE_A(KT, BUF, p) { \
        const int q = p * 256 + tid; const int row = q >> 2, pc = q & 3; \
        const int c = pc ^ ((row >> 2) & 3); \
        const bf16_t* pa = g.A + (long)(tm * 128 + row) * g.a_rs + (KT) * 32 + c * 8; \
        __builtin_amdgcn_global_load_lds((const unsigned*)pa, (lds_u32*)(sA + (BUF) * 4096 + q * 8), 16, 0, 0); }
#define WSTAGE_B(KT, BUF, p) { \
        const int q = p * 256 + tid; const int row = q >> 2, pc = q & 3; \
        const int c = pc ^ ((row >> 2) & 3); \
        const bf16_t* pb = g.Bt + (long)(tn * 256 + row) * g.K + (KT) * 32 + c * 8; \
        __builtin_amdgcn_global_load_lds((const unsigned*)pb, (lds_u32*)(sB + (BUF) * 8192 + q * 8), 16, 0, 0); }
#define WSTAGE(KT, BUF) { WSTAGE_A(KT, BUF, 0) WSTAGE_A(KT, BUF, 1) WSTAGE_B(KT, BUF, 0) WSTAGE_B(KT, BUF, 1) WSTAGE_B(KT, BUF, 2) WSTAGE_B(KT, BUF, 3) }
#define WFRAG(S, BUFOFF, ROW, C) (*(const bf16x8*)((S) + (BUFOFF) + (ROW) * 32 + (((C) ^ (((ROW) >> 2) & 3)) << 3)))
#define WCOMPUTE(BUF) { \
      const int ra_ = wm * 64 + (lane & 31), rb_ = wn * 128 + (lane & 31); \
      _Pragma("unroll") for (int ks = 0; ks < 2; ++ks) { \
        const int c = ks * 2 + (lane >> 5); \
        bf16x8 a0 = WFRAG(sA, (BUF) * 4096, ra_, c), a1 = WFRAG(sA, (BUF) * 4096, ra_ + 32, c); \
        bf16x8 b0 = WFRAG(sB, (BUF) * 8192, rb_, c), b1 = WFRAG(sB, (BUF) * 8192, rb_ + 32, c); \
        bf16x8 b2 = WFRAG(sB, (BUF) * 8192, rb_ + 64, c), b3 = WFRAG(sB, (BUF) * 8192, rb_ + 96, c); \
        accL[0][0] = __builtin_amdgcn_mfma_f32_32x32x16_bf16(a0, b0, accL[0][0], 0, 0, 0); \
        accL[0][1] = __builtin_amdgcn_mfma_f32_32x32x16_bf16(a0, b1, accL[0][1], 0, 0, 0); \
        accR[0][0] = __builtin_amdgcn_mfma_f32_32x32x16_bf16(a0, b2, accR[0][0], 0, 0, 0); \
        accR[0][1] = __builtin_amdgcn_mfma_f32_32x32x16_bf16(a0, b3, accR[0][1], 0, 0, 0); \
        accL[1][0] = __builtin_amdgcn_mfma_f32_32x32x16_bf16(a1, b0, accL[1][0], 0, 0, 0); \
        accL[1][1] = __builtin_amdgcn_mfma_f32_32x32x16_bf16(a1, b1, accL[1][1], 0, 0, 0); \
        accR[1][0] = __builtin_amdgcn_mfma_f32_32x32x16_bf16(a1, b2, accR[1][0], 0, 0, 0); \
        accR[1][1] = __builtin_amdgcn_mfma_f32_32x32x16_bf16(a1, b3, accR[1][1], 0, 0, 0); \
      } }
    lds_barrier();
    WSTAGE(0, 0);
    asm volatile("s_waitcnt vmcnt(0)" ::: "memory");
    lds_barrier();
    for (int kt = 0; kt < nk; kt += 2) {
      WSTAGE(kt + 1, 1);
      WCOMPUTE(0);
      asm volatile("s_waitcnt vmcnt(0)" ::: "memory");
      lds_barrier();
      if (kt + 2 < nk) WSTAGE(kt + 2, 0);
      WCOMPUTE(1);
      asm volatile("s_waitcnt vmcnt(0)" ::: "memory");
      lds_barrier();
    }
#undef WSTAGE
#undef WSTAGE_A
#undef WSTAGE_B
#undef WFRAG
#undef WCOMPUTE
    gemm_epilogue(g, 0, tm * 128 + wm * 64, tn * 256 + wn * 128, accL);
    gemm_epilogue(g, 0, tm * 128 + wm * 64, tn * 256 + wn * 128 + 64, accR);
  }
}

DI Gemm gemm_plain(const bf16_t* A, const bf16_t* Bt, int M, int N, int K, int epi, void* C, long ldc) {
  Gemm g{};
  g.A = A; g.a_rs = K; g.a_kbs = 16; g.a_bs = 0; g.A2 = A; g.K1 = K; g.a2_rs = K; g.a2_kbs = 16; g.a2_bs = 0;
  g.Bt = Bt; g.b_bs = 0; g.M = M; g.N = N; g.K = K; g.batch = 1; g.epi = epi; g.C = C; g.ldc = ldc; g.c_bs = 0;
  return g;
}

DI void sincos_red(double ang, float& s, float& c) {
  const double twopi = 6.283185307179586476925286766559;
  double t = ang / twopi; t = t - rint(t);
  float x = (float)(t * twopi);
  s = sinf(x); c = cosf(x);
}
DI void s5_pre_a(const Params& P, int j) {
  float2* apow = (float2*)(P.ws + WS_WT + WT_S5_APOW);
  float2* bbar = (float2*)(P.ws + WS_WT + WT_S5_BBAR);
  for (int id = blockIdx.x * 256 + opaque((int)threadIdx.x); id < 2 * 64 * 64; id += gridDim.x * 256) {
    const int d = id >> 12, g = (id >> 6) & 63, p = id & 63;
    const int base = ((j * 2 + d) * 64 + g);
    const double lr = P.s5_lam_re[base * 64 + p], li = P.s5_lam_im[base * 64 + p];
    const double dt = (double)expf(P.s5_log_dt[base]);
    float are = 1.f, aim = 0.f;
    for (int k = 0; k <= 16; ++k) {
      float mag = expf((float)(k * lr * dt)); float s, c; sincos_red(k * li * dt, s, c);
      apow[((d * 64 + g) * 17 + k) * 64 + p] = make_float2(mag * c, mag * s);
      if (k == 1) { are = mag * c; aim = mag * s; }
    }
    const float lrf = (float)lr, lif = (float)li;
    const float den = lrf * lrf + lif * lif;
    const float fre = ((are - 1.f) * lrf + aim * lif) / den, fim = (aim * lrf - (are - 1.f) * lif) / den;
    for (int c = 0; c < 16; ++c) {
      float br = P.s5_b_re[(size_t)(base * 64 + p) * 16 + c], bi = P.s5_b_im[(size_t)(base * 64 + p) * 16 + c];
      bbar[((d * 64 + g) * 64 + p) * 16 + c] = make_float2(fre * br - fim * bi, fre * bi + fim * br);
    }
  }
}
DI void s5_pre_b(const Params& P, int j) {
  const float2* apow = (const float2*)(P.ws + WS_WT + WT_S5_APOW);
  const float2* bbar = (const float2*)(P.ws + WS_WT + WT_S5_BBAR);
  float* ktab = (float*)(P.ws + WS_WT + WT_S5_KTAB);
  bf16_t* opt = (bf16_t*)(P.ws + WS_WT + WT_S5_OPT);
  bf16_t* bpt = (bf16_t*)(P.ws + WS_WT + WT_S5_BPT);
  const int gt = blockIdx.x * 256 + opaque((int)threadIdx.x), gn = gridDim.x * 256;
  for (int id = gt; id < 2 * 64 * 16 * 256; id += gn) {
    const int c2 = id & 15, c = (id >> 4) & 15, k = (id >> 8) & 15, g = (id >> 12) & 63, d = id >> 18;
    const int base = ((j * 2 + d) * 64 + g);
    const float* cr = P.s5_c_re + (size_t)(base * 16 + c) * 64;
    const float* ci = P.s5_c_im + (size_t)(base * 16 + c) * 64;
    float s = 0.f;
    for (int p = 0; p < 64; ++p) {
      float2 a = apow[((d * 64 + g) * 17 + k) * 64 + p];
      float2 b = bbar[((d * 64 + g) * 64 + p) * 16 + c2];
      float xr = cr[p] * a.x - ci[p] * a.y, xi = cr[p] * a.y + ci[p] * a.x;
      s += xr * b.x - xi * b.y;
    }
    ktab[id] = s;
  }
  for (int id = gt; id < 64 * 256 * 256; id += gn) {
    const int kk = id & 255, n = (id >> 8) & 255, g = id >> 16;
    const int i = kk >> 4, c2 = kk & 15, d = n >> 7, ri = (n >> 6) & 1, p = n & 63;
    const int e = d == 0 ? 15 - i : i;
    float2 a = apow[((d * 64 + g) * 17 + e) * 64 + p];
    float2 b = bbar[((d * 64 + g) * 64 + p) * 16 + c2];
    float re = a.x * b.x - a.y * b.y, im = a.x * b.y + a.y * b.x;
    bpt[id] = f2bf(ri ? im : re);
  }
  for (int id = gt; id < 64 * 256 * 256; id += gn) {
    const int kk = id & 255, n = (id >> 8) & 255, g = id >> 16;
    const int jj = n >> 4, c = n & 15, d = kk >> 7, ri = (kk >> 6) & 1, p = kk & 63;
    const int e = d == 0 ? jj + 1 : 16 - jj;
    const int base = ((j * 2 + d) * 64 + g);
    float2 a = apow[((d * 64 + g) * 17 + e) * 64 + p];
    float cr = P.s5_c_re[(size_t)(base * 16 + c) * 64 + p], ci = P.s5_c_im[(size_t)(base * 16 + c) * 64 + p];
    float re = cr * a.x - ci * a.y, im = cr * a.y + ci * a.x;
    opt[((size_t)g * 256 + n) * 512 + 256 + kk] = f2bf(ri ? -im : re);
  }
}
DI void s5_pre_c(const Params& P, int j) {
  const float* ktab = (const float*)(P.ws + WS_WT + WT_S5_KTAB);
  bf16_t* opt = (bf16_t*)(P.ws + WS_WT + WT_S5_OPT);
  for (int id = blockIdx.x * 256 + opaque((int)threadIdx.x); id < 64 * 256 * 256; id += gridDim.x * 256) {
    const int kk = id & 255, n = (id >> 8) & 255, g = id >> 16;
    const int jj = n >> 4, c = n & 15, i = kk >> 4, c2 = kk & 15;
    float v = 0.f;
    if (i <= jj) v += ktab[(((0 * 64 + g) * 16 + (jj - i)) * 16 + c) * 16 + c2];
    if (i >= jj) v += ktab[(((1 * 64 + g) * 16 + (i - jj)) * 16 + c) * 16 + c2];
    if (i == jj && c == c2) v += P.s5_d[j * 1024 + g * 16 + c];
    opt[((size_t)g * 256 + n) * 512 + kk] = f2bf(v);
  }
}
DI void s5_carry(const Params& P, const float* __restrict__ Sloc, bf16_t* __restrict__ Sin) {
  const float2* apow = (const float2*)(P.ws + WS_WT + WT_S5_APOW);
  const int wv = opaque((int)threadIdx.x) >> 6;
  for (int task = blockIdx.x + gridDim.x * wv; task < 512; task += gridDim.x * 4) {
    const int p = opaque((int)threadIdx.x) & 63;
    const int d = task & 1, b = (task >> 1) & 3, g = task >> 3;
    const float2 a = apow[((d * 64 + g) * 17 + 16) * 64 + p];
    const size_t base = ((size_t)g * 1088 + b * 272) * 256 + d * 128 + p;
    float sr = 0.f, si = 0.f;
    for (int s0 = 0; s0 < 272; s0 += 16) {
      float lr[16], li[16];
#pragma unroll
      for (int u = 0; u < 16; ++u) {
        const int step = s0 + u;
        const int q = d == 0 ? step : (step < 16 ? 15 - step : 287 - step);
        const size_t o = base + (size_t)q * 256;
        lr[u] = Sloc[o]; li[u] = Sloc[o + 64];
      }
#pragma unroll
      for (int u = 0; u < 16; ++u) {
        const int step = s0 + u;
        const int q = d == 0 ? step : (step < 16 ? 15 - step : 287 - step);
        const size_t o = base + (size_t)q * 256;
        Sin[o] = f2bf(sr); Sin[o + 64] = f2bf(si);
        const float nr = a.x * sr - a.y * si + lr[u], ni = a.x * si + a.y * sr + li[u];
        sr = nr; si = ni;
      }
    }
  }
}

template <bool WIN>
DI void na_step(const bf16_t* sK, const bf16_t* sV, const bf16x8 (&qf)[2], float& m, float& lsum, f32x4 (&O)[4],
                const float* __restrict__ rpb, int hd, int r, int r0, int step, int cs, int wq, int start, int lq, int lg) {
  constexpr int NTILE = WIN ? 4 : 8;
  f32x4 S[NTILE];
#pragma unroll
  for (int t = 0; t < NTILE; ++t) {
    const int kidx = WIN ? ((t >> 1) * 64 + cs + (t & 1) * 16 + lq) : (t * 16 + lq);
    f32x4 s = f32x4{0.f, 0.f, 0.f, 0.f};
#pragma unroll
    for (int kk = 0; kk < 2; ++kk) {
      bf16x8 kf = *(const bf16x8*)(sK + kidx * 72 + kk * 32 + lg * 8);
      s = __builtin_amdgcn_mfma_f32_16x16x32_bf16(kf, qf[kk], s, 0, 0, 0);
    }
    S[t] = s;
  }
  if (WIN) {
#pragma unroll
    for (int t = 0; t < NTILE; ++t) {
      const int ro = r0 + step * 2 + (t >> 1) - r + 7;
#pragma unroll
      for (int e = 0; e < 4; ++e) {
        const int col = cs + (t & 1) * 16 + lg * 4 + e;
        const bool valid = (col >= start) && (col < start + 16);
        const int co = imin(imax(col - wq + 15, 0), 30);
        const float bias = rpb[(hd * 15 + ro) * 31 + co];
        S[t][e] = valid ? S[t][e] + bias : -1e30f;
      }
    }
  }
  float mx = -1e30f;
#pragma unroll
  for (int t = 0; t < NTILE; ++t)
#pragma unroll
    for (int e = 0; e < 4; ++e) mx = fmaxf(mx, S[t][e]);
  mx = fmaxf(mx, __shfl_xor(mx, 16)); mx = fmaxf(mx, __shfl_xor(mx, 32));
  const float mnew = fmaxf(m, mx);
  const float alpha = __expf(m - mnew);
  float ps = 0.f;
#pragma unroll
  for (int t = 0; t < NTILE; ++t)
#pragma unroll
    for (int e = 0; e < 4; ++e) { float pv = __expf(S[t][e] - mnew); S[t][e] = pv; ps += pv; }
  lsum = lsum * alpha + ps; m = mnew;
#pragma unroll
  for (int dt = 0; dt < 4; ++dt) O[dt] *= alpha;
#pragma unroll
  for (int pr = 0; pr < NTILE / 2; ++pr) {
    bf16x8 pf;
#pragma unroll
    for (int e = 0; e < 4; ++e) { pf[e] = (short)f2bf(S[2 * pr][e]); pf[4 + e] = (short)f2bf(S[2 * pr + 1][e]); }
    const int pos0 = WIN ? (pr * 64 + cs + lg * 4) : (pr * 32 + lg * 4);
#pragma unroll
    for (int dt = 0; dt < 4; ++dt) {
      const bf16_t* vb = sV + (dt * 16 + lq) * 136;
      bf16x4 lo = *(const bf16x4*)(vb + pos0), hi = *(const bf16x4*)(vb + pos0 + 16);
      bf16x8 vf = __builtin_shufflevector(lo, hi, 0, 1, 2, 3, 4, 5, 6, 7);
      O[dt] = __builtin_amdgcn_mfma_f32_16x16x32_bf16(vf, pf, O[dt], 0, 0, 0);
    }
  }
}

DI void na_attn(const Params& P, const bf16_t* __restrict__ Pb, const bf16_t* __restrict__ Vt, bf16_t* __restrict__ Y, unsigned char* smem) {
  bf16_t* sK = (bf16_t*)smem;
  bf16_t* sV = sK + 128 * 72;
  const float* rpb = P.na_rpb;
  const int xcd_ = blockIdx.x & 7, nloc_ = gridDim.x >> 3;
  for (int job = xcd_ * 544 + (blockIdx.x >> 3); job < (xcd_ + 1) * 544; job += nloc_) {
    const int tid = opaque((int)threadIdx.x);
    const int lane = tid & 63, wv = tid >> 6;
    const int lq = lane & 15, lg = lane >> 4;
    int b, hd, r = 0, r0 = 0, cs = 0, w0 = 0, qtok, s_lo;
    if (job < 4096) { b = job >> 10; hd = (job >> 6) & 15; r = job & 63; w0 = wv * 16; r0 = imin(imax(r - 4, 0), 56); cs = imin(imax(w0 - 8, 0), 32); qtok = b * TPB + CTX + r * 64 + w0 + lq; s_lo = 0; }
    else { int jj = job - 4096; b = jj >> 6; hd = (jj >> 2) & 15; qtok = b * TPB + (jj & 3) * 64 + wv * 16 + lq; s_lo = 4; }
    bf16x8 qf[2];
#pragma unroll
    for (int kk = 0; kk < 2; ++kk) qf[kk] = *(const bf16x8*)(Pb + (size_t)qtok * 4096 + hd * 64 + kk * 32 + lg * 8);
    float m = -1e30f, lsum = 0.f;
    f32x4 O[4];
#pragma unroll
    for (int dt = 0; dt < 4; ++dt) O[dt] = f32x4{0.f, 0.f, 0.f, 0.f};
    const int wq = w0 + lq;
    const int start = imin(imax(wq - 8, 0), 48);
    uint4 rk0, rk1, rk2, rk3, rv0, rv1, rv2, rv3;
    const bf16_t* vrow = Vt + (size_t)((b * 16 + hd) * 64) * TPB;
#define NA_LOAD1(p, RK, RV, STEP) { \
      const int e = tid + p * 256; \
      const int key = e >> 3, part = e & 7; \
      const int ktok = (STEP) < 4 ? (b * TPB + CTX + (r0 + (STEP) * 2 + (key >> 6)) * 64 + (key & 63)) : (b * TPB + ((STEP) - 4) * 128 + key); \
      RK = *(const uint4*)(Pb + (size_t)ktok * 4096 + 1024 + hd * 64 + part * 8); \
      const int d = e >> 4, seg = e & 15; \
      const int vpos = (STEP) < 4 ? (CTX + (r0 + (STEP) * 2 + (seg >> 3)) * 64 + (seg & 7) * 8) : (((STEP) - 4) * 128 + seg * 8); \
      RV = *(const uint4*)(vrow + (size_t)d * TPB + vpos); }
#define NA_LOAD(STEP) { NA_LOAD1(0, rk0, rv0, STEP) NA_LOAD1(1, rk1, rv1, STEP) NA_LOAD1(2, rk2, rv2, STEP) NA_LOAD1(3, rk3, rv3, STEP) }
#define NA_STORE1(p, RK, RV) { \
      const int e = tid + p * 256; \
      *(uint4*)(sK + (e >> 3) * 72 + (e & 7) * 8) = RK; \
      *(uint4*)(sV + (e >> 4) * 136 + (e & 15) * 8) = RV; }
#define NA_STORE() { NA_STORE1(0, rk0, rv0) NA_STORE1(1, rk1, rv1) NA_STORE1(2, rk2, rv2) NA_STORE1(3, rk3, rv3) }
    NA_LOAD(s_lo);
    for (int step = s_lo; step < 6; ++step) {
      __syncthreads();
      NA_STORE();
      __syncthreads();
      if (step + 1 < 6) NA_LOAD(step + 1);
      if (step < 4) na_step<true>(sK, sV, qf, m, lsum, O, rpb, hd, r, r0, step, cs, wq, start, lq, lg);
      else na_step<false>(sK, sV, qf, m, lsum, O, rpb, hd, r, r0, step, cs, wq, start, lq, lg);
    }
#undef NA_LOAD
#undef NA_LOAD1
#undef NA_STORE
#undef NA_STORE1
    lsum += __shfl_xor(lsum, 16); lsum += __shfl_xor(lsum, 32);
    const float inv = 1.f / lsum;
#pragma unroll
    for (int dt = 0; dt < 4; ++dt) {
      const int dcol = hd * 64 + dt * 16 + lg * 4;
      bf16x4 z4 = *(const bf16x4*)(Pb + (size_t)qtok * 4096 + 3072 + dcol);
      bf16x4 o4;
#pragma unroll
      for (int e = 0; e < 4; ++e) o4[e] = (short)f2bf(O[dt][e] * inv * siluf_(bf2f((bf16_t)z4[e])));
      *(bf16x4*)(Y + (size_t)qtok * D + dcol) = o4;
    }
  }
}

DI int gdn_pos(int s, int dir) { return dir == 0 ? s : (s < CTX ? CTX - 1 - s : (TPB + CTX - 1) - s); }

DI void gdn_conv(const Params& P, bf16_t* __restrict__ Pb, const bf16_t* __restrict__ Hb) {
  for (int item = blockIdx.x; item < 272 * 24; item += gridDim.x) {
    const int tid = opaque((int)threadIdx.x), cp = tid & 63, tq = tid >> 6;
    const int tile = item / 24, slab = item % 24;
    const int ch = slab * 128 + cp * 2;
    const int tok0 = tile * 64;
    const int seg_first = ((tok0 % TPB) == 0) || ((tok0 % TPB) == CTX);
    const int seg_last = (((tok0 + 64) % TPB) == 0) || (((tok0 + 64) % TPB) == CTX);
    float v0[20], v1[20];
#pragma unroll
    for (int i = 0; i < 20; ++i) {
      const int lr = tq * 16 + i - 2;
      unsigned u = 0;
      if (lr >= 0 && lr < 64) u = *(const unsigned*)(Pb + (size_t)(tok0 + lr) * 4096 + ch);
      else if (lr < 0) { if (!seg_first) u = *(const unsigned*)(Hb + ((size_t)(tile - 1) * 4 + 2 + (lr + 2)) * 3072 + ch); }
      else { if (!seg_last) u = *(const unsigned*)(Hb + ((size_t)(tile + 1) * 4 + (lr - 64)) * 3072 + ch); }
      v0[i] = __uint_as_float(u << 16); v1[i] = __uint_as_float(u & 0xffff0000u);
    }
    float w0[5], w1[5];
#pragma unroll
    for (int j = 0; j < 5; ++j) { w0[j] = P.gdn_conv_w[j * 3072 + ch]; w1[j] = P.gdn_conv_w[j * 3072 + ch + 1]; }
    __syncthreads();
#pragma unroll
    for (int i = 0; i < 16; ++i) {
      float y0 = 0.f, y1 = 0.f;
#pragma unroll
      for (int j = 0; j < 5; ++j) { y0 += w0[j] * v0[i + j]; y1 += w1[j] * v1[i + j]; }
      y0 = siluf_(y0); y1 = siluf_(y1);
      if (slab < 16) {
        float ss = wsum(y0 * y0 + y1 * y1);
        float rn = rsqrtf(ss + 1e-6f);
        y0 *= rn; y1 *= rn;
      }
      unsigned o = (unsigned)f2bf(y0) | ((unsigned)f2bf(y1) << 16);
      *(unsigned*)(Pb + (size_t)(tok0 + tq * 16 + i) * 4096 + ch) = o;
    }
    __syncthreads();
  }
}

DI void gdn_prep(const Params& P, const bf16_t* __restrict__ Pb, const float* __restrict__ AB, bf16_t* __restrict__ Ob, int c_lo, int c_hi, int set, unsigned* ctr, unsigned char* smem) {
  bf16_t* sK = (bf16_t*)smem;
  bf16_t* sQ = sK + 64 * 136;
  bf16_t* sV = sQ + 64 * 136;
  float* sL = (float*)(sV + 64 * 136);
  float* sG = sL + 64 * 68;
  float* sBt = sG + 64;
  bf16_t* Wb = (bf16_t*)(P.ws + WS_WT + WT_G_W) + (size_t)set * 512 * 8192;
  bf16_t* Aq = (bf16_t*)(P.ws + WS_WT + (set ? WT_G_HALO : WT_G_AQK));
  float* Gc = (float*)(P.ws + WS_WT + WT_G_GC) + set * 512 * 64;
  int* s_item = (int*)(sBt + 64);
  const int nc = c_hi - c_lo;
  for (;;) {
    __syncthreads();
    if (threadIdx.x == 0) *s_item = (int)atomicAdd(ctr, 1u);
    __syncthreads();
    const int item = *s_item;
    if (item >= 64 * nc) break;
    const int tid = opaque((int)threadIdx.x), lane = tid & 63, w = tid >> 6;
    const int chain = item % 64, lc = item / 64;
    const int cidx = c_lo + lc;
    const int b = chain >> 4, hd = (chain >> 1) & 7, dir = chain & 1;
    const int slot = chain * GDN_R + lc;
    bf16_t* Ub = Ob + (((size_t)(dir * 32 + b * 8 + hd)) * TPB + cidx * 64) * 128;
    __syncthreads();
#pragma unroll
    for (int p = 0; p < 4; ++p) {
      const int e = tid + p * 256; const int row = e >> 4, kc = (e & 15) * 8;
      const int tok = b * TPB + gdn_pos(cidx * 64 + row, dir);
      const bf16_t* src = Pb + (size_t)tok * 4096 + hd * 128 + kc;
      *(uint4*)(sQ + row * 136 + kc) = *(const uint4*)(src);
      *(uint4*)(sK + row * 136 + kc) = *(const uint4*)(src + 1024);
      *(uint4*)(sV + row * 136 + kc) = *(const uint4*)(src + 2048);
    }
    if (tid < 64) {
      const int tok = b * TPB + gdn_pos(cidx * 64 + tid, dir);
      const float araw = AB[(size_t)tok * 32 + dir * 8 + hd] + P.gdn_dt_bias[dir * 8 + hd];
      const float sp = araw > 20.f ? araw : log1pf(__expf(araw));
      float gl = -__expf(P.gdn_a_log[dir * 8 + hd]) * sp;
      const float beta = sigmoidf_(AB[(size_t)tok * 32 + 16 + dir * 8 + hd]);
#pragma unroll
      for (int o = 1; o < 64; o <<= 1) { float t = __shfl_up(gl, o); if (lane >= o) gl += t; }
      sG[tid] = gl; sBt[tid] = beta; sBt[68 + tid] = beta * __expf(gl);
      Gc[slot * 64 + tid] = gl;
    }
    __syncthreads();
    {
      const int mi = w >> 1, ni = w & 1, r = lane & 31, h = lane >> 5;
      f32x16 kk, qk;
#pragma unroll
      for (int i = 0; i < 16; ++i) { kk[i] = 0.f; qk[i] = 0.f; }
#pragma unroll
      for (int ks = 0; ks < 8; ++ks) {
        bf16x8 ak = *(const bf16x8*)(sK + (mi * 32 + r) * 136 + ks * 16 + h * 8);
        bf16x8 aq = *(const bf16x8*)(sQ + (mi * 32 + r) * 136 + ks * 16 + h * 8);
        bf16x8 bk = *(const bf16x8*)(sK + (ni * 32 + r) * 136 + ks * 16 + h * 8);
        kk = __builtin_amdgcn_mfma_f32_32x32x16_bf16(ak, bk, kk, 0, 0, 0);
        qk = __builtin_amdgcn_mfma_f32_32x32x16_bf16(aq, bk, qk, 0, 0, 0);
      }
      const int col = ni * 32 + r;
      const float gcol = sG[col];
#pragma unroll
      for (int i = 0; i < 16; ++i) {
        const int row = mi * 32 + crow(i, h);
        const float grow = sG[row];
        const float dec = (col <= row) ? __expf(grow - gcol) : 0.f;
        sL[row * 68 + col] = (col < row) ? sBt[row] * kk[i] * dec : 0.f;
        Aq[((size_t)slot * 64 + row) * 64 + col] = f2bf(0.08838834764831845f * qk[i] * dec);
      }
    }
    __syncthreads();
    {
      float x[64];
#pragma unroll
      for (int i = 0; i < 64; ++i) x[i] = 0.f;
      const bool isv = tid < 128;
      const bf16_t* srcm = isv ? (sV + tid) : (sK + (tid - 128));
      const float* scl = isv ? sBt : (sBt + 68);
#pragma unroll
      for (int rr = 0; rr < 64; rr += 2) {
        const int ro0 = opaque(rr * 68);
        float a0 = bf2f(srcm[rr * 136]) * scl[rr];
        float a1 = bf2f(srcm[(rr + 1) * 136]) * scl[rr + 1];
        float l10 = 0.f;
#pragma unroll
        for (int c4 = 0; c4 < (rr + 4) / 4; ++c4) {
          const float4 p4 = *(const float4*)(sL + ro0 + c4 * 4);
          const float4 q4 = *(const float4*)(sL + ro0 + 68 + c4 * 4);
          a0 -= p4.x * x[c4 * 4 + 0]; a0 -= p4.y * x[c4 * 4 + 1]; a0 -= p4.z * x[c4 * 4 + 2]; a0 -= p4.w * x[c4 * 4 + 3];
          a1 -= q4.x * x[c4 * 4 + 0]; a1 -= q4.y * x[c4 * 4 + 1]; a1 -= q4.z * x[c4 * 4 + 2]; a1 -= q4.w * x[c4 * 4 + 3];
          if (c4 == rr / 4) l10 = ((rr & 3) == 0) ? q4.x : (((rr & 3) == 2) ? q4.z : 0.f);
        }
        a1 -= l10 * a0;
        asm volatile("" : "+v"(a0), "+v"(a1) :: "memory");
        x[rr] = a0; x[rr + 1] = a1;
      }
      bf16_t* dst = isv ? (Ub + tid) : (Wb + (size_t)slot * 64 * 128 + (tid - 128));
#pragma unroll
      for (int rr = 0; rr < 64; ++rr) dst[rr * 128] = f2bf(x[rr]);
    }
  }
}

struct ChainRegs { bf16x8 a1[8]; bf16x8 aq[4]; uint4 kt[4]; float g; };
DI void chain_load(ChainRegs& R, const bf16_t* __restrict__ Pb, const bf16_t* __restrict__ Wb, const bf16_t* __restrict__ Ub,
                   const bf16_t* __restrict__ Aq, const float* __restrict__ Gc, int slot, int cidx, int b, int hd, int dir, int dvb,
                   int tid, int w, int r, int h) {
  const int strip = w & 1;
  const bf16_t* arow;
  if (w < 2) arow = Wb + ((size_t)slot * 64 + strip * 32 + r) * 128;
  else { const int tok = b * TPB + gdn_pos(cidx * 64 + strip * 32 + r, dir); arow = Pb + (size_t)tok * 4096 + hd * 128; }
#pragma unroll
  for (int ks = 0; ks < 8; ++ks) R.a1[ks] = *(const bf16x8*)(arow + ks * 16 + h * 8);
  if (w < 2) {
    const bf16_t* ub = Ub + (((size_t)(dir * 32 + b * 8 + hd)) * TPB + cidx * 64) * 128 + dvb * 32 + r;
#pragma unroll
    for (int i = 0; i < 16; ++i) R.aq[i >> 3][i & 7] = (short)ub[(strip * 32 + crow(i, h)) * 128];
  } else {
    const bf16_t* aqrow = Aq + ((size_t)slot * 64 + strip * 32 + r) * 64;
#pragma unroll
    for (int ks = 0; ks < 4; ++ks) R.aq[ks] = *(const bf16x8*)(aqrow + ks * 16 + h * 8);
  }
  R.g = (tid < 64) ? Gc[slot * 64 + tid] : 0.f;
}
DI void chain_load_k(ChainRegs& R, const bf16_t* __restrict__ Pb, int cidx, int b, int hd, int dir, int tid) {
#pragma unroll
  for (int p = 0; p < 4; ++p) {
    const int e = tid + p * 256; const int row = e >> 4, kc = (e & 15) * 8;
    const int tok = b * TPB + gdn_pos(cidx * 64 + row, dir);
    R.kt[p] = *(const uint4*)(Pb + (size_t)tok * 4096 + 1024 + hd * 128 + kc);
  }
}
DI void gdn_chain(const Params& P, const bf16_t* __restrict__ Pb, bf16_t* Ob, int c_lo, int c_hi, int set, unsigned char* smem, bool save = true) {
  if (blockIdx.x >= 256) return;
  bf16_t* sSt = (bf16_t*)smem;
  bf16_t* sVn = sSt + 32 * 136;
  bf16_t* sVd = sVn + 32 * 72;
  bf16_t* sKt = sVd + 32 * 72;
  float* sG = (float*)(sKt + 64 * 136);
  const bf16_t* Wb = (const bf16_t*)(P.ws + WS_WT + WT_G_W) + (size_t)set * 512 * 8192;
  const bf16_t* Ub = Ob;
  const bf16_t* Aq = (const bf16_t*)(P.ws + WS_WT + (set ? WT_G_HALO : WT_G_AQK));
  const float* Gc = (const float*)(P.ws + WS_WT + WT_G_GC) + set * 512 * 64;
  float* Sst = (float*)(P.ws + WS_SST);
  const int tid = opaque((int)threadIdx.x), lane = tid & 63, w = tid >> 6, r = lane & 31, h = lane >> 5;
  const int chain = blockIdx.x >> 2, dvb = blockIdx.x & 3;
  const int b = chain >> 4, hd = (chain >> 1) & 7, dir = chain & 1;
  const int strip = w & 1;
  f32x16 S;
  if (c_lo == 0) {
#pragma unroll
    for (int i = 0; i < 16; ++i) S[i] = 0.f;
  } else {
#pragma unroll
    for (int i = 0; i < 16; ++i) S[i] = Sst[((size_t)blockIdx.x * 16 + i) * 256 + tid];
  }
  ChainRegs cur, nxt;
  chain_load(cur, Pb, Wb, Ub, Aq, Gc, chain * GDN_R, c_lo, b, hd, dir, dvb, tid, w, r, h);
  chain_load_k(cur, Pb, c_lo, b, hd, dir, tid);
  nxt = cur;
  const int tid0 = tid;
  for (int cidx = c_lo; cidx < c_hi; ++cidx) {
    const int tid = opaque(tid0), lane = tid & 63, w = tid >> 6, r = lane & 31, h = lane >> 5, strip = w & 1;
    const int slot = chain * GDN_R + (cidx - c_lo);
    __syncthreads();
#pragma unroll
    for (int q = 0; q < 4; ++q) {
      bf16x4 v;
#pragma unroll
      for (int e = 0; e < 4; ++e) v[e] = (short)f2bf(S[q * 4 + e]);
      *(bf16x4*)(sSt + r * 136 + w * 32 + 8 * q + 4 * h) = v;
    }
    if (tid < 64) {
      const float g63w = __shfl(cur.g, 63);
      sG[tid] = __expf(g63w - cur.g);
      sG[64 + tid] = 0.08838834764831845f * __expf(cur.g);
      if (tid == 63) sG[128] = __expf(cur.g);
    }
#pragma unroll
    for (int p = 0; p < 4; ++p) {
      const int e = tid + p * 256; const int row = e >> 4, kc = (e & 15) * 8;
      *(uint4*)(sKt + row * 136 + kc) = cur.kt[p];
    }
    if (cidx + 1 < c_hi) chain_load(nxt, Pb, Wb, Ub, Aq, Gc, slot + 1, cidx + 1, b, hd, dir, dvb, tid, w, r, h);
    __syncthreads();
    f32x16 acc1, acc1b;
#pragma unroll
    for (int i = 0; i < 16; ++i) { acc1[i] = 0.f; acc1b[i] = 0.f; }
#pragma unroll
    for (int ks = 0; ks < 8; ks += 2) {
      bf16x8 bfr0 = *(const bf16x8*)(sSt + r * 136 + ks * 16 + h * 8);
      bf16x8 bfr1 = *(const bf16x8*)(sSt + r * 136 + (ks + 1) * 16 + h * 8);
      acc1 = __builtin_amdgcn_mfma_f32_32x32x16_bf16(cur.a1[ks], bfr0, acc1, 0, 0, 0);
      acc1b = __builtin_amdgcn_mfma_f32_32x32x16_bf16(cur.a1[ks + 1], bfr1, acc1b, 0, 0, 0);
    }
#pragma unroll
    for (int i = 0; i < 16; ++i) acc1[i] += acc1b[i];
    if (w < 2) {
#pragma unroll
      for (int q = 0; q < 4; ++q) {
        bf16x4 vn, vd;
#pragma unroll
        for (int e = 0; e < 4; ++e) {
          const int row = strip * 32 + 8 * q + 4 * h + e;
          const float v = bf2f((bf16_t)cur.aq[(q * 4 + e) >> 3][(q * 4 + e) & 7]) - acc1[q * 4 + e];
          vn[e] = (short)f2bf(v);
          vd[e] = (short)f2bf(v * sG[row]);
        }
        *(bf16x4*)(sVn + r * 72 + strip * 32 + 8 * q + 4 * h) = vn;
        *(bf16x4*)(sVd + r * 72 + strip * 32 + 8 * q + 4 * h) = vd;
      }
    }
    __syncthreads();
    if (cidx + 1 < c_hi) chain_load_k(nxt, Pb, cidx + 1, b, hd, dir, tid);
    if (w >= 2) {
      f32x16 av;
#pragma unroll
      for (int i = 0; i < 16; ++i) av[i] = 0.f;
#pragma unroll
      for (int ks = 0; ks < 4; ++ks) {
        bf16x8 bfr = *(const bf16x8*)(sVn + r * 72 + ks * 16 + h * 8);
        av = __builtin_amdgcn_mfma_f32_32x32x16_bf16(cur.aq[ks], bfr, av, 0, 0, 0);
      }
      bf16_t* ob = Ob + (((size_t)(dir * 32 + b * 8 + hd)) * TPB + cidx * 64) * 128 + dvb * 32 + r;
#pragma unroll
      for (int i = 0; i < 16; ++i) {
        const int row = strip * 32 + crow(i, h);
        const float o = sG[64 + row] * acc1[i] + av[i];
        ob[(size_t)row * 128] = f2bf(o);
      }
    }
    {
      const float eg = sG[128];
      f32x16 d0, d1;
#pragma unroll
      for (int i = 0; i < 16; ++i) { d0[i] = 0.f; d1[i] = 0.f; }
#pragma unroll
      for (int ks = 0; ks < 4; ++ks) {
        bf16x8 af;
#pragma unroll
        for (int j = 0; j < 8; ++j) af[j] = (short)sKt[(ks * 16 + h * 8 + j) * 136 + w * 32 + r];
        bf16x8 bfr = *(const bf16x8*)(sVd + r * 72 + ks * 16 + h * 8);
        if (ks & 1) d1 = __builtin_amdgcn_mfma_f32_32x32x16_bf16(af, bfr, d1, 0, 0, 0);
        else d0 = __builtin_amdgcn_mfma_f32_32x32x16_bf16(af, bfr, d0, 0, 0, 0);
      }
#pragma unroll
      for (int i = 0; i < 16; ++i) S[i] = S[i] * eg + (d0[i] + d1[i]);
    }
    cur = nxt;
  }
  if (save) {
#pragma unroll
    for (int i = 0; i < 16; ++i) Sst[((size_t)blockIdx.x * 16 + i) * 256 + tid] = S[i];
  }
}

DI void gdn_post(const Params& P, const bf16_t* Pb, const bf16_t* __restrict__ Ob, bf16_t* Y, int ldy) {
  const int gw = blockIdx.x * 4 + (opaque((int)threadIdx.x) >> 6), nw = gridDim.x * 4;
  for (int tok = gw; tok < NT; tok += nw) {
    const int lane = opaque((int)threadIdx.x) & 63;
    const float g0 = P.gdn_norm_g[lane * 2], g1 = P.gdn_norm_g[lane * 2 + 1];
    const int b = tok / TPB, pos = tok % TPB;
    const int sf = pos, sr = pos < CTX ? CTX - 1 - pos : (TPB + CTX - 1) - pos;
#pragma unroll
    for (int hd = 0; hd < 8; ++hd) {
      const unsigned uf = *(const unsigned*)(Ob + (((size_t)(0 * 32 + b * 8 + hd)) * TPB + sf) * 128 + lane * 2);
      const unsigned ur = *(const unsigned*)(Ob + (((size_t)(1 * 32 + b * 8 + hd)) * TPB + sr) * 128 + lane * 2);
      float o0 = __uint_as_float(uf << 16) + __uint_as_float(ur << 16);
      float o1 = __uint_as_float(uf & 0xffff0000u) + __uint_as_float(ur & 0xffff0000u);
      const float ss = wsum(o0 * o0 + o1 * o1);
      const float rstd = rsqrtf(ss * (1.f / 128.f) + 1e-6f);
      const unsigned uz = *(const unsigned*)(Pb + (size_t)tok * 4096 + 3072 + hd * 128 + lane * 2);
      const float z0 = __uint_as_float(uz << 16), z1 = __uint_as_float(uz & 0xffff0000u);
      const float y0 = o0 * rstd * g0 * siluf_(z0), y1 = o1 * rstd * g1 * siluf_(z1);
      *(unsigned*)(Y + (size_t)tok * ldy + hd * 128 + lane * 2) = (unsigned)f2bf(y0) | ((unsigned)f2bf(y1) << 16);
    }
  }
}

#ifndef DUP_MASK
#define DUP_MASK 0
#endif
#define NREP(cat) (((DUP_MASK >> (cat)) & 1) ? 2 : 1)
constexpr int PH_S5 = 6;
constexpr int PH_GDN = 5 + GDN_ROUNDS;
constexpr int PH_NA = 3;
constexpr int L0_BASE = 3;
constexpr int E1_PH = L0_BASE + PH_S5;
constexpr int L1_BASE = E1_PH + 1;
constexpr int E2_PH = L1_BASE + PH_GDN;
constexpr int L2_BASE = E2_PH + 1;
constexpr int E3_PH = L2_BASE + PH_NA;
constexpr int PB3_PH = E3_PH + 1;
constexpr int L3_BASE = PB3_PH + 1;
constexpr int E4_PH = L3_BASE + PH_S5;
constexpr int NPHASES = E4_PH + 1;

DI void s5_layer_phase(const Params& P, int j, int sub, unsigned char* smem) {
  unsigned char* big = P.ws + WS_BIG;
  bf16_t* Pb = (bf16_t*)(big);
  bf16_t* A = (bf16_t*)(big + 5 * UNIT);
  float* Sloc = (float*)(big + 2 * UNIT);
  bf16_t* Sin = (bf16_t*)(big + 4 * UNIT);
  bf16_t* Y1 = (bf16_t*)(big + 5 * UNIT);
  bf16_t* Y2 = (bf16_t*)(big + 2 * UNIT);
  float* O = (float*)(big + 3 * UNIT);
  unsigned char* wt = P.ws + WS_WT;
  switch (sub) {
    case 0: {
      for (int rep_ = 0; rep_ < NREP(6); ++rep_) s5_pre_c(P, j);
      Gemm g = gemm_plain(A, (const bf16_t*)(wt + WT_S5_IN), NT, 2048, 1024, EPI_BF16, Pb, 2048);
      for (int rep_ = 0; rep_ < NREP(0); ++rep_) gemm_phase(g, smem);
    } break;
    case 1: {
      Gemm g{};
      g.A = Pb; g.a_rs = 16 * 2048; g.a_kbs = 2048; g.a_bs = 16; g.A2 = Pb; g.a2_rs = g.a_rs; g.a2_kbs = g.a_kbs; g.a2_bs = 16; g.K1 = 256;
      g.Bt = (const bf16_t*)(wt + WT_S5_BPT); g.b_bs = 256 * 256; g.M = 1088; g.N = 256; g.K = 256; g.batch = 64; g.epi = EPI_F32;
      g.C = Sloc; g.ldc = 256; g.c_bs = 1088 * 256;
      for (int rep_ = 0; rep_ < NREP(0); ++rep_) gemm_phase(g, smem);
    } break;
    case 2: for (int rep_ = 0; rep_ < NREP(3); ++rep_) s5_carry(P, Sloc, Sin); break;
    case 3: {
      Gemm g{};
      g.A = Pb; g.a_rs = 16 * 2048; g.a_kbs = 2048; g.a_bs = 16; g.K1 = 256;
      g.A2 = Sin; g.a2_rs = 256; g.a2_kbs = 16; g.a2_bs = 1088 * 256;
      g.Bt = (const bf16_t*)(wt + WT_S5_OPT); g.b_bs = 256 * 512; g.M = 1088; g.N = 256; g.K = 512; g.batch = 64; g.epi = EPI_S5Y;
      g.C = Y1;
      for (int rep_ = 0; rep_ < NREP(0); ++rep_) gemm_phase(g, smem);
    } break;
    case 4: {
      Gemm g = gemm_plain(Y1, (const bf16_t*)(wt + WT_S5_GLU), NT, 2048, 1024, EPI_GLU, Y2, 1024);
      g.zsrc = Pb; g.bias = P.s5_glu_b + j * 2048;
      for (int rep_ = 0; rep_ < NREP(0); ++rep_) gemm_phase(g, smem);
    } break;
    case 5: {
      Gemm g = gemm_plain(Y2, (const bf16_t*)(wt + WT_S5_OUT), NT, 1024, 1024, EPI_F32, O, 1024);
      for (int rep_ = 0; rep_ < NREP(0); ++rep_) gemm_phase(g, smem);
    } break;
    default: break;
  }
}
DI void s5_convert(const Params& P, int j, float* lds) {
  unsigned char* wt = P.ws + WS_WT;
  convert_wt(P.s5_in_w + (size_t)j * 1024 * 2048, 1024, 2048, 2048, (bf16_t*)(wt + WT_S5_IN), 0, lds);
  convert_wt(P.s5_glu_w + (size_t)j * 1024 * 2048, 1024, 2048, 2048, (bf16_t*)(wt + WT_S5_GLU), 1, lds);
  convert_wt(P.s5_out_w + (size_t)j * 1024 * 1024, 1024, 1024, 1024, (bf16_t*)(wt + WT_S5_OUT), 0, lds);
}

DI void run_phase(const Params& P, int ph, unsigned char* smem) {
  unsigned char* big = P.ws + WS_BIG;
  unsigned char* wt = P.ws + WS_WT;
  float* lds = (float*)smem;
  if (ph == 0) { for (int rep_ = 0; rep_ < NREP(6); ++rep_) { adaln_phase(P, lds); s5_convert(P, 0, lds); s5_pre_a(P, 0); } return; }
  if (ph == 1) { for (int rep_ = 0; rep_ < NREP(6); ++rep_) { adaln_reduce(P); s5_pre_b(P, 0); } return; }
  if (ph == 2) { ew_phase(P, -1, 0, nullptr, (bf16_t*)(big + 5 * UNIT)); return; }
  if (ph >= L0_BASE && ph < E1_PH) { s5_layer_phase(P, 0, ph - L0_BASE, smem); return; }
  if (ph == E1_PH) {
    ew_phase(P, 0, 1, (const float*)(big + 3 * UNIT), (bf16_t*)(big + 5 * UNIT));
    for (int rep_ = 0; rep_ < NREP(6); ++rep_) {
    convert_wt(P.gdn_in_w, 1024, 4128, 4352, (bf16_t*)(wt + WT_G_IN), 0, lds);
    convert_wt(P.gdn_out_w, 1024, 1024, 1024, (bf16_t*)(wt + WT_G_OUT), 0, lds); }
    return;
  }
  if (ph >= L1_BASE && ph < E2_PH) {
    const int sub = ph - L1_BASE;
    bf16_t* Pb = (bf16_t*)big;
    bf16_t* A = (bf16_t*)(big + 5 * UNIT);
    bf16_t* Ob = (bf16_t*)(big + 4 * UNIT);
    float* AB = (float*)(P.ws + WS_AB);
    bf16_t* Hb = (bf16_t*)(wt + WT_G_HALO);
    if (sub == 0) {
      Gemm g = gemm_plain(A, (const bf16_t*)(wt + WT_G_IN), NT, 4352, 1024, EPI_GDNIN, Pb, 4096);
      g.C2 = AB; g.C3 = Hb;
      gemm_phase_wide(g, smem);
    } else if (sub == 1) {
      gdn_conv(P, Pb, Hb);
    } else if (sub < 3 + GDN_ROUNDS) {
      unsigned* ctr = (unsigned*)(P.ws + WS_BAR) + XCD_BAR_WORDS;
      const int rd = sub - 3;
      if (rd >= 0) { const int c_lo = rd * GDN_R, c_hi = imin(GDN_NCH, c_lo + GDN_R); gdn_chain(P, Pb, Ob, c_lo, c_hi, rd & 1, smem); }
      const int pr = rd + 1;
      if (pr < GDN_ROUNDS) { const int c_lo = pr * GDN_R, c_hi = imin(GDN_NCH, c_lo + GDN_R); gdn_prep(P, Pb, AB, Ob, c_lo, c_hi, pr & 1, ctr + pr * 16, smem); }
    } else if (sub == 3 + GDN_ROUNDS) {
      for (int rep_ = 0; rep_ < NREP(6); ++rep_) gdn_post(P, Pb, Ob, Pb, 4096);
    } else {
      Gemm g = gemm_plain(Pb, (const bf16_t*)(wt + WT_G_OUT), NT, 1024, 1024, EPI_F32, (float*)(big + 4 * UNIT), 1024);
      g.a_rs = 4096; g.a2_rs = 4096;
      for (int rep_ = 0; rep_ < NREP(0); ++rep_) gemm_phase(g, smem);
    }
    return;
  }
  if (ph == E2_PH) {
    ew_phase(P, 1, 2, (const float*)(big + 4 * UNIT), (bf16_t*)(big));
    for (int rep_ = 0; rep_ < NREP(6); ++rep_) {
    convert_wt(P.na_in_w, 1024, 4096, 4096, (bf16_t*)(wt + WT_N_IN), 0, lds);
    convert_wt(P.na_out_w, 1024, 1024, 1024, (bf16_t*)(wt + WT_N_OUT), 0, lds); }
    return;
  }
  if (ph >= L2_BASE && ph < E3_PH) {
    const int sub = ph - L2_BASE;
    bf16_t* A = (bf16_t*)big;
    bf16_t* Pb = (bf16_t*)(big + 1 * UNIT);
    bf16_t* Vt = (bf16_t*)(big + 5 * UNIT);
    bf16_t* Y1 = (bf16_t*)big;
    float* O = (float*)(big + 1 * UNIT);
    if (sub == 0) {
      Gemm g = gemm_plain(A, (const bf16_t*)(wt + WT_N_IN), NT, 4096, 1024, EPI_NAIN, Pb, 4096);
      g.C2 = Vt;
      gemm_phase_wide(g, smem);
    } else if (sub == 1) {
      for (int rep_ = 0; rep_ < NREP(1); ++rep_) na_attn(P, Pb, Vt, Y1, smem);
    } else {
      Gemm g = gemm_plain(Y1, (const bf16_t*)(wt + WT_N_OUT), NT, 1024, 1024, EPI_F32, O, 1024);
      for (int rep_ = 0; rep_ < NREP(0); ++rep_) gemm_phase(g, smem);
    }
    return;
  }
  if (ph == E3_PH) {
    ew_phase(P, 2, 3, (const float*)(big + 1 * UNIT), (bf16_t*)(big + 5 * UNIT));
    for (int rep_ = 0; rep_ < NREP(6); ++rep_) { s5_convert(P, 1, lds); s5_pre_a(P, 1); }
    return;
  }
  if (ph == PB3_PH) { for (int rep_ = 0; rep_ < NREP(6); ++rep_) s5_pre_b(P, 1); return; }
  if (ph >= L3_BASE && ph < E4_PH) { s5_layer_phase(P, 1, ph - L3_BASE, smem); return; }
  if (ph == E4_PH) { ew_phase(P, 3, -1, (const float*)(big + 3 * UNIT), nullptr); return; }
}

#ifndef NO_MEGA
__global__ void __launch_bounds__(NTHREADS, 2) mega(Params P) {
  extern __shared__ __attribute__((aligned(16))) unsigned char smem[];
  __shared__ uint4 xb_words;
  cg::grid_group grid = cg::this_grid();
  if (threadIdx.x == 0) xb_words = make_uint4(0u, 0u, 0u, 0u);
  __syncthreads();
  XcdBarrier xb = xcd_barrier_post((unsigned*)(P.ws + WS_BAR), (volatile LAS unsigned*)&xb_words);
  if (P.ph_lo < 0) grid.sync();
  for (int ph = P.ph_lo; ph < P.ph_hi; ++ph) {
    run_phase(P, ph, smem);
    if (ph + 1 < P.ph_hi) { xcd_barrier(xb); if (DUP_MASK & 32) xcd_barrier(xb); }
  }
}

#ifndef MULTI_LAUNCH
#define MULTI_LAUNCH 0
#endif

extern "C" void kernel_launch(void* const* d_in, const int* in_sizes, int n_in, void* d_out, int out_size, void* d_ws, size_t ws_size, hipStream_t stream) {
  static int grid_blocks = 0;
  if (!grid_blocks) {
    int dev = 0, cus = 0, per_cu = 0;
    hipGetDevice(&dev);
    hipDeviceGetAttribute(&cus, hipDeviceAttributeMultiprocessorCount, dev);
    hipFuncSetAttribute((const void*)mega, hipFuncAttributeMaxDynamicSharedMemorySize, GEMM_LDS_BYTES);
    hipOccupancyMaxActiveBlocksPerMultiprocessor(&per_cu, (const void*)mega, NTHREADS, GEMM_LDS_BYTES);
    if (per_cu > 2) per_cu = 2;
    if (per_cu < 1) per_cu = 1;
    grid_blocks = cus * per_cu;
    if (ws_size < WS_END) fprintf(stderr, "kernel_launch: workspace too small: %zu < %zu\n", ws_size, (size_t)WS_END);
  }
  Params p{};
  const float** f = (const float**)&p;
  for (int i = 0; i < 29; ++i) f[i] = (const float*)d_in[i];
  p.out = (float*)d_out; p.ws = (unsigned char*)d_ws;
#if MULTI_LAUNCH
  for (int ph = 0; ph < NPHASES; ++ph) {
    p.ph_lo = ph; p.ph_hi = ph + 1;
    hipLaunchKernelGGL(mega, dim3(grid_blocks), dim3(NTHREADS), GEMM_LDS_BYTES, stream, p);
  }
#else
  p.ph_lo = 0; p.ph_hi = NPHASES;
  hipMemsetAsync((unsigned char*)d_ws + WS_BAR, 0, 16384, stream);
  void* args[] = {&p};
  hipError_t e = hipLaunchCooperativeKernel((const void*)mega, dim3(grid_blocks), dim3(NTHREADS), args, GEMM_LDS_BYTES, stream);
  if (e != hipSuccess) fprintf(stderr, "cooperative launch failed: %s (grid %d)\n", hipGetErrorString(e), grid_blocks);
#endif
}
#endif
```

```cpp
#include <hip/hip_runtime.h>
#include <hip/hip_cooperative_groups.h>
#include <cstdio>
namespace cg = cooperative_groups;

typedef unsigned short bf16_t;
typedef __attribute__((ext_vector_type(8))) short bf16x8;
typedef __attribute__((ext_vector_type(4))) short bf16x4;
typedef __attribute__((ext_vector_type(16))) float f32x16;
typedef __attribute__((ext_vector_type(4))) float f32x4;
#define DI __device__ __forceinline__
typedef __attribute__((address_space(3))) unsigned lds_u32;

constexpr int D = 1024;
constexpr int NB = 4;
constexpr int SEQ = 4096;
constexpr int CTX = 256;
constexpr int TPB = SEQ + CTX;
constexpr int NT = NB * TPB;
constexpr int NTHREADS = 256;
constexpr int GDN_R = 8;
constexpr int GDN_NCH = 68;
constexpr int GDN_ROUNDS = (GDN_NCH + GDN_R - 1) / GDN_R;

constexpr size_t MiB = 1024 * 1024;
constexpr size_t UNIT = (size_t)NT * 1024 * 2;
constexpr size_t WS_MOD = 0;
constexpr size_t WS_BAR = 245760;
constexpr size_t WS_HCTX = 262144;
constexpr size_t WS_AB = WS_HCTX + 4 * MiB;
constexpr size_t WS_SST = WS_AB + (size_t)NT * 32 * 4;
constexpr size_t WS_WT = WS_SST + 4 * MiB;
constexpr size_t WT_S5_IN = 0;
constexpr size_t WT_S5_GLU = WT_S5_IN + 4 * MiB;
constexpr size_t WT_S5_OUT = WT_S5_GLU + 4 * MiB;
constexpr size_t WT_S5_APOW = WT_S5_OUT + 2 * MiB;
constexpr size_t WT_S5_BBAR = WT_S5_APOW + 2 * 64 * 17 * 64 * 8;
constexpr size_t WT_S5_KTAB = WT_S5_BBAR + 2 * 64 * 64 * 16 * 8;
constexpr size_t WT_S5_OPT = WT_S5_KTAB + 2 * 64 * 16 * 256 * 4;
constexpr size_t WT_S5_BPT = WT_S5_OPT + (size_t)64 * 256 * 512 * 2;
constexpr size_t WT_S5_END = WT_S5_BPT + (size_t)64 * 256 * 256 * 2;
constexpr size_t WT_G_IN = 0;
constexpr size_t WT_G_OUT = WT_G_IN + (size_t)4224 * 1024 * 2;
constexpr size_t WT_G_HALO = WT_G_OUT + 2 * MiB;
constexpr size_t WT_G_W = WT_G_HALO + (size_t)272 * 4 * 3072 * 2;
constexpr size_t WT_G_AQK = WT_G_W + (size_t)2 * 64 * GDN_R * 64 * 128 * 2;
constexpr size_t WT_G_GC = WT_G_AQK + (size_t)64 * GDN_R * 64 * 64 * 2;
constexpr size_t WT_G_END = WT_G_GC + (size_t)2 * 64 * GDN_R * 64 * 4;
static_assert((size_t)64 * GDN_R * 64 * 64 * 2 <= (size_t)272 * 4 * 3072 * 2, "Aqk set 1 must fit the halo region");
constexpr size_t WT_N_IN = 0;
constexpr size_t WT_N_OUT = 8 * MiB;
constexpr size_t WT_SIZE = (WT_S5_END > WT_G_END ? WT_S5_END : WT_G_END);
constexpr size_t WS_BIG = (WS_WT + WT_SIZE + 255) / 256 * 256;
constexpr size_t WS_END = WS_BIG + 6 * UNIT;
static_assert(WS_END <= 256 * MiB, "workspace too large");

struct Params {
  const float *x, *c, *ctx, *c_ctx, *ada_w, *ada_b, *pre_g, *post_g;
  const float *s5_in_w, *s5_lam_re, *s5_lam_im, *s5_log_dt, *s5_b_re, *s5_b_im, *s5_c_re, *s5_c_im, *s5_d, *s5_glu_w, *s5_glu_b, *s5_out_w;
  const float *gdn_in_w, *gdn_conv_w, *gdn_a_log, *gdn_dt_bias, *gdn_norm_g, *gdn_out_w;
  const float *na_in_w, *na_rpb, *na_out_w;
  float* out;
  unsigned char* ws;
  int ph_lo, ph_hi;
};

DI bf16_t f2bf(float x) { return __builtin_bit_cast(unsigned short, (__bf16)x); }
DI float bf2f(bf16_t b) { return __uint_as_float(((unsigned)b) << 16); }
DI float wsum(float v) {
#pragma unroll
  for (int o = 32; o > 0; o >>= 1) v += __shfl_xor(v, o);
  return v;
}
DI float sigmoidf_(float x) { return __builtin_amdgcn_rcpf(1.f + __expf(-x)); }
DI float siluf_(float x) { return x * __builtin_amdgcn_rcpf(1.f + __expf(-x)); }
DI float geluf_(float x) { float u = 1.5957691216057308f * (x + 0.044715f * x * x * x); return x * __builtin_amdgcn_rcpf(1.f + __expf(-u)); }
DI int crow(int i, int h) { return (i & 3) + 8 * (i >> 2) + 4 * h; }
DI void lds_barrier() { asm volatile("s_waitcnt lgkmcnt(0)" ::: "memory"); __builtin_amdgcn_s_barrier(); asm volatile("" ::: "memory"); }
DI int opaque(int v) { asm volatile("" : "+v"(v)); return v; }
DI int imin(int a, int b) { return a < b ? a : b; }
DI int imax(int a, int b) { return a > b ? a : b; }


#define XB_TMO      128
#define XB_XCNT(j)  (256  + 64 * (j))
#define XB_XSUB(j)  (1280 + 64 * (j))
#define XB_XGEN(j)  (2304 + 64 * (j))
#define XB_TOP      3328
#define XB_TOPGEN   3392
#define XCD_BAR_WORDS 3456
#define XB_SPIN_CAP (1u << 18)
#define LAS __attribute__((address_space(3)))
DI unsigned xb_ld(unsigned* p)              { return __hip_atomic_load(p, __ATOMIC_RELAXED, __HIP_MEMORY_SCOPE_AGENT); }
DI unsigned xb_add(unsigned* p, unsigned v) { return __hip_atomic_fetch_add(p, v, __ATOMIC_RELAXED, __HIP_MEMORY_SCOPE_AGENT); }
DI unsigned xb_xcc_id() { return (unsigned)__builtin_amdgcn_s_getreg((3 << 11) | 20) & 0xFu; }
#define XB_SPIN(cond, bar) do { unsigned _sp = 0; while (cond) { __builtin_amdgcn_s_sleep(1); \
    if ((++_sp & 255u) == 0u) { if (xb_ld(&(bar)[XB_TMO])) break; if (_sp > XB_SPIN_CAP) { atomicAdd(&(bar)[XB_TMO], 1u); break; } } } } while (0)
struct XcdBarrier { unsigned* bar; unsigned x; volatile LAS unsigned* st; };
DI XcdBarrier xcd_barrier_post(unsigned* bar, volatile LAS unsigned* st) {
  XcdBarrier b; b.bar = bar; b.x = xb_xcc_id(); b.st = st;
  if (threadIdx.x == 0) (void)xb_add(&bar[XB_XCNT(b.x)], 1u);
  return b;
}
DI void xcd_barrier_complete(unsigned* bar, unsigned x, unsigned& nloc, unsigned& nx) {
  const unsigned G = gridDim.x * gridDim.y * gridDim.z;
  unsigned sum, cnt, mine, sp = 0u;
  for (;;) {
    sum = 0u; cnt = 0u; mine = 0u;
#pragma unroll
    for (unsigned j = 0; j < 16; ++j) { const unsigned c = xb_ld(&bar[XB_XCNT(j)]); sum += c; cnt += (c > 0u) ? 1u : 0u; mine = (j == x) ? c : mine; }
    if (sum == G) break;
    __builtin_amdgcn_s_sleep(1);
    if ((++sp & 255u) == 0u) { if (xb_ld(&bar[XB_TMO])) break; if (sp > XB_SPIN_CAP) { atomicAdd(&bar[XB_TMO], 1u); break; } }
  }
  nloc = mine > 0u ? mine : 1u; nx = cnt > 0u ? cnt : 1u;
}
DI void xcd_barrier(const XcdBarrier& b) {
  asm volatile("s_waitcnt vmcnt(0)" ::: "memory");
  __syncthreads();
  if (threadIdx.x == 0) {
    unsigned* bar = b.bar;
    __builtin_amdgcn_s_waitcnt(0);
    unsigned nloc = b.st[0], nx = b.st[1];
    if (nloc == 0u) { xcd_barrier_complete(bar, b.x, nloc, nx); b.st[0] = nloc; b.st[1] = nx; }
    const unsigned old = xb_add(&bar[XB_XSUB(b.x)], 1u);
    const unsigned gen = old / nloc;
    if (old + 1u == (gen + 1u) * nloc) {
      __builtin_amdgcn_fence(__ATOMIC_RELEASE, "agent");
      asm volatile("s_waitcnt vmcnt(0)" ::: "memory");
      const unsigned og = xb_add(&bar[XB_TOP], 1u);
      const unsigned tg = og / nx;
      if (og + 1u == (tg + 1u) * nx) xb_add(&bar[XB_TOPGEN], 1u);
      else XB_SPIN(xb_ld(&bar[XB_TOPGEN]) == tg, bar);
      __builtin_amdgcn_fence(__ATOMIC_ACQUIRE, "agent");
      xb_add(&bar[XB_XGEN(b.x)], 1u);
      asm volatile("s_waitcnt vmcnt(0)" ::: "memory");
    } else {
      XB_SPIN(xb_ld(&bar[XB_XGEN(b.x)]) == gen, bar);
      __builtin_amdgcn_fence(__ATOMIC_ACQUIRE, "agent");
      asm volatile("s_waitcnt vmcnt(0)" ::: "memory");
    }
  }
  __syncthreads();
}

DI void convert_wt(const float* __restrict__ W, int K, int N, int Npad, bf16_t* __restrict__ Wt, int mode, float* lds) {
  const int tk = K / 64, tn = Npad / 64;
  for (int t = blockIdx.x; t < tk * tn; t += gridDim.x) {
    const int tid = opaque((int)threadIdx.x);
    const int k0 = (t % tk) * 64, n0 = (t / tk) * 64;
    __syncthreads();
#pragma unroll
    for (int p = 0; p < 16; ++p) {
      int e = tid + p * 256; int kk = e >> 6, nn = e & 63;
      float v = (n0 + nn < N) ? W[(size_t)(k0 + kk) * N + n0 + nn] : 0.f;
      lds[kk * 65 + nn] = v;
    }
    __syncthreads();
#pragma unroll
    for (int p = 0; p < 16; ++p) {
      int e = tid + p * 256; int nn = e >> 6, kk = e & 63;
      int n = n0 + nn; int dst = n;
      if (mode == 1) dst = (n < 1024) ? ((n >> 5) * 64 + (n & 31)) : (((n - 1024) >> 5) * 64 + 32 + ((n - 1024) & 31));
      Wt[(size_t)dst * K + k0 + kk] = f2bf(lds[kk * 65 + nn]);
    }
  }
}

DI void adaln_phase(const Params& P, float* lds) {
  float* part = (float*)(P.ws + WS_BIG);
  float* sc = lds;
  float* red = lds + 5 * 1024;
  bool loaded = false;
  for (int item = blockIdx.x; item < 4 * 48 * 8; item += gridDim.x) {
    const int tid = opaque((int)threadIdx.x);
    if (!loaded) {
      for (int e = tid; e < 5 * 1024; e += 256) {
        int j = e >> 10, k = e & 1023;
        float v = (j < 4) ? P.c[j * 1024 + k] : P.c_ctx[k];
        sc[e] = siluf_(v);
      }
      loaded = true;
    }
    __syncthreads();
    const int ksl = item & 7, cg_ = (item >> 3) % 48, layer = item / (8 * 48);
    const int n0 = cg_ * 64;
    const int col = tid & 63, ks = tid >> 6;
    const int kb = ksl * 128 + ks * 32;
    const float* W = P.ada_w + (size_t)layer * 1024 * 3072 + (size_t)kb * 3072 + n0 + col;
    float wv[32];
#pragma unroll
    for (int i = 0; i < 32; ++i) wv[i] = W[(size_t)i * 3072];
    float a0 = 0, a1 = 0, a2 = 0, a3 = 0, a4 = 0;
#pragma unroll
    for (int i = 0; i < 32; ++i) {
      const int k = kb + i; const float w = wv[i];
      a0 += sc[k] * w; a1 += sc[1024 + k] * w; a2 += sc[2048 + k] * w; a3 += sc[3072 + k] * w; a4 += sc[4096 + k] * w;
    }
    red[(ks * 5 + 0) * 64 + col] = a0; red[(ks * 5 + 1) * 64 + col] = a1; red[(ks * 5 + 2) * 64 + col] = a2;
    red[(ks * 5 + 3) * 64 + col] = a3; red[(ks * 5 + 4) * 64 + col] = a4;
    __syncthreads();
    for (int e = tid; e < 5 * 64; e += 256) {
      int j = e >> 6, cc = e & 63;
      float s = red[(0 * 5 + j) * 64 + cc] + red[(1 * 5 + j) * 64 + cc] + red[(2 * 5 + j) * 64 + cc] + red[(3 * 5 + j) * 64 + cc];
      part[(size_t)ksl * 61440 + (layer * 5 + j) * 3072 + n0 + cc] = s;
    }
  }
}

DI void adaln_reduce(const Params& P) {
  float* mod = (float*)(P.ws + WS_MOD);
  const float* part = (const float*)(P.ws + WS_BIG);
  for (int id = blockIdx.x * 256 + opaque((int)threadIdx.x); id < 61440; id += gridDim.x * 256) {
    float s = P.ada_b[(id / 15360) * 3072 + (id % 3072)];
#pragma unroll
    for (int k = 0; k < 8; ++k) s += part[(size_t)k * 61440 + id];
    mod[id] = s;
  }
}

DI void ew_phase(const Params& P, int prev, int next, const float* __restrict__ O, bf16_t* __restrict__ A) {
  const float* mod = (const float*)(P.ws + WS_MOD);
  float* hctx = (float*)(P.ws + WS_HCTX);
  const int gw = blockIdx.x * 4 + (opaque((int)threadIdx.x) >> 6), nw = gridDim.x * 4;
  for (int tok = gw; tok < NT; tok += nw) {
    const int lane = opaque((int)threadIdx.x) & 63;
    const int b = tok / TPB, pos = tok % TPB;
    const bool isctx = pos < CTX;
    if (isctx && prev == 3) continue;
    const int cj = isctx ? 4 : b;
    const float* hs; float* hd;
    if (isctx) { hd = hctx + (size_t)(b * CTX + pos) * D; hs = (prev <= 0) ? P.ctx + (size_t)(b * CTX + pos) * D : hd; }
    else { hd = P.out + (size_t)(b * SEQ + pos - CTX) * D; hs = (prev <= 0) ? P.x + (size_t)(b * SEQ + pos - CTX) * D : hd; }
    float4 h[4];
#pragma unroll
    for (int j = 0; j < 4; ++j) h[j] = *(const float4*)(hs + j * 256 + lane * 4);
    if (prev >= 0) {
      float4 o[4]; float ss = 0;
#pragma unroll
      for (int j = 0; j < 4; ++j) { o[j] = *(const float4*)(O + (size_t)tok * D + j * 256 + lane * 4); ss += o[j].x * o[j].x + o[j].y * o[j].y + o[j].z * o[j].z + o[j].w * o[j].w; }
      ss = wsum(ss);
      const float rstd = rsqrtf(ss * (1.f / 1024.f) + 1e-6f);
      const float* gt = mod + (prev * 5 + cj) * 3072 + 2048;
      const float* pg = P.post_g + prev * 1024;
#pragma unroll
      for (int j = 0; j < 4; ++j) {
        float4 g4 = *(const float4*)(gt + j * 256 + lane * 4), p4 = *(const float4*)(pg + j * 256 + lane * 4);
        h[j].x += g4.x * o[j].x * rstd * p4.x; h[j].y += g4.y * o[j].y * rstd * p4.y;
        h[j].z += g4.z * o[j].z * rstd * p4.z; h[j].w += g4.w * o[j].w * rstd * p4.w;
        *(float4*)(hd + j * 256 + lane * 4) = h[j];
      }
    }
    if (next >= 0) {
      float ss = 0;
#pragma unroll
      for (int j = 0; j < 4; ++j) ss += h[j].x * h[j].x + h[j].y * h[j].y + h[j].z * h[j].z + h[j].w * h[j].w;
      ss = wsum(ss);
      const float rstd = rsqrtf(ss * (1.f / 1024.f) + 1e-6f);
      const float* sh = mod + (next * 5 + cj) * 3072;
      const float* scl = sh + 1024;
      const float* pg = P.pre_g + next * 1024;
#pragma unroll
      for (int j = 0; j < 4; ++j) {
        float4 s4 = *(const float4*)(sh + j * 256 + lane * 4), c4 = *(const float4*)(scl + j * 256 + lane * 4), p4 = *(const float4*)(pg + j * 256 + lane * 4);
        bf16x4 r;
        r[0] = (short)f2bf(h[j].x * rstd * p4.x * (1.f + c4.x) + s4.x);
        r[1] = (short)f2bf(h[j].y * rstd * p4.y * (1.f + c4.y) + s4.y);
        r[2] = (short)f2bf(h[j].z * rstd * p4.z * (1.f + c4.z) + s4.z);
        r[3] = (short)f2bf(h[j].w * rstd * p4.w * (1.f + c4.w) + s4.w);
        *(bf16x4*)(A + (size_t)tok * D + j * 256 + lane * 4) = r;
      }
    }
  }
}


typedef __attribute__((ext_vector_type(2))) __bf16 bf16v2;
typedef __attribute__((ext_vector_type(2))) float f32v2;
DI unsigned pack2bf(float lo, float hi) { f32v2 v = {lo, hi}; return __builtin_bit_cast(unsigned, __builtin_convertvector(v, bf16v2)); }
DI void st_pair(bf16_t* C, size_t ldc, int row_i, int col, float vi, float vi1, int r) {
  const bool odd = (r & 1) != 0;
  const float recv = __shfl_xor(odd ? vi : vi1, 1);
  const float lo = odd ? recv : vi, hi = odd ? vi1 : recv;
  *(unsigned*)(C + (size_t)(row_i + (odd ? 1 : 0)) * ldc + (col & ~1)) = pack2bf(lo, hi);
}

enum { EPI_BF16 = 0, EPI_F32, EPI_S5Y, EPI_GLU, EPI_NAIN, EPI_GDNIN };
struct Gemm {
  const bf16_t* A; long a_rs, a_kbs, a_bs;
  const bf16_t* A2; long a2_rs, a2_kbs, a2_bs; int K1;
  const bf16_t* Bt; long b_bs;
  int M, N, K, batch, epi;
  void* C; long ldc, c_bs;
  const bf16_t* zsrc; const float* bias; void* C2; void* C3;
};
constexpr int LDS_STRIDE = 72;
constexpr int GEMM_LDS_BYTES = 2 * 2 * 128 * LDS_STRIDE * 2;

DI void gemm_epilogue(const Gemm& g, int bt, int row0, int col0, f32x16 (&acc)[2][2]) {
  const int lane = opaque((int)threadIdx.x) & 63, r = lane & 31, h = lane >> 5;
  const bool full = (g.M & 127) == 0;
  if (g.epi == EPI_BF16) {
    bf16_t* C = (bf16_t*)g.C;
#pragma unroll
    for (int mi = 0; mi < 2; ++mi)
#pragma unroll
      for (int ni = 0; ni < 2; ++ni)
#pragma unroll
        for (int i = 0; i < 16; i += 2) {
          int row = row0 + mi * 32 + crow(i, h), col = col0 + ni * 32 + r;
          if (full) st_pair(C, g.ldc, row, col, acc[mi][ni][i], acc[mi][ni][i + 1], r);
          else {
            if (row < g.M) C[(size_t)row * g.ldc + col] = f2bf(acc[mi][ni][i]);
            if (row + 1 < g.M) C[(size_t)(row + 1) * g.ldc + col] = f2bf(acc[mi][ni][i + 1]);
          }
        }
  } else if (g.epi == EPI_F32) {
    float* C = (float*)g.C + (size_t)bt * g.c_bs;
#pragma unroll
    for (int mi = 0; mi < 2; ++mi)
#pragma unroll
      for (int ni = 0; ni < 2; ++ni)
#pragma unroll
        for (int i = 0; i < 16; ++i) {
          int row = row0 + mi * 32 + crow(i, h), col = col0 + ni * 32 + r;
          if (full || row < g.M) C[(size_t)row * g.ldc + col] = acc[mi][ni][i];
        }
  } else if (g.epi == EPI_S5Y) {
    bf16_t* C = (bf16_t*)g.C;
#pragma unroll
    for (int mi = 0; mi < 2; ++mi)
#pragma unroll
      for (int ni = 0; ni < 2; ++ni)
#pragma unroll
        for (int i = 0; i < 16; ++i) {
          int row = row0 + mi * 32 + crow(i, h), col = col0 + ni * 32 + r;
          if (full || row < g.M) {
            int tok = row * 16 + (col >> 4);
            C[(size_t)tok * D + bt * 16 + (col & 15)] = f2bf(geluf_(acc[mi][ni][i]));
          }
        }
  } else if (g.epi == EPI_GLU) {
    bf16_t* C = (bf16_t*)g.C;
    const int oc = (col0 >> 6) * 32 + r;
    const float ba = g.bias[oc], bb = g.bias[1024 + oc];
#pragma unroll
    for (int mi = 0; mi < 2; ++mi)
#pragma unroll
      for (int i = 0; i < 16; i += 2) {
        const int row = row0 + mi * 32 + crow(i, h);
        float y[2];
#pragma unroll
        for (int u = 0; u < 2; ++u) {
          const float ga = acc[mi][0][i + u] + ba, gb = acc[mi][1][i + u] + bb;
          const float z = bf2f(g.zsrc[(size_t)(row + u) * 2048 + 1024 + oc]);
          y[u] = ga * sigmoidf_(gb) * siluf_(z);
        }
        st_pair(C, D, row, oc, y[0], y[1], r);
      }
  } else if (g.epi == EPI_NAIN) {
    bf16_t* C = (bf16_t*)g.C;
    bf16_t* Vt = (bf16_t*)g.C2;
#pragma unroll
    for (int ni = 0; ni < 2; ++ni) {
      const int col = col0 + ni * 32 + r;
      if (col >= 2048 && col < 3072) {
        const int hh = (col - 2048) >> 6, d = (col - 2048) & 63;
#pragma unroll
        for (int mi = 0; mi < 2; ++mi)
#pragma unroll
          for (int q = 0; q < 4; ++q) {
            int row = row0 + mi * 32 + 8 * q + 4 * h;
            int b = row / TPB, pos = row % TPB;
            bf16x4 v;
            v[0] = (short)f2bf(acc[mi][ni][q * 4 + 0]); v[1] = (short)f2bf(acc[mi][ni][q * 4 + 1]);
            v[2] = (short)f2bf(acc[mi][ni][q * 4 + 2]); v[3] = (short)f2bf(acc[mi][ni][q * 4 + 3]);
            *(bf16x4*)(Vt + ((size_t)((b * 16 + hh) * 64 + d)) * TPB + pos) = v;
          }
      } else {
        const float sc = (col < 1024) ? 0.125f : 1.f;
#pragma unroll
        for (int mi = 0; mi < 2; ++mi)
#pragma unroll
          for (int i = 0; i < 16; i += 2) {
            int row = row0 + mi * 32 + crow(i, h);
            st_pair(C, 4096, row, col, acc[mi][ni][i] * sc, acc[mi][ni][i + 1] * sc, r);
          }
      }
    }
  } else if (g.epi == EPI_GDNIN) {
    bf16_t* C = (bf16_t*)g.C;
    float* AB = (float*)g.C2;
    bf16_t* Hb = (bf16_t*)g.C3;
#pragma unroll
    for (int ni = 0; ni < 2; ++ni) {
      const int col = col0 + ni * 32 + r;
      if (col < 4096) {
#pragma unroll
        for (int mi = 0; mi < 2; ++mi)
#pragma unroll
          for (int i = 0; i < 16; i += 2) {
            const int row = row0 + mi * 32 + crow(i, h);
            st_pair(C, 4096, row, col, acc[mi][ni][i], acc[mi][ni][i + 1], r);
            if (mi == 0 && i == 0) { if (h == 0 && col < 3072) { Hb[((size_t)(row >> 6) * 4 + 0) * 3072 + col] = f2bf(acc[mi][ni][0]); Hb[((size_t)(row >> 6) * 4 + 1) * 3072 + col] = f2bf(acc[mi][ni][1]); } }
            if (mi == 1 && i == 14) { if (h == 1 && col < 3072) { Hb[((size_t)(row >> 6) * 4 + 2) * 3072 + col] = f2bf(acc[mi][ni][14]); Hb[((size_t)(row >> 6) * 4 + 3) * 3072 + col] = f2bf(acc[mi][ni][15]); } }
          }
      } else if (col < 4128) {
#pragma unroll
        for (int mi = 0; mi < 2; ++mi)
#pragma unroll
          for (int i = 0; i < 16; ++i) {
            const int row = row0 + mi * 32 + crow(i, h);
            AB[(size_t)row * 32 + col - 4096] = acc[mi][ni][i];
          }
      }
    }
  }
}

DI void gemm_phase(const Gemm& g, unsigned char* smem) {
  bf16_t* sA = (bf16_t*)smem;
  bf16_t* sB = sA + 2 * 128 * 64;
  const int ntm = (g.M + 127) / 128, ntn = g.N / 128, nk = g.K / 64;
  const int tiles = g.batch * ntm * ntn;
  const int xcd = blockIdx.x & 7, loc = blockIdx.x >> 3, nloc = gridDim.x >> 3;
  const int t_lo = (int)((long)tiles * xcd / 8), t_hi = (int)((long)tiles * (xcd + 1) / 8);
  for (int tile = t_lo + loc; tile < t_hi; tile += nloc) {
    const int tid = opaque((int)threadIdx.x), lane = tid & 63, w = tid >> 6, wm = w >> 1, wn = w & 1;
    int bt = tile / (ntm * ntn); const int rem = tile % (ntm * ntn);
    int tm = rem / ntn, tn = rem % ntn;
    if (g.batch == 1 && ntm == 136) {
      const int li = tile - t_lo;
      const int band = li / (8 * ntn), idx = li - band * 8 * ntn;
      int row, col;
      if (band < 2) {
        const int nb = ntn >> 3, fullt = nb << 6;
        if (idx < fullt) { row = (idx & 63) >> 3; col = (idx >> 6) * 8 + (idx & 7); }
        else { const int wr = ntn - 8 * nb, i2 = idx - fullt; row = i2 / wr; col = 8 * nb + i2 % wr; }
      } else { row = 0; col = idx; }
      if (band == 1) col = ntn - 1 - col;
      bt = 0; tm = xcd * 17 + band * 8 + row; tn = col;
    }
    f32x16 acc[2][2];
#pragma unroll
    for (int mi = 0; mi < 2; ++mi)
#pragma unroll
      for (int ni = 0; ni < 2; ++ni)
#pragma unroll
        for (int i = 0; i < 16; ++i) acc[mi][ni][i] = 0.f;
#define STAGE1(KT, BUF, p) { \
        const int q = p * 256 + tid; \
        const int row = q >> 3, pc = q & 7; \
        const int c = pc ^ ((row >> 1) & 7); \
        const int grow = imin(tm * 128 + row, g.M - 1); \
        const int k = (KT) * 64 + c * 8; \
        const bf16_t* pa; \
        if (k < g.K1) pa = g.A + (long)bt * g.a_bs + (long)grow * g.a_rs + (long)(k >> 4) * g.a_kbs + (k & 15); \
        else { const int k2 = k - g.K1; pa = g.A2 + (long)bt * g.a2_bs + (long)grow * g.a2_rs + (long)(k2 >> 4) * g.a2_kbs + (k2 & 15); } \
        const bf16_t* pb = g.Bt + (long)bt * g.b_bs + (long)(tn * 128 + row) * g.K + k; \
        __builtin_amdgcn_global_load_lds((const unsigned*)pa, (lds_u32*)(sA + (BUF) * 8192 + q * 8), 16, 0, 0); \
        __builtin_amdgcn_global_load_lds((const unsigned*)pb, (lds_u32*)(sB + (BUF) * 8192 + q * 8), 16, 0, 0); }
#define STAGE(KT, BUF) { STAGE1(KT, BUF, 0) STAGE1(KT, BUF, 1) STAGE1(KT, BUF, 2) STAGE1(KT, BUF, 3) }
#define COMPUTE(BUF) { \
      const int ra0_ = wm * 64 + (lane & 31), ra1_ = ra0_ + 32, rb0_ = wn * 64 + (lane & 31), rb1_ = rb0_ + 32; \
      _Pragma("unroll") for (int ks = 0; ks < 4; ++ks) { \
        const int c = ks * 2 + (lane >> 5); \
        bf16x8 af0 = *(const bf16x8*)(sA + (BUF) * 8192 + ra0_ * 64 + ((c ^ ((ra0_ >> 1) & 7)) << 3)); \
        bf16x8 af1 = *(const bf16x8*)(sA + (BUF) * 8192 + ra1_ * 64 + ((c ^ ((ra1_ >> 1) & 7)) << 3)); \
        bf16x8 bf0 = *(const bf16x8*)(sB + (BUF) * 8192 + rb0_ * 64 + ((c ^ ((rb0_ >> 1) & 7)) << 3)); \
        bf16x8 bf1 = *(const bf16x8*)(sB + (BUF) * 8192 + rb1_ * 64 + ((c ^ ((rb1_ >> 1) & 7)) << 3)); \
        acc[0][0] = __builtin_amdgcn_mfma_f32_32x32x16_bf16(af0, bf0, acc[0][0], 0, 0, 0); \
        acc[0][1] = __builtin_amdgcn_mfma_f32_32x32x16_bf16(af0, bf1, acc[0][1], 0, 0, 0); \
        acc[1][0] = __builtin_amdgcn_mfma_f32_32x32x16_bf16(af1, bf0, acc[1][0], 0, 0, 0); \
        acc[1][1] = __builtin_amdgcn_mfma_f32_32x32x16_bf16(af1, bf1, acc[1][1], 0, 0, 0); \
      } }
    lds_barrier();
    STAGE(0, 0);
    asm volatile("s_waitcnt vmcnt(0)" ::: "memory");
    lds_barrier();
    for (int kt = 0; kt < nk; kt += 2) {
      STAGE(kt + 1, 1);
      COMPUTE(0);
      asm volatile("s_waitcnt vmcnt(0)" ::: "memory");
      lds_barrier();
      if (kt + 2 < nk) STAGE(kt + 2, 0);
      COMPUTE(1);
      asm volatile("s_waitcnt vmcnt(0)" ::: "memory");
      lds_barrier();
    }
#undef STAGE
#undef STAGE1
#undef COMPUTE
    gemm_epilogue(g, bt, tm * 128 + wm * 64, tn * 128 + wn * 64, acc);
  }
}

DI Gemm gemm_plain(const bf16_t* A, const bf16_t* Bt, int M, int N, int K, int epi, void* C, long ldc) {
  Gemm g{};
  g.A = A; g.a_rs = K; g.a_kbs = 16; g.a_bs = 0; g.A2 = A; g.K1 = K; g.a2_rs = K; g.a2_kbs = 16; g.a2_bs = 0;
  g.Bt = Bt; g.b_bs = 0; g.M = M; g.N = N; g.K = K; g.batch = 1; g.epi = epi; g.C = C; g.ldc = ldc; g.c_bs = 0;
  return g;
}

DI void sincos_red(double ang, float& s, float& c) {
  const double twopi = 6.283185307179586476925286766559;
  double t = ang / twopi; t = t - rint(t);
  float x = (float)(t * twopi);
  s = sinf(x); c = cosf(x);
}
DI void s5_pre_a(const Params& P, int j) {
  float2* apow = (float2*)(P.ws + WS_WT + WT_S5_APOW);
  float2* bbar = (float2*)(P.ws + WS_WT + WT_S5_BBAR);
  for (int id = blockIdx.x * 256 + opaque((int)threadIdx.x); id < 2 * 64 * 64; id += gridDim.x * 256) {
    const int d = id >> 12, g = (id >> 6) & 63, p = id & 63;
    const int base = ((j * 2 + d) * 64 + g);
    const double lr = P.s5_lam_re[base * 64 + p], li = P.s5_lam_im[base * 64 + p];
    const double dt = (double)expf(P.s5_log_dt[base]);
    float are = 1.f, aim = 0.f;
    for (int k = 0; k <= 16; ++k) {
      float mag = expf((float)(k * lr * dt)); float s, c; sincos_red(k * li * dt, s, c);
      apow[((d * 64 + g) * 17 + k) * 64 + p] = make_float2(mag * c, mag * s);
      if (k == 1) { are = mag * c; aim = mag * s; }
    }
    const float lrf = (float)lr, lif = (float)li;
    const float den = lrf * lrf + lif * lif;
    const float fre = ((are - 1.f) * lrf + aim * lif) / den, fim = (aim * lrf - (are - 1.f) * lif) / den;
    for (int c = 0; c < 16; ++c) {
      float br = P.s5_b_re[(size_t)(base * 64 + p) * 16 + c], bi = P.s5_b_im[(size_t)(base * 64 + p) * 16 + c];
      bbar[((d * 64 + g) * 64 + p) * 16 + c] = make_float2(fre * br - fim * bi, fre * bi + fim * br);
    }
  }
}
DI void s5_pre_b(const Params& P, int j) {
  const float2* apow = (const float2*)(P.ws + WS_WT + WT_S5_APOW);
  const float2* bbar = (const float2*)(P.ws + WS_WT + WT_S5_BBAR);
  float* ktab = (float*)(P.ws + WS_WT + WT_S5_KTAB);
  bf16_t* opt = (bf16_t*)(P.ws + WS_WT + WT_S5_OPT);
  bf16_t* bpt = (bf16_t*)(P.ws + WS_WT + WT_S5_BPT);
  const int gt = blockIdx.x * 256 + opaque((int)threadIdx.x), gn = gridDim.x * 256;
  for (int id = gt; id < 2 * 64 * 16 * 256; id += gn) {
    const int c2 = id & 15, c = (id >> 4) & 15, k = (id >> 8) & 15, g = (id >> 12) & 63, d = id >> 18;
    const int base = ((j * 2 + d) * 64 + g);
    const float* cr = P.s5_c_re + (size_t)(base * 16 + c) * 64;
    const float* ci = P.s5_c_im + (size_t)(base * 16 + c) * 64;
    float s = 0.f;
    for (int p = 0; p < 64; ++p) {
      float2 a = apow[((d * 64 + g) * 17 + k) * 64 + p];
      float2 b = bbar[((d * 64 + g) * 64 + p) * 16 + c2];
      float xr = cr[p] * a.x - ci[p] * a.y, xi = cr[p] * a.y + ci[p] * a.x;
      s += xr * b.x - xi * b.y;
    }
    ktab[id] = s;
  }
  for (int id = gt; id < 64 * 256 * 256; id += gn) {
    const int kk = id & 255, n = (id >> 8) & 255, g = id >> 16;
    const int i = kk >> 4, c2 = kk & 15, d = n >> 7, ri = (n >> 6) & 1, p = n & 63;
    const int e = d == 0 ? 15 - i : i;
    float2 a = apow[((d * 64 + g) * 17 + e) * 64 + p];
    float2 b = bbar[((d * 64 + g) * 64 + p) * 16 + c2];
    float re = a.x * b.x - a.y * b.y, im = a.x * b.y + a.y * b.x;
    bpt[id] = f2bf(ri ? im : re);
  }
  for (int id = gt; id < 64 * 256 * 256; id += gn) {
    const int kk = id & 255, n = (id >> 8) & 255, g = id >> 16;
    const int jj = n >> 4, c = n & 15, d = kk >> 7, ri = (kk >> 6) & 1, p = kk & 63;
    const int e = d == 0 ? jj + 1 : 16 - jj;
    const int base = ((j * 2 + d) * 64 + g);
    float2 a = apow[((d * 64 + g) * 17 + e) * 64 + p];
    float cr = P.s5_c_re[(size_t)(base * 16 + c) * 64 + p], ci = P.s5_c_im[(size_t)(base * 16 + c) * 64 + p];
    float re = cr * a.x - ci * a.y, im = cr * a.y + ci * a.x;
    opt[((size_t)g * 256 + n) * 512 + 256 + kk] = f2bf(ri ? -im : re);
  }
}
DI void s5_pre_c(const Params& P, int j) {
  const float* ktab = (const float*)(P.ws + WS_WT + WT_S5_KTAB);
  bf16_t* opt = (bf16_t*)(P.ws + WS_WT + WT_S5_OPT);
  for (int id = blockIdx.x * 256 + opaque((int)threadIdx.x); id < 64 * 256 * 256; id += gridDim.x * 256) {
    const int kk = id & 255, n = (id >> 8) & 255, g = id >> 16;
    const int jj = n >> 4, c = n & 15, i = kk >> 4, c2 = kk & 15;
    float v = 0.f;
    if (i <= jj) v += ktab[(((0 * 64 + g) * 16 + (jj - i)) * 16 + c) * 16 + c2];
    if (i >= jj) v += ktab[(((1 * 64 + g) * 16 + (i - jj)) * 16 + c) * 16 + c2];
    if (i == jj && c == c2) v += P.s5_d[j * 1024 + g * 16 + c];
    opt[((size_t)g * 256 + n) * 512 + kk] = f2bf(v);
  }
}
DI void s5_carry(const Params& P, const float* __restrict__ Sloc, bf16_t* __restrict__ Sin) {
  const float2* apow = (const float2*)(P.ws + WS_WT + WT_S5_APOW);
  const int wv = opaque((int)threadIdx.x) >> 6;
  for (int task = blockIdx.x + gridDim.x * wv; task < 512; task += gridDim.x * 4) {
    const int p = opaque((int)threadIdx.x) & 63;
    const int d = task & 1, b = (task >> 1) & 3, g = task >> 3;
    const float2 a = apow[((d * 64 + g) * 17 + 16) * 64 + p];
    const size_t base = ((size_t)g * 1088 + b * 272) * 256 + d * 128 + p;
    float sr = 0.f, si = 0.f;
    for (int s0 = 0; s0 < 272; s0 += 16) {
      float lr[16], li[16];
#pragma unroll
      for (int u = 0; u < 16; ++u) {
        const int step = s0 + u;
        const int q = d == 0 ? step : (step < 16 ? 15 - step : 287 - step);
        const size_t o = base + (size_t)q * 256;
        lr[u] = Sloc[o]; li[u] = Sloc[o + 64];
      }
#pragma unroll
      for (int u = 0; u < 16; ++u) {
        const int step = s0 + u;
        const int q = d == 0 ? step : (step < 16 ? 15 - step : 287 - step);
        const size_t o = base + (size_t)q * 256;
        Sin[o] = f2bf(sr); Sin[o + 64] = f2bf(si);
        const float nr = a.x * sr - a.y * si + lr[u], ni = a.x * si + a.y * sr + li[u];
        sr = nr; si = ni;
      }
    }
  }
}

template <bool WIN>
DI void na_step(const bf16_t* sK, const bf16_t* sV, const bf16x8 (&qf)[2], float& m, float& lsum, f32x4 (&O)[4],
                const float* __restrict__ rpb, int hd, int r, int r0, int step, int cs, int wq, int start, int lq, int lg) {
  constexpr int NTILE = WIN ? 4 : 8;
  f32x4 S[NTILE];
#pragma unroll
  for (int t = 0; t < NTILE; ++t) {
    const int kidx = WIN ? ((t >> 1) * 64 + cs + (t & 1) * 16 + lq) : (t * 16 + lq);
    f32x4 s = f32x4{0.f, 0.f, 0.f, 0.f};
#pragma unroll
    for (int kk = 0; kk < 2; ++kk) {
      bf16x8 kf = *(const bf16x8*)(sK + kidx * 72 + kk * 32 + lg * 8);
      s = __builtin_amdgcn_mfma_f32_16x16x32_bf16(kf, qf[kk], s, 0, 0, 0);
    }
    S[t] = s;
  }
  if (WIN) {
#pragma unroll
    for (int t = 0; t < NTILE; ++t) {
      const int ro = r0 + step * 2 + (t >> 1) - r + 7;
#pragma unroll
      for (int e = 0; e < 4; ++e) {
        const int col = cs + (t & 1) * 16 + lg * 4 + e;
        const bool valid = (col >= start) && (col < start + 16);
        const int co = imin(imax(col - wq + 15, 0), 30);
        const float bias = rpb[(hd * 15 + ro) * 31 + co];
        S[t][e] = valid ? S[t][e] + bias : -1e30f;
      }
    }
  }
  float mx = -1e30f;
#pragma unroll
  for (int t = 0; t < NTILE; ++t)
#pragma unroll
    for (int e = 0; e < 4; ++e) mx = fmaxf(mx, S[t][e]);
  mx = fmaxf(mx, __shfl_xor(mx, 16)); mx = fmaxf(mx, __shfl_xor(mx, 32));
  const float mnew = fmaxf(m, mx);
  const float alpha = __expf(m - mnew);
  float ps = 0.f;
#pragma unroll
  for (int t = 0; t < NTILE; ++t)
#pragma unroll
    for (int e = 0; e < 4; ++e) { float pv = __expf(S[t][e] - mnew); S[t][e] = pv; ps += pv; }
  lsum = lsum * alpha + ps; m = mnew;
#pragma unroll
  for (int dt = 0; dt < 4; ++dt) O[dt] *= alpha;
#pragma unroll
  for (int pr = 0; pr < NTILE / 2; ++pr) {
    bf16x8 pf;
#pragma unroll
    for (int e = 0; e < 4; ++e) { pf[e] = (short)f2bf(S[2 * pr][e]); pf[4 + e] = (short)f2bf(S[2 * pr + 1][e]); }
    const int pos0 = WIN ? (pr * 64 + cs + lg * 4) : (pr * 32 + lg * 4);
#pragma unroll
    for (int dt = 0; dt < 4; ++dt) {
      const bf16_t* vb = sV + (dt * 16 + lq) * 136;
      bf16x4 lo = *(const bf16x4*)(vb + pos0), hi = *(const bf16x4*)(vb + pos0 + 16);
      bf16x8 vf = __builtin_shufflevector(lo, hi, 0, 1, 2, 3, 4, 5, 6, 7);
      O[dt] = __builtin_amdgcn_mfma_f32_16x16x32_bf16(vf, pf, O[dt], 0, 0, 0);
    }
  }
}

DI void na_attn(const Params& P, const bf16_t* __restrict__ Pb, const bf16_t* __restrict__ Vt, bf16_t* __restrict__ Y, unsigned char* smem) {
  bf16_t* sK = (bf16_t*)smem;
  bf16_t* sV = sK + 128 * 72;
  const float* rpb = P.na_rpb;
  const int xcd_ = blockIdx.x & 7, nloc_ = gridDim.x >> 3;
  for (int job = xcd_ * 544 + (blockIdx.x >> 3); job < (xcd_ + 1) * 544; job += nloc_) {
    const int tid = opaque((int)threadIdx.x);
    const int lane = tid & 63, wv = tid >> 6;
    const int lq = lane & 15, lg = lane >> 4;
    int b, hd, r = 0, r0 = 0, cs = 0, w0 = 0, qtok, s_lo;
    if (job < 4096) { b = job >> 10; hd = (job >> 6) & 15; r = job & 63; w0 = wv * 16; r0 = imin(imax(r - 4, 0), 56); cs = imin(imax(w0 - 8, 0), 32); qtok = b * TPB + CTX + r * 64 + w0 + lq; s_lo = 0; }
    else { int jj = job - 4096; b = jj >> 6; hd = (jj >> 2) & 15; qtok = b * TPB + (jj & 3) * 64 + wv * 16 + lq; s_lo = 4; }
    bf16x8 qf[2];
#pragma unroll
    for (int kk = 0; kk < 2; ++kk) qf[kk] = *(const bf16x8*)(Pb + (size_t)qtok * 4096 + hd * 64 + kk * 32 + lg * 8);
    float m = -1e30f, lsum = 0.f;
    f32x4 O[4];
#pragma unroll
    for (int dt = 0; dt < 4; ++dt) O[dt] = f32x4{0.f, 0.f, 0.f, 0.f};
    const int wq = w0 + lq;
    const int start = imin(imax(wq - 8, 0), 48);
    uint4 rk0, rk1, rk2, rk3, rv0, rv1, rv2, rv3;
    const bf16_t* vrow = Vt + (size_t)((b * 16 + hd) * 64) * TPB;
#define NA_LOAD1(p, RK, RV, STEP) { \
      const int e = tid + p * 256; \
      const int key = e >> 3, part = e & 7; \
      const int ktok = (STEP) < 4 ? (b * TPB + CTX + (r0 + (STEP) * 2 + (key >> 6)) * 64 + (key & 63)) : (b * TPB + ((STEP) - 4) * 128 + key); \
      RK = *(const uint4*)(Pb + (size_t)ktok * 4096 + 1024 + hd * 64 + part * 8); \
      const int d = e >> 4, seg = e & 15; \
      const int vpos = (STEP) < 4 ? (CTX + (r0 + (STEP) * 2 + (seg >> 3)) * 64 + (seg & 7) * 8) : (((STEP) - 4) * 128 + seg * 8); \
      RV = *(const uint4*)(vrow + (size_t)d * TPB + vpos); }
#define NA_LOAD(STEP) { NA_LOAD1(0, rk0, rv0, STEP) NA_LOAD1(1, rk1, rv1, STEP) NA_LOAD1(2, rk2, rv2, STEP) NA_LOAD1(3, rk3, rv3, STEP) }
#define NA_STORE1(p, RK, RV) { \
      const int e = tid + p * 256; \
      *(uint4*)(sK + (e >> 3) * 72 + (e & 7) * 8) = RK; \
      *(uint4*)(sV + (e >> 4) * 136 + (e & 15) * 8) = RV; }
#define NA_STORE() { NA_STORE1(0, rk0, rv0) NA_STORE1(1, rk1, rv1) NA_STORE1(2, rk2, rv2) NA_STORE1(3, rk3, rv3) }
    NA_LOAD(s_lo);
    for (int step = s_lo; step < 6; ++step) {
      __syncthreads();
      NA_STORE();
      __syncthreads();
      if (step + 1 < 6) NA_LOAD(step + 1);
      if (step < 4) na_step<true>(sK, sV, qf, m, lsum, O, rpb, hd, r, r0, step, cs, wq, start, lq, lg);
      else na_step<false>(sK, sV, qf, m, lsum, O, rpb, hd, r, r0, step, cs, wq, start, lq, lg);
    }
#undef NA_LOAD
#undef NA_LOAD1
#undef NA_STORE
#undef NA_STORE1
    lsum += __shfl_xor(lsum, 16); lsum += __shfl_xor(lsum, 32);
    const float inv = 1.f / lsum;
#pragma unroll
    for (int dt = 0; dt < 4; ++dt) {
      const int dcol = hd * 64 + dt * 16 + lg * 4;
      bf16x4 z4 = *(const bf16x4*)(Pb + (size_t)qtok * 4096 + 3072 + dcol);
      bf16x4 o4;
#pragma unroll
      for (int e = 0; e < 4; ++e) o4[e] = (short)f2bf(O[dt][e] * inv * siluf_(bf2f((bf16_t)z4[e])));
      *(bf16x4*)(Y + (size_t)qtok * D + dcol) = o4;
    }
  }
}

DI int gdn_pos(int s, int dir) { return dir == 0 ? s : (s < CTX ? CTX - 1 - s : (TPB + CTX - 1) - s); }

DI unsigned u4c(const uint4& u, int k) { return k == 0 ? u.x : (k == 1 ? u.y : (k == 2 ? u.z : u.w)); }
DI void gdn_conv(const Params& P, bf16_t* __restrict__ Pb, const bf16_t* __restrict__ Hb) {
  for (int item = blockIdx.x; item < 272 * 6; item += gridDim.x) {
    const int tid = opaque((int)threadIdx.x), c8 = tid & 63, tq = tid >> 6;
    const int tile = item / 6, slab = item % 6;
    const int ch = slab * 512 + c8 * 8;
    const int tok0 = tile * 64;
    const int seg_first = ((tok0 % TPB) == 0) || ((tok0 % TPB) == CTX);
    const int seg_last = (((tok0 + 64) % TPB) == 0) || (((tok0 + 64) % TPB) == CTX);
    uint4 raw[20];
#pragma unroll
    for (int i = 0; i < 20; ++i) {
      const int lr = tq * 16 + i - 2;
      uint4 u = make_uint4(0u, 0u, 0u, 0u);
      if (lr >= 0 && lr < 64) u = *(const uint4*)(Pb + (size_t)(tok0 + lr) * 4096 + ch);
      else if (lr < 0) { if (!seg_first) u = *(const uint4*)(Hb + ((size_t)(tile - 1) * 4 + 2 + (lr + 2)) * 3072 + ch); }
      else { if (!seg_last) u = *(const uint4*)(Hb + ((size_t)(tile + 1) * 4 + (lr - 64)) * 3072 + ch); }
      raw[i] = u;
    }
    float w[5][8];
#pragma unroll
    for (int j = 0; j < 5; ++j) {
      const float4 a = *(const float4*)(P.gdn_conv_w + j * 3072 + ch), b = *(const float4*)(P.gdn_conv_w + j * 3072 + ch + 4);
      w[j][0] = a.x; w[j][1] = a.y; w[j][2] = a.z; w[j][3] = a.w; w[j][4] = b.x; w[j][5] = b.y; w[j][6] = b.z; w[j][7] = b.w;
    }
    __syncthreads();
#pragma unroll
    for (int i = 0; i < 16; ++i) {
      float y[8];
#pragma unroll
      for (int e = 0; e < 8; ++e) {
        float acc = 0.f;
#pragma unroll
        for (int j = 0; j < 5; ++j) {
          const unsigned d = u4c(raw[i + j], e >> 1);
          const float v = (e & 1) ? __uint_as_float(d & 0xffff0000u) : __uint_as_float(d << 16);
          acc += w[j][e] * v;
        }
        y[e] = siluf_(acc);
      }
      if (slab < 4) {
        float ss = 0.f;
#pragma unroll
        for (int e = 0; e < 8; ++e) ss += y[e] * y[e];
        ss += __shfl_xor(ss, 1); ss += __shfl_xor(ss, 2); ss += __shfl_xor(ss, 4); ss += __shfl_xor(ss, 8);
        const float rn = rsqrtf(ss + 1e-6f);
#pragma unroll
        for (int e = 0; e < 8; ++e) y[e] *= rn;
      }
      uint4 o;
      o.x = pack2bf(y[0], y[1]); o.y = pack2bf(y[2], y[3]); o.z = pack2bf(y[4], y[5]); o.w = pack2bf(y[6], y[7]);
      *(uint4*)(Pb + (size_t)(tok0 + tq * 16 + i) * 4096 + ch) = o;
    }
    __syncthreads();
  }
}

DI void gdn_prep(const Params& P, const bf16_t* __restrict__ Pb, const float* __restrict__ AB, bf16_t* __restrict__ Ob, int c_lo, int c_hi, int set, unsigned* ctr, unsigned char* smem) {
  bf16_t* sK = (bf16_t*)smem;
  bf16_t* sQ = sK + 64 * 136;
  bf16_t* sV = sQ + 64 * 136;
  float* sL = (float*)(sV + 64 * 136);
  float* sG = sL + 64 * 68;
  float* sBt = sG + 64;
  bf16_t* Wb = (bf16_t*)(P.ws + WS_WT + WT_G_W) + (size_t)set * 512 * 8192;
  bf16_t* Aq = (bf16_t*)(P.ws + WS_WT + (set ? WT_G_HALO : WT_G_AQK));
  float* Gc = (float*)(P.ws + WS_WT + WT_G_GC) + set * 512 * 64;
  int* s_item = (int*)(sBt + 64);
  const int nc = c_hi - c_lo;
  for (;;) {
    __syncthreads();
    if (threadIdx.x == 0) *s_item = (int)atomicAdd(ctr, 1u);
    __syncthreads();
    const int item = *s_item;
    if (item >= 64 * nc) break;
    const int tid = opaque((int)threadIdx.x), lane = tid & 63, w = tid >> 6;
    const int chain = item % 64, lc = item / 64;
    const int cidx = c_lo + lc;
    const int b = chain >> 4, hd = (chain >> 1) & 7, dir = chain & 1;
    const int slot = chain * GDN_R + lc;
    bf16_t* Ub = Ob + (((size_t)(dir * 32 + b * 8 + hd)) * TPB + cidx * 64) * 128;
    __syncthreads();
#pragma unroll
    for (int p = 0; p < 4; ++p) {
      const int e = tid + p * 256; const int row = e >> 4, kc = (e & 15) * 8;
      const int tok = b * TPB + gdn_pos(cidx * 64 + row, dir);
      const bf16_t* src = Pb + (size_t)tok * 4096 + hd * 128 + kc;
      *(uint4*)(sQ + row * 136 + kc) = *(const uint4*)(src);
      *(uint4*)(sK + row * 136 + kc) = *(const uint4*)(src + 1024);
      *(uint4*)(sV + row * 136 + kc) = *(const uint4*)(src + 2048);
    }
    if (tid < 64) {
      const int tok = b * TPB + gdn_pos(cidx * 64 + tid, dir);
      const float araw = AB[(size_t)tok * 32 + dir * 8 + hd] + P.gdn_dt_bias[dir * 8 + hd];
      const float sp = araw > 20.f ? araw : log1pf(__expf(araw));
      float gl = -__expf(P.gdn_a_log[dir * 8 + hd]) * sp;
      const float beta = sigmoidf_(AB[(size_t)tok * 32 + 16 + dir * 8 + hd]);
#pragma unroll
      for (int o = 1; o < 64; o <<= 1) { float t = __shfl_up(gl, o); if (lane >= o) gl += t; }
      sG[tid] = gl; sBt[tid] = beta; sBt[68 + tid] = beta * __expf(gl);
      Gc[slot * 64 + tid] = gl;
    }
    __syncthreads();
    {
      const int mi = w >> 1, ni = w & 1, r = lane & 31, h = lane >> 5;
      f32x16 kk, qk;
#pragma unroll
      for (int i = 0; i < 16; ++i) { kk[i] = 0.f; qk[i] = 0.f; }
#pragma unroll
      for (int ks = 0; ks < 8; ++ks) {
        bf16x8 ak = *(const bf16x8*)(sK + (mi * 32 + r) * 136 + ks * 16 + h * 8);
        bf16x8 aq = *(const bf16x8*)(sQ + (mi * 32 + r) * 136 + ks * 16 + h * 8);
        bf16x8 bk = *(const bf16x8*)(sK + (ni * 32 + r) * 136 + ks * 16 + h * 8);
        kk = __builtin_amdgcn_mfma_f32_32x32x16_bf16(ak, bk, kk, 0, 0, 0);
        qk = __builtin_amdgcn_mfma_f32_32x32x16_bf16(aq, bk, qk, 0, 0, 0);
      }
      const int col = ni * 32 + r;
      const float gcol = sG[col];
#pragma unroll
      for (int i = 0; i < 16; ++i) {
        const int row = mi * 32 + crow(i, h);
        const float grow = sG[row];
        const float dec = (col <= row) ? __expf(grow - gcol) : 0.f;
        sL[row * 68 + col] = (col < row) ? sBt[row] * kk[i] * dec : 0.f;
        Aq[((size_t)slot * 64 + row) * 64 + col] = f2bf(0.08838834764831845f * qk[i] * dec);
      }
    }
    __syncthreads();
    {
      float x[64];
#pragma unroll
      for (int i = 0; i < 64; ++i) x[i] = 0.f;
      const bool isv = tid < 128;
      const bf16_t* srcm = isv ? (sV + tid) : (sK + (tid - 128));
      const float* scl = isv ? sBt : (sBt + 68);
#pragma unroll
      for (int rr = 0; rr < 64; rr += 2) {
        const int ro0 = opaque(rr * 68);
        float a0 = bf2f(srcm[rr * 136]) * scl[rr];
        float a1 = bf2f(srcm[(rr + 1) * 136]) * scl[rr + 1];
        float l10 = 0.f;
#pragma unroll
        for (int c4 = 0; c4 < (rr + 4) / 4; ++c4) {
          const float4 p4 = *(const float4*)(sL + ro0 + c4 * 4);
          const float4 q4 = *(const float4*)(sL + ro0 + 68 + c4 * 4);
          a0 -= p4.x * x[c4 * 4 + 0]; a0 -= p4.y * x[c4 * 4 + 1]; a0 -= p4.z * x[c4 * 4 + 2]; a0 -= p4.w * x[c4 * 4 + 3];
          a1 -= q4.x * x[c4 * 4 + 0]; a1 -= q4.y * x[c4 * 4 + 1]; a1 -= q4.z * x[c4 * 4 + 2]; a1 -= q4.w * x[c4 * 4 + 3];
          if (c4 == rr / 4) l10 = ((rr & 3) == 0) ? q4.x : (((rr & 3) == 2) ? q4.z : 0.f);
        }
        a1 -= l10 * a0;
        asm volatile("" : "+v"(a0), "+v"(a1) :: "memory");
        x[rr] = a0; x[rr + 1] = a1;
      }
      bf16_t* dst = isv ? (Ub + tid) : (Wb + (size_t)slot * 64 * 128 + (tid - 128));
#pragma unroll
      for (int rr = 0; rr < 64; ++rr) dst[rr * 128] = f2bf(x[rr]);
    }
  }
}

struct ChainRegs { bf16x8 a1[8]; bf16x8 aq[4]; uint4 kt[4]; float g; };
DI void chain_load(ChainRegs& R, const bf16_t* __restrict__ Pb, const bf16_t* __restrict__ Wb, const bf16_t* __restrict__ Ub,
                   const bf16_t* __restrict__ Aq, const float* __restrict__ Gc, int slot, int cidx, int b, int hd, int dir, int dvb,
                   int tid, int w, int r, int h) {
  const int strip = w & 1;
  const bf16_t* arow;
  if (w < 2) arow = Wb + ((size_t)slot * 64 + strip * 32 + r) * 128;
  else { const int tok = b * TPB + gdn_pos(cidx * 64 + strip * 32 + r, dir); arow = Pb + (size_t)tok * 4096 + hd * 128; }
#pragma unroll
  for (int ks = 0; ks < 8; ++ks) R.a1[ks] = *(const bf16x8*)(arow + ks * 16 + h * 8);
  if (w < 2) {
    const bf16_t* ub = Ub + (((size_t)(dir * 32 + b * 8 + hd)) * TPB + cidx * 64) * 128 + dvb * 32 + r;
#pragma unroll
    for (int i = 0; i < 16; ++i) R.aq[i >> 3][i & 7] = (short)ub[(strip * 32 + crow(i, h)) * 128];
  } else {
    const bf16_t* aqrow = Aq + ((size_t)slot * 64 + strip * 32 + r) * 64;
#pragma unroll
    for (int ks = 0; ks < 4; ++ks) R.aq[ks] = *(const bf16x8*)(aqrow + ks * 16 + h * 8);
  }
  R.g = (tid < 64) ? Gc[slot * 64 + tid] : 0.f;
}
DI void chain_load_k(ChainRegs& R, const bf16_t* __restrict__ Pb, int cidx, int b, int hd, int dir, int tid) {
#pragma unroll
  for (int p = 0; p < 4; ++p) {
    const int e = tid + p * 256; const int row = e >> 4, kc = (e & 15) * 8;
    const int tok = b * TPB + gdn_pos(cidx * 64 + row, dir);
    R.kt[p] = *(const uint4*)(Pb + (size_t)tok * 4096 + 1024 + hd * 128 + kc);
  }
}
DI void gdn_chain(const Params& P, const bf16_t* __restrict__ Pb, bf16_t* Ob, int c_lo, int c_hi, int set, unsigned char* smem, bool save = true) {
  if (blockIdx.x >= 256) return;
  bf16_t* sSt = (bf16_t*)smem;
  bf16_t* sVn = sSt + 32 * 136;
  bf16_t* sVd = sVn + 32 * 72;
  bf16_t* sKt = sVd + 32 * 72;
  float* sG = (float*)(sKt + 64 * 136);
  const bf16_t* Wb = (const bf16_t*)(P.ws + WS_WT + WT_G_W) + (size_t)set * 512 * 8192;
  const bf16_t* Ub = Ob;
  const bf16_t* Aq = (const bf16_t*)(P.ws + WS_WT + (set ? WT_G_HALO : WT_G_AQK));
  const float* Gc = (const float*)(P.ws + WS_WT + WT_G_GC) + set * 512 * 64;
  float* Sst = (float*)(P.ws + WS_SST);
  const int tid = opaque((int)threadIdx.x), lane = tid & 63, w = tid >> 6, r = lane & 31, h = lane >> 5;
  const int chain = blockIdx.x >> 2, dvb = blockIdx.x & 3;
  const int b = chain >> 4, hd = (chain >> 1) & 7, dir = chain & 1;
  const int strip = w & 1;
  f32x16 S;
  if (c_lo == 0) {
#pragma unroll
    for (int i = 0; i < 16; ++i) S[i] = 0.f;
  } else {
#pragma unroll
    for (int i = 0; i < 16; ++i) S[i] = Sst[((size_t)blockIdx.x * 16 + i) * 256 + tid];
  }
  ChainRegs cur, nxt;
  chain_load(cur, Pb, Wb, Ub, Aq, Gc, chain * GDN_R, c_lo, b, hd, dir, dvb, tid, w, r, h);
  chain_load_k(cur, Pb, c_lo, b, hd, dir, tid);
  nxt = cur;
  const int tid0 = tid;
  for (int cidx = c_lo; cidx < c_hi; ++cidx) {
    const int tid = opaque(tid0), lane = tid & 63, w = tid >> 6, r = lane & 31, h = lane >> 5, strip = w & 1;
    const int slot = chain * GDN_R + (cidx - c_lo);
    __syncthreads();
#pragma unroll
    for (int q = 0; q < 4; ++q) {
      bf16x4 v;
#pragma unroll
      for (int e = 0; e < 4; ++e) v[e] = (short)f2bf(S[q * 4 + e]);
      *(bf16x4*)(sSt + r * 136 + w * 32 + 8 * q + 4 * h) = v;
    }
    if (tid < 64) {
      const float g63w = __shfl(cur.g, 63);
      sG[tid] = __expf(g63w - cur.g);
      sG[64 + tid] = 0.08838834764831845f * __expf(cur.g);
      if (tid == 63) sG[128] = __expf(cur.g);
    }
#pragma unroll
    for (int p = 0; p < 4; ++p) {
      const int e = tid + p * 256; const int row = e >> 4, kc = (e & 15) * 8;
      *(uint4*)(sKt + row * 136 + kc) = cur.kt[p];
    }
    if (cidx + 1 < c_hi) chain_load(nxt, Pb, Wb, Ub, Aq, Gc, slot + 1, cidx + 1, b, hd, dir, dvb, tid, w, r, h);
    __syncthreads();
    f32x16 acc1, acc1b;
#pragma unroll
    for (int i = 0; i < 16; ++i) { acc1[i] = 0.f; acc1b[i] = 0.f; }
#pragma unroll
    for (int ks = 0; ks < 8; ks += 2) {
      bf16x8 bfr0 = *(const bf16x8*)(sSt + r * 136 + ks * 16 + h * 8);
      bf16x8 bfr1 = *(const bf16x8*)(sSt + r * 136 + (ks + 1) * 16 + h * 8);
      acc1 = __builtin_amdgcn_mfma_f32_32x32x16_bf16(cur.a1[ks], bfr0, acc1, 0, 0, 0);
      acc1b = __builtin_amdgcn_mfma_f32_32x32x16_bf16(cur.a1[ks + 1], bfr1, acc1b, 0, 0, 0);
    }
#pragma unroll
    for (int i = 0; i < 16; ++i) acc1[i] += acc1b[i];
    if (w < 2) {
#pragma unroll
      for (int q = 0; q < 4; ++q) {
        bf16x4 vn, vd;
#pragma unroll
        for (int e = 0; e < 4; ++e) {
          const int row = strip * 32 + 8 * q + 4 * h + e;
          const float v = bf2f((bf16_t)cur.aq[(q * 4 + e) >> 3][(q * 4 + e) & 7]) - acc1[q * 4 + e];
          vn[e] = (short)f2bf(v);
          vd[e] = (short)f2bf(v * sG[row]);
        }
        *(bf16x4*)(sVn + r * 72 + strip * 32 + 8 * q + 4 * h) = vn;
        *(bf16x4*)(sVd + r * 72 + strip * 32 + 8 * q + 4 * h) = vd;
      }
    }
    __syncthreads();
    if (cidx + 1 < c_hi) chain_load_k(nxt, Pb, cidx + 1, b, hd, dir, tid);
    if (w >= 2) {
      f32x16 av;
#pragma unroll
      for (int i = 0; i < 16; ++i) av[i] = 0.f;
#pragma unroll
      for (int ks = 0; ks < 4; ++ks) {
        bf16x8 bfr = *(const bf16x8*)(sVn + r * 72 + ks * 16 + h * 8);
        av = __builtin_amdgcn_mfma_f32_32x32x16_bf16(cur.aq[ks], bfr, av, 0, 0, 0);
      }
      bf16_t* ob = Ob + (((size_t)(dir * 32 + b * 8 + hd)) * TPB + cidx * 64) * 128 + dvb * 32 + r;
#pragma unroll
      for (int i = 0; i < 16; ++i) {
        const int row = strip * 32 + crow(i, h);
        const float o = sG[64 + row] * acc1[i] + av[i];
        ob[(size_t)row * 128] = f2bf(o);
      }
    }
    {
      const float eg = sG[128];
      f32x16 d0, d1;
#pragma unroll
      for (int i = 0; i < 16; ++i) { d0[i] = 0.f; d1[i] = 0.f; }
#pragma unroll
      for (int ks = 0; ks < 4; ++ks) {
        bf16x8 af;
#pragma unroll
        for (int j = 0; j < 8; ++j) af[j] = (short)sKt[(ks * 16 + h * 8 + j) * 136 + w * 32 + r];
        bf16x8 bfr = *(const bf16x8*)(sVd + r * 72 + ks * 16 + h * 8);
        if (ks & 1) d1 = __builtin_amdgcn_mfma_f32_32x32x16_bf16(af, bfr, d1, 0, 0, 0);
        else d0 = __builtin_amdgcn_mfma_f32_32x32x16_bf16(af, bfr, d0, 0, 0, 0);
      }
#pragma unroll
      for (int i = 0; i < 16; ++i) S[i] = S[i] * eg + (d0[i] + d1[i]);
    }
    cur = nxt;
  }
  if (save) {
#pragma unroll
    for (int i = 0; i < 16; ++i) Sst[((size_t)blockIdx.x * 16 + i) * 256 + tid] = S[i];
  }
}

DI void gdn_post(const Params& P, const bf16_t* Pb, const bf16_t* __restrict__ Ob, bf16_t* Y, int ldy) {
  const int gw = blockIdx.x * 4 + (opaque((int)threadIdx.x) >> 6), nw = gridDim.x * 4;
  for (int tok = gw; tok < NT; tok += nw) {
    const int lane = opaque((int)threadIdx.x) & 63;
    const float g0 = P.gdn_norm_g[lane * 2], g1 = P.gdn_norm_g[lane * 2 + 1];
    const int b = tok / TPB, pos = tok % TPB;
    const int sf = pos, sr = pos < CTX ? CTX - 1 - pos : (TPB + CTX - 1) - pos;
#pragma unroll
    for (int hd = 0; hd < 8; ++hd) {
      const unsigned uf = *(const unsigned*)(Ob + (((size_t)(0 * 32 + b * 8 + hd)) * TPB + sf) * 128 + lane * 2);
      const unsigned ur = *(const unsigned*)(Ob + (((size_t)(1 * 32 + b * 8 + hd)) * TPB + sr) * 128 + lane * 2);
      float o0 = __uint_as_float(uf << 16) + __uint_as_float(ur << 16);
      float o1 = __uint_as_float(uf & 0xffff0000u) + __uint_as_float(ur & 0xffff0000u);
      const float ss = wsum(o0 * o0 + o1 * o1);
      const float rstd = rsqrtf(ss * (1.f / 128.f) + 1e-6f);
      const unsigned uz = *(const unsigned*)(Pb + (size_t)tok * 4096 + 3072 + hd * 128 + lane * 2);
      const float z0 = __uint_as_float(uz << 16), z1 = __uint_as_float(uz & 0xffff0000u);
      const float y0 = o0 * rstd * g0 * siluf_(z0), y1 = o1 * rstd * g1 * siluf_(z1);
      *(unsigned*)(Y + (size_t)tok * ldy + hd * 128 + lane * 2) = (unsigned)f2bf(y0) | ((unsigned)f2bf(y1) << 16);
    }
  }
}

#ifndef DUP_MASK
#define DUP_MASK 0
#endif
#define NREP(cat) (((DUP_MASK >> (cat)) & 1) ? 2 : 1)
constexpr int PH_S5 = 6;
constexpr int PH_GDN = 5 + GDN_ROUNDS;
constexpr int PH_NA = 3;
constexpr int L0_BASE = 3;
constexpr int E1_PH = L0_BASE + PH_S5;
constexpr int L1_BASE = E1_PH + 1;
constexpr int E2_PH = L1_BASE + PH_GDN;
constexpr int L2_BASE = E2_PH + 1;
constexpr int E3_PH = L2_BASE + PH_NA;
constexpr int PB3_PH = E3_PH + 1;
constexpr int L3_BASE = PB3_PH + 1;
constexpr int E4_PH = L3_BASE + PH_S5;
constexpr int NPHASES = E4_PH + 1;

DI void s5_layer_phase(const Params& P, int j, int sub, unsigned char* smem) {
  unsigned char* big = P.ws + WS_BIG;
  bf16_t* Pb = (bf16_t*)(big);
  bf16_t* A = (bf16_t*)(big + 5 * UNIT);
  float* Sloc = (float*)(big + 2 * UNIT);
  bf16_t* Sin = (bf16_t*)(big + 4 * UNIT);
  bf16_t* Y1 = (bf16_t*)(big + 5 * UNIT);
  bf16_t* Y2 = (bf16_t*)(big + 2 * UNIT);
  float* O = (float*)(big + 3 * UNIT);
  unsigned char* wt = P.ws + WS_WT;
  switch (sub) {
    case 0: {
      for (int rep_ = 0; rep_ < NREP(6); ++rep_) s5_pre_c(P, j);
      Gemm g = gemm_plain(A, (const bf16_t*)(wt + WT_S5_IN), NT, 2048, 1024, EPI_BF16, Pb, 2048);
      for (int rep_ = 0; rep_ < NREP(0); ++rep_) gemm_phase(g, smem);
    } break;
    case 1: {
      Gemm g{};
      g.A = Pb; g.a_rs = 16 * 2048; g.a_kbs = 2048; g.a_bs = 16; g.A2 = Pb; g.a2_rs = g.a_rs; g.a2_kbs = g.a_kbs; g.a2_bs = 16; g.K1 = 256;
      g.Bt = (const bf16_t*)(wt + WT_S5_BPT); g.b_bs = 256 * 256; g.M = 1088; g.N = 256; g.K = 256; g.batch = 64; g.epi = EPI_F32;
      g.C = Sloc; g.ldc = 256; g.c_bs = 1088 * 256;
      for (int rep_ = 0; rep_ < NREP(0); ++rep_) gemm_phase(g, smem);
    } break;
    case 2: for (int rep_ = 0; rep_ < NREP(3); ++rep_) s5_carry(P, Sloc, Sin); break;
    case 3: {
      Gemm g{};
      g.A = Pb; g.a_rs = 16 * 2048; g.a_kbs = 2048; g.a_bs = 16; g.K1 = 256;
      g.A2 = Sin; g.a2_rs = 256; g.a2_kbs = 16; g.a2_bs = 1088 * 256;
      g.Bt = (const bf16_t*)(wt + WT_S5_OPT); g.b_bs = 256 * 512; g.M = 1088; g.N = 256; g.K = 512; g.batch = 64; g.epi = EPI_S5Y;
      g.C = Y1;
      for (int rep_ = 0; rep_ < NREP(0); ++rep_) gemm_phase(g, smem);
    } break;
    case 4: {
      Gemm g = gemm_plain(Y1, (const bf16_t*)(wt + WT_S5_GLU), NT, 2048, 1024, EPI_GLU, Y2, 1024);
      g.zsrc = Pb; g.bias = P.s5_glu_b + j * 2048;
      for (int rep_ = 0; rep_ < NREP(0); ++rep_) gemm_phase(g, smem);
    } break;
    case 5: {
      Gemm g = gemm_plain(Y2, (const bf16_t*)(wt + WT_S5_OUT), NT, 1024, 1024, EPI_F32, O, 1024);
      for (int rep_ = 0; rep_ < NREP(0); ++rep_) gemm_phase(g, smem);
    } break;
    default: break;
  }
}
DI void s5_convert(const Params& P, int j, float* lds) {
  unsigned char* wt = P.ws + WS_WT;
  convert_wt(P.s5_in_w + (size_t)j * 1024 * 2048, 1024, 2048, 2048, (bf16_t*)(wt + WT_S5_IN), 0, lds);
  convert_wt(P.s5_glu_w + (size_t)j * 1024 * 2048, 1024, 2048, 2048, (bf16_t*)(wt + WT_S5_GLU), 1, lds);
  convert_wt(P.s5_out_w + (size_t)j * 1024 * 1024, 1024, 1024, 1024, (bf16_t*)(wt + WT_S5_OUT), 0, lds);
}

DI void run_phase(const Params& P, int ph, unsigned char* smem) {
  unsigned char* big = P.ws + WS_BIG;
  unsigned char* wt = P.ws + WS_WT;
  float* lds = (float*)smem;
  if (ph == 0) { for (int rep_ = 0; rep_ < NREP(6); ++rep_) { adaln_phase(P, lds); s5_convert(P, 0, lds); s5_pre_a(P, 0); } return; }
  if (ph == 1) { for (int rep_ = 0; rep_ < NREP(6); ++rep_) { adaln_reduce(P); s5_pre_b(P, 0); } return; }
  if (ph == 2) { ew_phase(P, -1, 0, nullptr, (bf16_t*)(big + 5 * UNIT)); return; }
  if (ph >= L0_BASE && ph < E1_PH) { s5_layer_phase(P, 0, ph - L0_BASE, smem); return; }
  if (ph == E1_PH) {
    ew_phase(P, 0, 1, (const float*)(big + 3 * UNIT), (bf16_t*)(big + 5 * UNIT));
    for (int rep_ = 0; rep_ < NREP(6); ++rep_) {
    convert_wt(P.gdn_in_w, 1024, 4128, 4224, (bf16_t*)(wt + WT_G_IN), 0, lds);
    convert_wt(P.gdn_out_w, 1024, 1024, 1024, (bf16_t*)(wt + WT_G_OUT), 0, lds); }
    return;
  }
  if (ph >= L1_BASE && ph < E2_PH) {
    const int sub = ph - L1_BASE;
    bf16_t* Pb = (bf16_t*)big;
    bf16_t* A = (bf16_t*)(big + 5 * UNIT);
    bf16_t* Ob = (bf16_t*)(big + 4 * UNIT);
    float* AB = (float*)(P.ws + WS_AB);
    bf16_t* Hb = (bf16_t*)(wt + WT_G_HALO);
    if (sub == 0) {
      Gemm g = gemm_plain(A, (const bf16_t*)(wt + WT_G_IN), NT, 4224, 1024, EPI_GDNIN, Pb, 4096);
      g.C2 = AB; g.C3 = Hb;
      for (int rep_ = 0; rep_ < NREP(0); ++rep_) gemm_phase(g, smem);
    } else if (sub == 1) {
      gdn_conv(P, Pb, Hb);
    } else if (sub < 3 + GDN_ROUNDS) {
      unsigned* ctr = (unsigned*)(P.ws + WS_BAR) + XCD_BAR_WORDS;
      const int rd = sub - 3;
      if (rd >= 0) { const int c_lo = rd * GDN_R, c_hi = imin(GDN_NCH, c_lo + GDN_R); gdn_chain(P, Pb, Ob, c_lo, c_hi, rd & 1, smem); }
      const int pr = rd + 1;
      if (pr < GDN_ROUNDS) { const int c_lo = pr * GDN_R, c_hi = imin(GDN_NCH, c_lo + GDN_R); gdn_prep(P, Pb, AB, Ob, c_lo, c_hi, pr & 1, ctr + pr * 16, smem); }
    } else if (sub == 3 + GDN_ROUNDS) {
      for (int rep_ = 0; rep_ < NREP(6); ++rep_) gdn_post(P, Pb, Ob, Pb, 4096);
    } else {
      Gemm g = gemm_plain(Pb, (const bf16_t*)(wt + WT_G_OUT), NT, 1024, 1024, EPI_F32, (float*)(big + 4 * UNIT), 1024);
      g.a_rs = 4096; g.a2_rs = 4096;
      for (int rep_ = 0; rep_ < NREP(0); ++rep_) gemm_phase(g, smem);
    }
    return;
  }
  if (ph == E2_PH) {
    ew_phase(P, 1, 2, (const float*)(big + 4 * UNIT), (bf16_t*)(big));
    for (int rep_ = 0; rep_ < NREP(6); ++rep_) {
    convert_wt(P.na_in_w, 1024, 4096, 4096, (bf16_t*)(wt + WT_N_IN), 0, lds);
    convert_wt(P.na_out_w, 1024, 1024, 1024, (bf16_t*)(wt + WT_N_OUT), 0, lds); }
    return;
  }
  if (ph >= L2_BASE && ph < E3_PH) {
    const int sub = ph - L2_BASE;
    bf16_t* A = (bf16_t*)big;
    bf16_t* Pb = (bf16_t*)(big + 1 * UNIT);
    bf16_t* Vt = (bf16_t*)(big + 5 * UNIT);
    bf16_t* Y1 = (bf16_t*)big;
    float* O = (float*)(big + 1 * UNIT);
    if (sub == 0) {
      Gemm g = gemm_plain(A, (const bf16_t*)(wt + WT_N_IN), NT, 4096, 1024, EPI_NAIN, Pb, 4096);
      g.C2 = Vt;
      for (int rep_ = 0; rep_ < NREP(0); ++rep_) gemm_phase(g, smem);
    } else if (sub == 1) {
      for (int rep_ = 0; rep_ < NREP(1); ++rep_) na_attn(P, Pb, Vt, Y1, smem);
    } else {
      Gemm g = gemm_plain(Y1, (const bf16_t*)(wt + WT_N_OUT), NT, 1024, 1024, EPI_F32, O, 1024);
      for (int rep_ = 0; rep_ < NREP(0); ++rep_) gemm_phase(g, smem);
    }
    return;
  }
  if (ph == E3_PH) {
    ew_phase(P, 2, 3, (const float*)(big + 1 * UNIT), (bf16_t*)(big + 5 * UNIT));
    for (int rep_ = 0; rep_ < NREP(6); ++rep_) { s5_convert(P, 1, lds); s5_pre_a(P, 1); }
    return;
  }
  if (ph == PB3_PH) { for (int rep_ = 0; rep_ < NREP(6); ++rep_) s5_pre_b(P, 1); return; }
  if (ph >= L3_BASE && ph < E4_PH) { s5_layer_phase(P, 1, ph - L3_BASE, smem); return; }
  if (ph == E4_PH) { ew_phase(P, 3, -1, (const float*)(big + 3 * UNIT), nullptr); return; }
}

#ifndef NO_MEGA
__global__ void __launch_bounds__(NTHREADS, 2) mega(Params P) {
  extern __shared__ __attribute__((aligned(16))) unsigned char smem[];
  __shared__ uint4 xb_words;
  cg::grid_group grid = cg::this_grid();
  if (threadIdx.x == 0) xb_words = make_uint4(0u, 0u, 0u, 0u);
  __syncthreads();
  XcdBarrier xb = xcd_barrier_post((unsigned*)(P.ws + WS_BAR), (volatile LAS unsigned*)&xb_words);
  if (P.ph_lo < 0) grid.sync();
  for (int ph = P.ph_lo; ph < P.ph_hi; ++ph) {
    run_phase(P, ph, smem);
    if (ph + 1 < P.ph_hi) { xcd_barrier(xb); if (DUP_MASK & 32) xcd_barrier(xb); }
  }
}

#ifndef MULTI_LAUNCH
#define MULTI_LAUNCH 0
#endif

extern "C" void kernel_launch(void* const* d_in, const int* in_sizes, int n_in, void* d_out, int out_size, void* d_ws, size_t ws_size, hipStream_t stream) {
  static int grid_blocks = 0;
  if (!grid_blocks) {
    int dev = 0, cus = 0, per_cu = 0;
    hipGetDevice(&dev);
    hipDeviceGetAttribute(&cus, hipDeviceAttributeMultiprocessorCount, dev);
    hipFuncSetAttribute((const void*)mega, hipFuncAttributeMaxDynamicSharedMemorySize, GEMM_LDS_BYTES);
    hipOccupancyMaxActiveBlocksPerMultiprocessor(&per_cu, (const void*)mega, NTHREADS, GEMM_LDS_BYTES);
    if (per_cu > 2) per_cu = 2;
    if (per_cu < 1) per_cu = 1;
    grid_blocks = cus * per_cu;
    if (ws_size < WS_END) fprintf(stderr, "kernel_launch: workspace too small: %zu < %zu\n", ws_size, (size_t)WS_END);
  }
  Params p{};
  const float** f = (const float**)&p;
  for (int i = 0; i < 29; ++i) f[i] = (const float*)d_in[i];
  p.out = (float*)d_out; p.ws = (unsigned char*)d_ws;
#if MULTI_LAUNCH
  for (int ph = 0; ph < NPHASES; ++ph) {
    p.ph_lo = ph; p.ph_hi = ph + 1;
    hipLaunchKernelGGL(mega, dim3(grid_blocks), dim3(NTHREADS), GEMM_LDS_BYTES, stream, p);
  }
#else
  p.ph_lo = 0; p.ph_hi = NPHASES;
  hipMemsetAsync((unsigned char*)d_ws + WS_BAR, 0, 16384, stream);
  void* args[] = {&p};
  hipError_t e = hipLaunchCooperativeKernel((const void*)mega, dim3(grid_blocks), dim3(NTHREADS), args, GEMM_LDS_BYTES, stream);
  if (e != hipSuccess) fprintf(stderr, "cooperative launch failed: %s (grid %d)\n", hipGetErrorString(e), grid_blocks);
#endif
}
#endif
```

```cpp
#include <hip/hip_runtime.h>
#include <hip/hip_cooperative_groups.h>
#include <cstdio>
namespace cg = cooperative_groups;

typedef unsigned short bf16_t;
typedef __attribute__((ext_vector_type(8))) short bf16x8;
typedef __attribute__((ext_vector_type(4))) short bf16x4;
typedef __attribute__((ext_vector_type(16))) float f32x16;
typedef __attribute__((ext_vector_type(4))) float f32x4;
#define DI __device__ __forceinline__
typedef __attribute__((address_space(3))) unsigned lds_u32;

constexpr int D = 1024;
constexpr int NB = 4;
constexpr int SEQ = 4096;
constexpr int CTX = 256;
constexpr int TPB = SEQ + CTX;
constexpr int NT = NB * TPB;
constexpr int NTHREADS = 256;
constexpr int GDN_R = 8;
constexpr int GDN_NCH = 68;
constexpr int GDN_ROUNDS = (GDN_NCH + GDN_R - 1) / GDN_R;

constexpr size_t MiB = 1024 * 1024;
constexpr size_t UNIT = (size_t)NT * 1024 * 2;
constexpr size_t WS_MOD = 0;
constexpr size_t WS_BAR = 245760;
constexpr size_t WS_HCTX = 262144;
constexpr size_t WS_AB = WS_HCTX + 4 * MiB;
constexpr size_t WS_SST = WS_AB + (size_t)NT * 32 * 4;
constexpr size_t WS_WT = WS_SST + 4 * MiB;
constexpr size_t WT_S5_IN = 0;
constexpr size_t WT_S5_GLU = WT_S5_IN + 4 * MiB;
constexpr size_t WT_S5_OUT = WT_S5_GLU + 4 * MiB;
constexpr size_t WT_S5_APOW = WT_S5_OUT + 2 * MiB;
constexpr size_t WT_S5_BBAR = WT_S5_APOW + 2 * 64 * 17 * 64 * 8;
constexpr size_t WT_S5_KTAB = WT_S5_BBAR + 2 * 64 * 64 * 16 * 8;
constexpr size_t WT_S5_OPT = WT_S5_KTAB + 2 * 64 * 16 * 256 * 4;
constexpr size_t WT_S5_BPT = WT_S5_OPT + (size_t)64 * 256 * 512 * 2;
constexpr size_t WT_S5_END = WT_S5_BPT + (size_t)64 * 256 * 256 * 2;
constexpr size_t WT_G_IN = 0;
constexpr size_t WT_G_OUT = WT_G_IN + (size_t)4224 * 1024 * 2;
constexpr size_t WT_G_HALO = WT_G_OUT + 2 * MiB;
constexpr size_t WT_G_W = WT_G_HALO + (size_t)272 * 4 * 3072 * 2;
constexpr size_t WT_G_AQK = WT_G_W + (size_t)2 * 64 * GDN_R * 64 * 128 * 2;
constexpr size_t WT_G_GC = WT_G_AQK + (size_t)64 * GDN_R * 64 * 64 * 2;
constexpr size_t WT_G_END = WT_G_GC + (size_t)2 * 64 * GDN_R * 64 * 4;
static_assert((size_t)64 * GDN_R * 64 * 64 * 2 <= (size_t)272 * 4 * 3072 * 2, "Aqk set 1 must fit the halo region");
constexpr size_t WT_N_IN = 0;
constexpr size_t WT_N_OUT = 8 * MiB;
constexpr size_t WT_SIZE = (WT_S5_END > WT_G_END ? WT_S5_END : WT_G_END);
constexpr size_t WS_BIG = (WS_WT + WT_SIZE + 255) / 256 * 256;
constexpr size_t WS_END = WS_BIG + 6 * UNIT;
static_assert(WS_END <= 256 * MiB, "workspace too large");

struct Params {
  const float *x, *c, *ctx, *c_ctx, *ada_w, *ada_b, *pre_g, *post_g;
  const float *s5_in_w, *s5_lam_re, *s5_lam_im, *s5_log_dt, *s5_b_re, *s5_b_im, *s5_c_re, *s5_c_im, *s5_d, *s5_glu_w, *s5_glu_b, *s5_out_w;
  const float *gdn_in_w, *gdn_conv_w, *gdn_a_log, *gdn_dt_bias, *gdn_norm_g, *gdn_out_w;
  const float *na_in_w, *na_rpb, *na_out_w;
  float* out;
  unsigned char* ws;
  int ph_lo, ph_hi;
};

DI bf16_t f2bf(float x) { return __builtin_bit_cast(unsigned short, (__bf16)x); }
DI float bf2f(bf16_t b) { return __uint_as_float(((unsigned)b) << 16); }
DI float wsum(float v) {
#pragma unroll
  for (int o = 32; o > 0; o >>= 1) v += __shfl_xor(v, o);
  return v;
}
DI float sigmoidf_(float x) { return __builtin_amdgcn_rcpf(1.f + __expf(-x)); }
DI float siluf_(float x) { return x * __builtin_amdgcn_rcpf(1.f + __expf(-x)); }
DI float geluf_(float x) { float u = 1.5957691216057308f * (x + 0.044715f * x * x * x); return x * __builtin_amdgcn_rcpf(1.f + __expf(-u)); }
DI int crow(int i, int h) { return (i & 3) + 8 * (i >> 2) + 4 * h; }
DI void lds_barrier() { asm volatile("s_waitcnt lgkmcnt(0)" ::: "memory"); __builtin_amdgcn_s_barrier(); asm volatile("" ::: "memory"); }
DI int opaque(int v) { asm volatile("" : "+v"(v)); return v; }
DI int imin(int a, int b) { return a < b ? a : b; }
DI int imax(int a, int b) { return a > b ? a : b; }


#define XB_TMO      128
#define XB_XCNT(j)  (256  + 64 * (j))
#define XB_XSUB(j)  (1280 + 64 * (j))
#define XB_XGEN(j)  (2304 + 64 * (j))
#define XB_TOP      3328
#define XB_TOPGEN   3392
#define XCD_BAR_WORDS 3456
#define XB_SPIN_CAP (1u << 18)
#define LAS __attribute__((address_space(3)))
DI unsigned xb_ld(unsigned* p)              { return __hip_atomic_load(p, __ATOMIC_RELAXED, __HIP_MEMORY_SCOPE_AGENT); }
DI unsigned xb_add(unsigned* p, unsigned v) { return __hip_atomic_fetch_add(p, v, __ATOMIC_RELAXED, __HIP_MEMORY_SCOPE_AGENT); }
DI unsigned xb_xcc_id() { return (unsigned)__builtin_amdgcn_s_getreg((3 << 11) | 20) & 0xFu; }
#define XB_SPIN(cond, bar) do { unsigned _sp = 0; while (cond) { __builtin_amdgcn_s_sleep(1); \
    if ((++_sp & 255u) == 0u) { if (xb_ld(&(bar)[XB_TMO])) break; if (_sp > XB_SPIN_CAP) { atomicAdd(&(bar)[XB_TMO], 1u); break; } } } } while (0)
struct XcdBarrier { unsigned* bar; unsigned x; volatile LAS unsigned* st; };
DI XcdBarrier xcd_barrier_post(unsigned* bar, volatile LAS unsigned* st) {
  XcdBarrier b; b.bar = bar; b.x = xb_xcc_id(); b.st = st;
  if (threadIdx.x == 0) (void)xb_add(&bar[XB_XCNT(b.x)], 1u);
  return b;
}
DI void xcd_barrier_complete(unsigned* bar, unsigned x, unsigned& nloc, unsigned& nx) {
  const unsigned G = gridDim.x * gridDim.y * gridDim.z;
  unsigned sum, cnt, mine, sp = 0u;
  for (;;) {
    sum = 0u; cnt = 0u; mine = 0u;
#pragma unroll
    for (unsigned j = 0; j < 16; ++j) { const unsigned c = xb_ld(&bar[XB_XCNT(j)]); sum += c; cnt += (c > 0u) ? 1u : 0u; mine = (j == x) ? c : mine; }
    if (sum == G) break;
    __builtin_amdgcn_s_sleep(1);
    if ((++sp & 255u) == 0u) { if (xb_ld(&bar[XB_TMO])) break; if (sp > XB_SPIN_CAP) { atomicAdd(&bar[XB_TMO], 1u); break; } }
  }
  nloc = mine > 0u ? mine : 1u; nx = cnt > 0u ? cnt : 1u;
}
DI void xcd_barrier(const XcdBarrier& b) {
  asm volatile("s_waitcnt vmcnt(0)" ::: "memory");
  __syncthreads();
  if (threadIdx.x == 0) {
    unsigned* bar = b.bar;
    __builtin_amdgcn_s_waitcnt(0);
    unsigned nloc = b.st[0], nx = b.st[1];
    if (nloc == 0u) { xcd_barrier_complete(bar, b.x, nloc, nx); b.st[0] = nloc; b.st[1] = nx; }
    const unsigned old = xb_add(&bar[XB_XSUB(b.x)], 1u);
    const unsigned gen = old / nloc;
    if (old + 1u == (gen + 1u) * nloc) {
      __builtin_amdgcn_fence(__ATOMIC_RELEASE, "agent");
      asm volatile("s_waitcnt vmcnt(0)" ::: "memory");
      const unsigned og = xb_add(&bar[XB_TOP], 1u);
      const unsigned tg = og / nx;
      if (og + 1u == (tg + 1u) * nx) xb_add(&bar[XB_TOPGEN], 1u);
      else XB_SPIN(xb_ld(&bar[XB_TOPGEN]) == tg, bar);
      __builtin_amdgcn_fence(__ATOMIC_ACQUIRE, "agent");
      xb_add(&bar[XB_XGEN(b.x)], 1u);
      asm volatile("s_waitcnt vmcnt(0)" ::: "memory");
    } else {
      XB_SPIN(xb_ld(&bar[XB_XGEN(b.x)]) == gen, bar);
      __builtin_amdgcn_fence(__ATOMIC_ACQUIRE, "agent");
      asm volatile("s_waitcnt vmcnt(0)" ::: "memory");
    }
  }
  __syncthreads();
}

DI void convert_wt(const float* __restrict__ W, int K, int N, int Npad, bf16_t* __restrict__ Wt, int mode, float* lds) {
  const int tk = K / 64, tn = Npad / 64;
  for (int t = blockIdx.x; t < tk * tn; t += gridDim.x) {
    const int tid = opaque((int)threadIdx.x);
    const int k0 = (t % tk) * 64, n0 = (t / tk) * 64;
    __syncthreads();
#pragma unroll
    for (int p = 0; p < 16; ++p) {
      int e = tid + p * 256; int kk = e >> 6, nn = e & 63;
      float v = (n0 + nn < N) ? W[(size_t)(k0 + kk) * N + n0 + nn] : 0.f;
      lds[kk * 65 + nn] = v;
    }
    __syncthreads();
#pragma unroll
    for (int p = 0; p < 16; ++p) {
      int e = tid + p * 256; int nn = e >> 6, kk = e & 63;
      int n = n0 + nn; int dst = n;
      if (mode == 1) dst = (n < 1024) ? ((n >> 5) * 64 + (n & 31)) : (((n - 1024) >> 5) * 64 + 32 + ((n - 1024) & 31));
      Wt[(size_t)dst * K + k0 + kk] = f2bf(lds[kk * 65 + nn]);
    }
  }
}

DI void adaln_phase(const Params& P, float* lds) {
  float* part = (float*)(P.ws + WS_BIG);
  float* sc = lds;
  float* red = lds + 5 * 1024;
  bool loaded = false;
  for (int item = blockIdx.x; item < 4 * 48 * 8; item += gridDim.x) {
    const int tid = opaque((int)threadIdx.x);
    if (!loaded) {
      for (int e = tid; e < 5 * 1024; e += 256) {
        int j = e >> 10, k = e & 1023;
        float v = (j < 4) ? P.c[j * 1024 + k] : P.c_ctx[k];
        sc[e] = siluf_(v);
      }
      loaded = true;
    }
    __syncthreads();
    const int ksl = item & 7, cg_ = (item >> 3) % 48, layer = item / (8 * 48);
    const int n0 = cg_ * 64;
    const int col = tid & 63, ks = tid >> 6;
    const int kb = ksl * 128 + ks * 32;
    const float* W = P.ada_w + (size_t)layer * 1024 * 3072 + (size_t)kb * 3072 + n0 + col;
    float wv[32];
#pragma unroll
    for (int i = 0; i < 32; ++i) wv[i] = W[(size_t)i * 3072];
    float a0 = 0, a1 = 0, a2 = 0, a3 = 0, a4 = 0;
#pragma unroll
    for (int i = 0; i < 32; ++i) {
      const int k = kb + i; const float w = wv[i];
      a0 += sc[k] * w; a1 += sc[1024 + k] * w; a2 += sc[2048 + k] * w; a3 += sc[3072 + k] * w; a4 += sc[4096 + k] * w;
    }
    red[(ks * 5 + 0) * 64 + col] = a0; red[(ks * 5 + 1) * 64 + col] = a1; red[(ks * 5 + 2) * 64 + col] = a2;
    red[(ks * 5 + 3) * 64 + col] = a3; red[(ks * 5 + 4) * 64 + col] = a4;
    __syncthreads();
    for (int e = tid; e < 5 * 64; e += 256) {
      int j = e >> 6, cc = e & 63;
      float s = red[(0 * 5 + j) * 64 + cc] + red[(1 * 5 + j) * 64 + cc] + red[(2 * 5 + j) * 64 + cc] + red[(3 * 5 + j) * 64 + cc];
      part[(size_t)ksl * 61440 + (layer * 5 + j) * 3072 + n0 + cc] = s;
    }
  }
}

DI void adaln_reduce(const Params& P) {
  float* mod = (float*)(P.ws + WS_MOD);
  const float* part = (const float*)(P.ws + WS_BIG);
  for (int id = blockIdx.x * 256 + opaque((int)threadIdx.x); id < 61440; id += gridDim.x * 256) {
    float s = P.ada_b[(id / 15360) * 3072 + (id % 3072)];
#pragma unroll
    for (int k = 0; k < 8; ++k) s += part[(size_t)k * 61440 + id];
    mod[id] = s;
  }
}

DI void ew_phase(const Params& P, int prev, int next, const float* __restrict__ O, bf16_t* __restrict__ A) {
  const float* mod = (const float*)(P.ws + WS_MOD);
  float* hctx = (float*)(P.ws + WS_HCTX);
  const int gw = blockIdx.x * 4 + (opaque((int)threadIdx.x) >> 6), nw = gridDim.x * 4;
  for (int tok = gw; tok < NT; tok += nw) {
    const int lane = opaque((int)threadIdx.x) & 63;
    const int b = tok / TPB, pos = tok % TPB;
    const bool isctx = pos < CTX;
    if (isctx && prev == 3) continue;
    const int cj = isctx ? 4 : b;
    const float* hs; float* hd;
    if (isctx) { hd = hctx + (size_t)(b * CTX + pos) * D; hs = (prev <= 0) ? P.ctx + (size_t)(b * CTX + pos) * D : hd; }
    else { hd = P.out + (size_t)(b * SEQ + pos - CTX) * D; hs = (prev <= 0) ? P.x + (size_t)(b * SEQ + pos - CTX) * D : hd; }
    float4 h[4];
#pragma unroll
    for (int j = 0; j < 4; ++j) h[j] = *(const float4*)(hs + j * 256 + lane * 4);
    if (prev >= 0) {
      float4 o[4]; float ss = 0;
#pragma unroll
      for (int j = 0; j < 4; ++j) { o[j] = *(const float4*)(O + (size_t)tok * D + j * 256 + lane * 4); ss += o[j].x * o[j].x + o[j].y * o[j].y + o[j].z * o[j].z + o[j].w * o[j].w; }
      ss = wsum(ss);
      const float rstd = rsqrtf(ss * (1.f / 1024.f) + 1e-6f);
      const float* gt = mod + (prev * 5 + cj) * 3072 + 2048;
      const float* pg = P.post_g + prev * 1024;
#pragma unroll
      for (int j = 0; j < 4; ++j) {
        float4 g4 = *(const float4*)(gt + j * 256 + lane * 4), p4 = *(const float4*)(pg + j * 256 + lane * 4);
        h[j].x += g4.x * o[j].x * rstd * p4.x; h[j].y += g4.y * o[j].y * rstd * p4.y;
        h[j].z += g4.z * o[j].z * rstd * p4.z; h[j].w += g4.w * o[j].w * rstd * p4.w;
        *(float4*)(hd + j * 256 + lane * 4) = h[j];
      }
    }
    if (next >= 0) {
      float ss = 0;
#pragma unroll
      for (int j = 0; j < 4; ++j) ss += h[j].x * h[j].x + h[j].y * h[j].y + h[j].z * h[j].z + h[j].w * h[j].w;
      ss = wsum(ss);
      const float rstd = rsqrtf(ss * (1.f / 1024.f) + 1e-6f);
      const float* sh = mod + (next * 5 + cj) * 3072;
      const float* scl = sh + 1024;
      const float* pg = P.pre_g + next * 1024;
#pragma unroll
      for (int j = 0; j < 4; ++j) {
        float4 s4 = *(const float4*)(sh + j * 256 + lane * 4), c4 = *(const float4*)(scl + j * 256 + lane * 4), p4 = *(const float4*)(pg + j * 256 + lane * 4);
        bf16x4 r;
        r[0] = (short)f2bf(h[j].x * rstd * p4.x * (1.f + c4.x) + s4.x);
        r[1] = (short)f2bf(h[j].y * rstd * p4.y * (1.f + c4.y) + s4.y);
        r[2] = (short)f2bf(h[j].z * rstd * p4.z * (1.f + c4.z) + s4.z);
        r[3] = (short)f2bf(h[j].w * rstd * p4.w * (1.f + c4.w) + s4.w);
        *(bf16x4*)(A + (size_t)tok * D + j * 256 + lane * 4) = r;
      }
    }
  }
}


typedef __attribute__((ext_vector_type(2))) __bf16 bf16v2;
typedef __attribute__((ext_vector_type(2))) float f32v2;
DI unsigned pack2bf(float lo, float hi) { f32v2 v = {lo, hi}; return __builtin_bit_cast(unsigned, __builtin_convertvector(v, bf16v2)); }
DI void st_pair(bf16_t* C, size_t ldc, int row_i, int col, float vi, float vi1, int r) {
  const bool odd = (r & 1) != 0;
  const float recv = __shfl_xor(odd ? vi : vi1, 1);
  const float lo = odd ? recv : vi, hi = odd ? vi1 : recv;
  *(unsigned*)(C + (size_t)(row_i + (odd ? 1 : 0)) * ldc + (col & ~1)) = pack2bf(lo, hi);
}

enum { EPI_BF16 = 0, EPI_F32, EPI_S5Y, EPI_GLU, EPI_NAIN, EPI_GDNIN };
struct Gemm {
  const bf16_t* A; long a_rs, a_kbs, a_bs;
  const bf16_t* A2; long a2_rs, a2_kbs, a2_bs; int K1;
  const bf16_t* Bt; long b_bs;
  int M, N, K, batch, epi;
  void* C; long ldc, c_bs;
  const bf16_t* zsrc; const float* bias; void* C2; void* C3;
};
constexpr int LDS_STRIDE = 72;
constexpr int GEMM_LDS_BYTES = 2 * 2 * 128 * LDS_STRIDE * 2;

DI void gemm_epilogue(const Gemm& g, int bt, int row0, int col0, f32x16 (&acc)[2][2]) {
  const int lane = opaque((int)threadIdx.x) & 63, r = lane & 31, h = lane >> 5;
  const bool full = (g.M & 127) == 0;
  if (g.epi == EPI_BF16) {
    bf16_t* C = (bf16_t*)g.C;
#pragma unroll
    for (int mi = 0; mi < 2; ++mi)
#pragma unroll
      for (int ni = 0; ni < 2; ++ni)
#pragma unroll
        for (int i = 0; i < 16; i += 2) {
          int row = row0 + mi * 32 + crow(i, h), col = col0 + ni * 32 + r;
          if (full) st_pair(C, g.ldc, row, col, acc[mi][ni][i], acc[mi][ni][i + 1], r);
          else {
            if (row < g.M) C[(size_t)row * g.ldc + col] = f2bf(acc[mi][ni][i]);
            if (row + 1 < g.M) C[(size_t)(row + 1) * g.ldc + col] = f2bf(acc[mi][ni][i + 1]);
          }
        }
  } else if (g.epi == EPI_F32) {
    float* C = (float*)g.C + (size_t)bt * g.c_bs;
#pragma unroll
    for (int mi = 0; mi < 2; ++mi)
#pragma unroll
      for (int ni = 0; ni < 2; ++ni)
#pragma unroll
        for (int i = 0; i < 16; ++i) {
          int row = row0 + mi * 32 + crow(i, h), col = col0 + ni * 32 + r;
          if (full || row < g.M) C[(size_t)row * g.ldc + col] = acc[mi][ni][i];
        }
  } else if (g.epi == EPI_S5Y) {
    bf16_t* C = (bf16_t*)g.C;
#pragma unroll
    for (int mi = 0; mi < 2; ++mi)
#pragma unroll
      for (int ni = 0; ni < 2; ++ni)
#pragma unroll
        for (int i = 0; i < 16; ++i) {
          int row = row0 + mi * 32 + crow(i, h), col = col0 + ni * 32 + r;
          if (full || row < g.M) {
            int tok = row * 16 + (col >> 4);
            C[(size_t)tok * D + bt * 16 + (col & 15)] = f2bf(geluf_(acc[mi][ni][i]));
          }
        }
  } else if (g.epi == EPI_GLU) {
    bf16_t* C = (bf16_t*)g.C;
    const int oc = (col0 >> 6) * 32 + r;
    const float ba = g.bias[oc], bb = g.bias[1024 + oc];
#pragma unroll
    for (int mi = 0; mi < 2; ++mi)
#pragma unroll
      for (int i = 0; i < 16; i += 2) {
        const int row = row0 + mi * 32 + crow(i, h);
        float y[2];
#pragma unroll
        for (int u = 0; u < 2; ++u) {
          const float ga = acc[mi][0][i + u] + ba, gb = acc[mi][1][i + u] + bb;
          const float z = bf2f(g.zsrc[(size_t)(row + u) * 2048 + 1024 + oc]);
          y[u] = ga * sigmoidf_(gb) * siluf_(z);
        }
        st_pair(C, D, row, oc, y[0], y[1], r);
      }
  } else if (g.epi == EPI_NAIN) {
    bf16_t* C = (bf16_t*)g.C;
    bf16_t* Vt = (bf16_t*)g.C2;
#pragma unroll
    for (int ni = 0; ni < 2; ++ni) {
      const int col = col0 + ni * 32 + r;
      if (col >= 2048 && col < 3072) {
        const int hh = (col - 2048) >> 6, d = (col - 2048) & 63;
#pragma unroll
        for (int mi = 0; mi < 2; ++mi)
#pragma unroll
          for (int q = 0; q < 4; ++q) {
            int row = row0 + mi * 32 + 8 * q + 4 * h;
            int b = row / TPB, pos = row % TPB;
            bf16x4 v;
            v[0] = (short)f2bf(acc[mi][ni][q * 4 + 0]); v[1] = (short)f2bf(acc[mi][ni][q * 4 + 1]);
            v[2] = (short)f2bf(acc[mi][ni][q * 4 + 2]); v[3] = (short)f2bf(acc[mi][ni][q * 4 + 3]);
            *(bf16x4*)(Vt + ((size_t)((b * 16 + hh) * 64 + d)) * TPB + pos) = v;
          }
      } else {
        const float sc = (col < 1024) ? 0.125f : 1.f;
#pragma unroll
        for (int mi = 0; mi < 2; ++mi)
#pragma unroll
          for (int i = 0; i < 16; i += 2) {
            int row = row0 + mi * 32 + crow(i, h);
            st_pair(C, 4096, row, col, acc[mi][ni][i] * sc, acc[mi][ni][i + 1] * sc, r);
          }
      }
    }
  } else if (g.epi == EPI_GDNIN) {
    bf16_t* C = (bf16_t*)g.C;
    float* AB = (float*)g.C2;
    bf16_t* Hb = (bf16_t*)g.C3;
#pragma unroll
    for (int ni = 0; ni < 2; ++ni) {
      const int col = col0 + ni * 32 + r;
      if (col < 4096) {
#pragma unroll
        for (int mi = 0; mi < 2; ++mi)
#pragma unroll
          for (int i = 0; i < 16; i += 2) {
            const int row = row0 + mi * 32 + crow(i, h);
            st_pair(C, 4096, row, col, acc[mi][ni][i], acc[mi][ni][i + 1], r);
            if (mi == 0 && i == 0) { if (h == 0 && col < 3072) { Hb[((size_t)(row >> 6) * 4 + 0) * 3072 + col] = f2bf(acc[mi][ni][0]); Hb[((size_t)(row >> 6) * 4 + 1) * 3072 + col] = f2bf(acc[mi][ni][1]); } }
            if (mi == 1 && i == 14) { if (h == 1 && col < 3072) { Hb[((size_t)(row >> 6) * 4 + 2) * 3072 + col] = f2bf(acc[mi][ni][14]); Hb[((size_t)(row >> 6) * 4 + 3) * 3072 + col] = f2bf(acc[mi][ni][15]); } }
          }
      } else if (col < 4128) {
#pragma unroll
        for (int mi = 0; mi < 2; ++mi)
#pragma unroll
          for (int i = 0; i < 16; ++i) {
            const int row = row0 + mi * 32 + crow(i, h);
            AB[(size_t)row * 32 + col - 4096] = acc[mi][ni][i];
          }
      }
    }
  }
}

DI void gemm_phase(const Gemm& g, unsigned char* smem) {
  bf16_t* sA = (bf16_t*)smem;
  bf16_t* sB = sA + 2 * 128 * 64;
  const int ntm = (g.M + 127) / 128, ntn = g.N / 128, nk = g.K / 64;
  const int tiles = g.batch * ntm * ntn;
  const int xcd = blockIdx.x & 7, loc = blockIdx.x >> 3, nloc = gridDim.x >> 3;
  const int t_lo = (int)((long)tiles * xcd / 8), t_hi = (int)((long)tiles * (xcd + 1) / 8);
  for (int tile = t_lo + loc; tile < t_hi; tile += nloc) {
    const int tid = opaque((int)threadIdx.x), lane = tid & 63, w = tid >> 6, wm = w >> 1, wn = w & 1;
    int bt = tile / (ntm * ntn); const int rem = tile % (ntm * ntn);
    int tm = rem / ntn, tn = rem % ntn;
    if (g.batch == 1 && ntm == 136) {
      const int li = tile - t_lo;
      const int band = li / (8 * ntn), idx = li - band * 8 * ntn;
      int row, col;
      if (band < 2) {
        const int nb = ntn >> 3, fullt = nb << 6;
        if (idx < fullt) { row = (idx & 63) >> 3; col = (idx >> 6) * 8 + (idx & 7); }
        else { const int wr = ntn - 8 * nb, i2 = idx - fullt; row = i2 / wr; col = 8 * nb + i2 % wr; }
      } else { row = 0; col = idx; }
      if (band == 1) col = ntn - 1 - col;
      bt = 0; tm = xcd * 17 + band * 8 + row; tn = col;
    }
    f32x16 acc[2][2];
#pragma unroll
    for (int mi = 0; mi < 2; ++mi)
#pragma unroll
      for (int ni = 0; ni < 2; ++ni)
#pragma unroll
        for (int i = 0; i < 16; ++i) acc[mi][ni][i] = 0.f;
#define STAGE1(KT, BUF, p) { \
        const int q = p * 256 + tid; \
        const int row = q >> 3, pc = q & 7; \
        const int c = pc ^ ((row >> 1) & 7); \
        const int grow = imin(tm * 128 + row, g.M - 1); \
        const int k = (KT) * 64 + c * 8; \
        const bf16_t* pa; \
        if (k < g.K1) pa = g.A + (long)bt * g.a_bs + (long)grow * g.a_rs + (long)(k >> 4) * g.a_kbs + (k & 15); \
        else { const int k2 = k - g.K1; pa = g.A2 + (long)bt * g.a2_bs + (long)grow * g.a2_rs + (long)(k2 >> 4) * g.a2_kbs + (k2 & 15); } \
        const bf16_t* pb = g.Bt + (long)bt * g.b_bs + (long)(tn * 128 + row) * g.K + k; \
        __builtin_amdgcn_global_load_lds((const unsigned*)pa, (lds_u32*)(sA + (BUF) * 8192 + q * 8), 16, 0, 0); \
        __builtin_amdgcn_global_load_lds((const unsigned*)pb, (lds_u32*)(sB + (BUF) * 8192 + q * 8), 16, 0, 0); }
#define STAGE(KT, BUF) { STAGE1(KT, BUF, 0) STAGE1(KT, BUF, 1) STAGE1(KT, BUF, 2) STAGE1(KT, BUF, 3) }
#define COMPUTE(BUF) { \
      const int ra0_ = wm * 64 + (lane & 31), ra1_ = ra0_ + 32, rb0_ = wn * 64 + (lane & 31), rb1_ = rb0_ + 32; \
      _Pragma("unroll") for (int ks = 0; ks < 4; ++ks) { \
        const int c = ks * 2 + (lane >> 5); \
        bf16x8 af0 = *(const bf16x8*)(sA + (BUF) * 8192 + ra0_ * 64 + ((c ^ ((ra0_ >> 1) & 7)) << 3)); \
        bf16x8 af1 = *(const bf16x8*)(sA + (BUF) * 8192 + ra1_ * 64 + ((c ^ ((ra1_ >> 1) & 7)) << 3)); \
        bf16x8 bf0 = *(const bf16x8*)(sB + (BUF) * 8192 + rb0_ * 64 + ((c ^ ((rb0_ >> 1) & 7)) << 3)); \
        bf16x8 bf1 = *(const bf16x8*)(sB + (BUF) * 8192 + rb1_ * 64 + ((c ^ ((rb1_ >> 1) & 7)) << 3)); \
        acc[0][0] = __builtin_amdgcn_mfma_f32_32x32x16_bf16(af0, bf0, acc[0][0], 0, 0, 0); \
        acc[0][1] = __builtin_amdgcn_mfma_f32_32x32x16_bf16(af0, bf1, acc[0][1], 0, 0, 0); \
        acc[1][0] = __builtin_amdgcn_mfma_f32_32x32x16_bf16(af1, bf0, acc[1][0], 0, 0, 0); \
        acc[1][1] = __builtin_amdgcn_mfma_f32_32x32x16_bf16(af1, bf1, acc[1][1], 0, 0, 0); \
      } }
    lds_barrier();
    STAGE(0, 0);
    asm volatile("s_waitcnt vmcnt(0)" ::: "memory");
    lds_barrier();
    for (int kt = 0; kt < nk; kt += 2) {
      STAGE(kt + 1, 1);
      COMPUTE(0);
      asm volatile("s_waitcnt vmcnt(0)" ::: "memory");
      lds_barrier();
      if (kt + 2 < nk) STAGE(kt + 2, 0);
      COMPUTE(1);
      asm volatile("s_waitcnt vmcnt(0)" ::: "memory");
      lds_barrier();
    }
#undef STAGE
#undef STAGE1
#undef COMPUTE
    gemm_epilogue(g, bt, tm * 128 + wm * 64, tn * 128 + wn * 64, acc);
  }
}

DI Gemm gemm_plain(const bf16_t* A, const bf16_t* Bt, int M, int N, int K, int epi, void* C, long ldc) {
  Gemm g{};
  g.A = A; g.a_rs = K; g.a_kbs = 16; g.a_bs = 0; g.A2 = A; g.K1 = K; g.a2_rs = K; g.a2_kbs = 16; g.a2_bs = 0;
  g.Bt = Bt; g.b_bs = 0; g.M = M; g.N = N; g.K = K; g.batch = 1; g.epi = epi; g.C = C; g.ldc = ldc; g.c_bs = 0;
  return g;
}

DI void sincos_red(double ang, float& s, float& c) {
  const double twopi = 6.283185307179586476925286766559;
  double t = ang / twopi; t = t - rint(t);
  float x = (float)(t * twopi);
  s = sinf(x); c = cosf(x);
}
DI void s5_pre_a(const Params& P, int j) {
  float2* apow = (float2*)(P.ws + WS_WT + WT_S5_APOW);
  float2* bbar = (float2*)(P.ws + WS_WT + WT_S5_BBAR);
  for (int id = blockIdx.x * 256 + opaque((int)threadIdx.x); id < 2 * 64 * 64; id += gridDim.x * 256) {
    const int d = id >> 12, g = (id >> 6) & 63, p = id & 63;
    const int base = ((j * 2 + d) * 64 + g);
    const double lr = P.s5_lam_re[base * 64 + p], li = P.s5_lam_im[base * 64 + p];
    const double dt = (double)expf(P.s5_log_dt[base]);
    float are = 1.f, aim = 0.f;
    for (int k = 0; k <= 16; ++k) {
      float mag = expf((float)(k * lr * dt)); float s, c; sincos_red(k * li * dt, s, c);
      apow[((d * 64 + g) * 17 + k) * 64 + p] = make_float2(mag * c, mag * s);
      if (k == 1) { are = mag * c; aim = mag * s; }
    }
    const float lrf = (float)lr, lif = (float)li;
    const float den = lrf * lrf + lif * lif;
    const float fre = ((are - 1.f) * lrf + aim * lif) / den, fim = (aim * lrf - (are - 1.f) * lif) / den;
    for (int c = 0; c < 16; ++c) {
      float br = P.s5_b_re[(size_t)(base * 64 + p) * 16 + c], bi = P.s5_b_im[(size_t)(base * 64 + p) * 16 + c];
      bbar[((d * 64 + g) * 64 + p) * 16 + c] = make_float2(fre * br - fim * bi, fre * bi + fim * br);
    }
  }
}
DI void s5_pre_b(const Params& P, int j) {
  const float2* apow = (const float2*)(P.ws + WS_WT + WT_S5_APOW);
  const float2* bbar = (const float2*)(P.ws + WS_WT + WT_S5_BBAR);
  float* ktab = (float*)(P.ws + WS_WT + WT_S5_KTAB);
  bf16_t* opt = (bf16_t*)(P.ws + WS_WT + WT_S5_OPT);
  bf16_t* bpt = (bf16_t*)(P.ws + WS_WT + WT_S5_BPT);
  const int gt = blockIdx.x * 256 + opaque((int)threadIdx.x), gn = gridDim.x * 256;
  for (int id = gt; id < 2 * 64 * 16 * 256; id += gn) {
    const int c2 = id & 15, c = (id >> 4) & 15, k = (id >> 8) & 15, g = (id >> 12) & 63, d = id >> 18;
    const int base = ((j * 2 + d) * 64 + g);
    const float* cr = P.s5_c_re + (size_t)(base * 16 + c) * 64;
    const float* ci = P.s5_c_im + (size_t)(base * 16 + c) * 64;
    float s = 0.f;
    for (int p = 0; p < 64; ++p) {
      float2 a = apow[((d * 64 + g) * 17 + k) * 64 + p];
      float2 b = bbar[((d * 64 + g) * 64 + p) * 16 + c2];
      float xr = cr[p] * a.x - ci[p] * a.y, xi = cr[p] * a.y + ci[p] * a.x;
      s += xr * b.x - xi * b.y;
    }
    ktab[id] = s;
  }
  for (int id = gt; id < 64 * 256 * 256; id += gn) {
    const int kk = id & 255, n = (id >> 8) & 255, g = id >> 16;
    const int i = kk >> 4, c2 = kk & 15, d = n >> 7, ri = (n >> 6) & 1, p = n & 63;
    const int e = d == 0 ? 15 - i : i;
    float2 a = apow[((d * 64 + g) * 17 + e) * 64 + p];
    float2 b = bbar[((d * 64 + g) * 64 + p) * 16 + c2];
    float re = a.x * b.x - a.y * b.y, im = a.x * b.y + a.y * b.x;
    bpt[id] = f2bf(ri ? im : re);
  }
  for (int id = gt; id < 64 * 256 * 256; id += gn) {
    const int kk = id & 255, n = (id >> 8) & 255, g = id >> 16;
    const int jj = n >> 4, c = n & 15, d = kk >> 7, ri = (kk >> 6) & 1, p = kk & 63;
    const int e = d == 0 ? jj + 1 : 16 - jj;
    const int base = ((j * 2 + d) * 64 + g);
    float2 a = apow[((d * 64 + g) * 17 + e) * 64 + p];
    float cr = P.s5_c_re[(size_t)(base * 16 + c) * 64 + p], ci = P.s5_c_im[(size_t)(base * 16 + c) * 64 + p];
    float re = cr * a.x - ci * a.y, im = cr * a.y + ci * a.x;
    opt[((size_t)g * 256 + n) * 512 + 256 + kk] = f2bf(ri ? -im : re);
  }
}
DI void s5_pre_c(const Params& P, int j) {
  const float* ktab = (const float*)(P.ws + WS_WT + WT_S5_KTAB);
  bf16_t* opt = (bf16_t*)(P.ws + WS_WT + WT_S5_OPT);
  for (int id = blockIdx.x * 256 + opaque((int)threadIdx.x); id < 64 * 256 * 256; id += gridDim.x * 256) {
    const int kk = id & 255, n = (id >> 8) & 255, g = id >> 16;
    const int jj = n >> 4, c = n & 15, i = kk >> 4, c2 = kk & 15;
    float v = 0.f;
    if (i <= jj) v += ktab[(((0 * 64 + g) * 16 + (jj - i)) * 16 + c) * 16 + c2];
    if (i >= jj) v += ktab[(((1 * 64 + g) * 16 + (i - jj)) * 16 + c) * 16 + c2];
    if (i == jj && c == c2) v += P.s5_d[j * 1024 + g * 16 + c];
    opt[((size_t)g * 256 + n) * 512 + kk] = f2bf(v);
  }
}
DI void s5_carry(const Params& P, const float* __restrict__ Sloc, bf16_t* __restrict__ Sin) {
  const float2* apow = (const float2*)(P.ws + WS_WT + WT_S5_APOW);
  const int wv = opaque((int)threadIdx.x) >> 6;
  for (int task = blockIdx.x + gridDim.x * wv; task < 512; task += gridDim.x * 4) {
    const int p = opaque((int)threadIdx.x) & 63;
    const int d = task & 1, b = (task >> 1) & 3, g = task >> 3;
    const float2 a = apow[((d * 64 + g) * 17 + 16) * 64 + p];
    const size_t base = ((size_t)g * 1088 + b * 272) * 256 + d * 128 + p;
    float sr = 0.f, si = 0.f;
    for (int s0 = 0; s0 < 272; s0 += 16) {
      float lr[16], li[16];
#pragma unroll
      for (int u = 0; u < 16; ++u) {
        const int step = s0 + u;
        const int q = d == 0 ? step : (step < 16 ? 15 - step : 287 - step);
        const size_t o = base + (size_t)q * 256;
        lr[u] = Sloc[o]; li[u] = Sloc[o + 64];
      }
#pragma unroll
      for (int u = 0; u < 16; ++u) {
        const int step = s0 + u;
        const int q = d == 0 ? step : (step < 16 ? 15 - step : 287 - step);
        const size_t o = base + (size_t)q * 256;
        Sin[o] = f2bf(sr); Sin[o + 64] = f2bf(si);
        const float nr = a.x * sr - a.y * si + lr[u], ni = a.x * si + a.y * sr + li[u];
        sr = nr; si = ni;
      }
    }
  }
}

template <bool WIN>
DI void na_step(const bf16_t* sK, const bf16_t* sV, const bf16x8 (&qf)[2], float& m, float& lsum, f32x4 (&O)[4],
                const float* __restrict__ rpb, int hd, int r, int r0, int step, int cs, int wq, int start, int lq, int lg) {
  constexpr int NTILE = WIN ? 4 : 8;
  f32x4 S[NTILE];
#pragma unroll
  for (int t = 0; t < NTILE; ++t) {
    const int kidx = WIN ? ((t >> 1) * 64 + cs + (t & 1) * 16 + lq) : (t * 16 + lq);
    f32x4 s = f32x4{0.f, 0.f, 0.f, 0.f};
#pragma unroll
    for (int kk = 0; kk < 2; ++kk) {
      bf16x8 kf = *(const bf16x8*)(sK + kidx * 72 + kk * 32 + lg * 8);
      s = __builtin_amdgcn_mfma_f32_16x16x32_bf16(kf, qf[kk], s, 0, 0, 0);
    }
    S[t] = s;
  }
  if (WIN) {
#pragma unroll
    for (int t = 0; t < NTILE; ++t) {
      const int ro = r0 + step * 2 + (t >> 1) - r + 7;
#pragma unroll
      for (int e = 0; e < 4; ++e) {
        const int col = cs + (t & 1) * 16 + lg * 4 + e;
        const bool valid = (col >= start) && (col < start + 16);
        const int co = imin(imax(col - wq + 15, 0), 30);
        const float bias = rpb[(hd * 15 + ro) * 31 + co];
        S[t][e] = valid ? S[t][e] + bias : -1e30f;
      }
    }
  }
  float mx = -1e30f;
#pragma unroll
  for (int t = 0; t < NTILE; ++t)
#pragma unroll
    for (int e = 0; e < 4; ++e) mx = fmaxf(mx, S[t][e]);
  mx = fmaxf(mx, __shfl_xor(mx, 16)); mx = fmaxf(mx, __shfl_xor(mx, 32));
  const float mnew = fmaxf(m, mx);
  const float alpha = __expf(m - mnew);
  float ps = 0.f;
#pragma unroll
  for (int t = 0; t < NTILE; ++t)
#pragma unroll
    for (int e = 0; e < 4; ++e) { float pv = __expf(S[t][e] - mnew); S[t][e] = pv; ps += pv; }
  lsum = lsum * alpha + ps; m = mnew;
#pragma unroll
  for (int dt = 0; dt < 4; ++dt) O[dt] *= alpha;
#pragma unroll
  for (int pr = 0; pr < NTILE / 2; ++pr) {
    bf16x8 pf;
#pragma unroll
    for (int e = 0; e < 4; ++e) { pf[e] = (short)f2bf(S[2 * pr][e]); pf[4 + e] = (short)f2bf(S[2 * pr + 1][e]); }
    const int pos0 = WIN ? (pr * 64 + cs + lg * 4) : (pr * 32 + lg * 4);
#pragma unroll
    for (int dt = 0; dt < 4; ++dt) {
      const bf16_t* vb = sV + (dt * 16 + lq) * 136;
      bf16x4 lo = *(const bf16x4*)(vb + pos0), hi = *(const bf16x4*)(vb + pos0 + 16);
      bf16x8 vf = __builtin_shufflevector(lo, hi, 0, 1, 2, 3, 4, 5, 6, 7);
      O[dt] = __builtin_amdgcn_mfma_f32_16x16x32_bf16(vf, pf, O[dt], 0, 0, 0);
    }
  }
}

DI void na_attn(const Params& P, const bf16_t* __restrict__ Pb, const bf16_t* __restrict__ Vt, bf16_t* __restrict__ Y, unsigned char* smem) {
  bf16_t* sK = (bf16_t*)smem;
  bf16_t* sV = sK + 128 * 72;
  const float* rpb = P.na_rpb;
  const int xcd_ = blockIdx.x & 7, nloc_ = gridDim.x >> 3;
  for (int job = xcd_ * 544 + (blockIdx.x >> 3); job < (xcd_ + 1) * 544; job += nloc_) {
    const int tid = opaque((int)threadIdx.x);
    const int lane = tid & 63, wv = tid >> 6;
    const int lq = lane & 15, lg = lane >> 4;
    int b, hd, r = 0, r0 = 0, cs = 0, w0 = 0, qtok, s_lo;
    if (job < 4096) { b = job >> 10; hd = (job >> 6) & 15; r = job & 63; w0 = wv * 16; r0 = imin(imax(r - 4, 0), 56); cs = imin(imax(w0 - 8, 0), 32); qtok = b * TPB + CTX + r * 64 + w0 + lq; s_lo = 0; }
    else { int jj = job - 4096; b = jj >> 6; hd = (jj >> 2) & 15; qtok = b * TPB + (jj & 3) * 64 + wv * 16 + lq; s_lo = 4; }
    bf16x8 qf[2];
#pragma unroll
    for (int kk = 0; kk < 2; ++kk) qf[kk] = *(const bf16x8*)(Pb + (size_t)qtok * 4096 + hd * 64 + kk * 32 + lg * 8);
    float m = -1e30f, lsum = 0.f;
    f32x4 O[4];
#pragma unroll
    for (int dt = 0; dt < 4; ++dt) O[dt] = f32x4{0.f, 0.f, 0.f, 0.f};
    const int wq = w0 + lq;
    const int start = imin(imax(wq - 8, 0), 48);
    uint4 rk0, rk1, rk2, rk3, rv0, rv1, rv2, rv3;
    const bf16_t* vrow = Vt + (size_t)((b * 16 + hd) * 64) * TPB;
#define NA_LOAD1(p, RK, RV, STEP) { \
      const int e = tid + p * 256; \
      const int key = e >> 3, part = e & 7; \
      const int ktok = (STEP) < 4 ? (b * TPB + CTX + (r0 + (STEP) * 2 + (key >> 6)) * 64 + (key & 63)) : (b * TPB + ((STEP) - 4) * 128 + key); \
      RK = *(const uint4*)(Pb + (size_t)ktok * 4096 + 1024 + hd * 64 + part * 8); \
      const int d = e >> 4, seg = e & 15; \
      const int vpos = (STEP) < 4 ? (CTX + (r0 + (STEP) * 2 + (seg >> 3)) * 64 + (seg & 7) * 8) : (((STEP) - 4) * 128 + seg * 8); \
      RV = *(const uint4*)(vrow + (size_t)d * TPB + vpos); }
#define NA_LOAD(STEP) { NA_LOAD1(0, rk0, rv0, STEP) NA_LOAD1(1, rk1, rv1, STEP) NA_LOAD1(2, rk2, rv2, STEP) NA_LOAD1(3, rk3, rv3, STEP) }
#define NA_STORE1(p, RK, RV) { \
      const int e = tid + p * 256; \
      *(uint4*)(sK + (e >> 3) * 72 + (e & 7) * 8) = RK; \
      *(uint4*)(sV + (e >> 4) * 136 + (e & 15) * 8) = RV; }
#define NA_STORE() { NA_STORE1(0, rk0, rv0) NA_STORE1(1, rk1, rv1) NA_STORE1(2, rk2, rv2) NA_STORE1(3, rk3, rv3) }
    NA_LOAD(s_lo);
    for (int step = s_lo; step < 6; ++step) {
      __syncthreads();
      NA_STORE();
      __syncthreads();
      if (step + 1 < 6) NA_LOAD(step + 1);
      if (step < 4) na_step<true>(sK, sV, qf, m, lsum, O, rpb, hd, r, r0, step, cs, wq, start, lq, lg);
      else na_step<false>(sK, sV, qf, m, lsum, O, rpb, hd, r, r0, step, cs, wq, start, lq, lg);
    }
#undef NA_LOAD
#undef NA_LOAD1
#undef NA_STORE
#undef NA_STORE1
    lsum += __shfl_xor(lsum, 16); lsum += __shfl_xor(lsum, 32);
    const float inv = 1.f / lsum;
#pragma unroll
    for (int dt = 0; dt < 4; ++dt) {
      const int dcol = hd * 64 + dt * 16 + lg * 4;
      bf16x4 z4 = *(const bf16x4*)(Pb + (size_t)qtok * 4096 + 3072 + dcol);
      bf16x4 o4;
#pragma unroll
      for (int e = 0; e < 4; ++e) o4[e] = (short)f2bf(O[dt][e] * inv * siluf_(bf2f((bf16_t)z4[e])));
      *(bf16x4*)(Y + (size_t)qtok * D + dcol) = o4;
    }
  }
}

DI int gdn_pos(int s, int dir) { return dir == 0 ? s : (s < CTX ? CTX - 1 - s : (TPB + CTX - 1) - s); }

DI unsigned u4c(const uint4& u, int k) { return k == 0 ? u.x : (k == 1 ? u.y : (k == 2 ? u.z : u.w)); }
DI void gdn_conv(const Params& P, bf16_t* __restrict__ Pb, const bf16_t* __restrict__ Hb) {
  for (int item = blockIdx.x; item < 272 * 6; item += gridDim.x) {
    const int tid = opaque((int)threadIdx.x), c8 = tid & 63, tq = tid >> 6;
    const int tile = item / 6, slab = item % 6;
    const int ch = slab * 512 + c8 * 8;
    const int tok0 = tile * 64;
    const int seg_first = ((tok0 % TPB) == 0) || ((tok0 % TPB) == CTX);
    const int seg_last = (((tok0 + 64) % TPB) == 0) || (((tok0 + 64) % TPB) == CTX);
    uint4 raw[20];
#pragma unroll
    for (int i = 0; i < 20; ++i) {
      const int lr = tq * 16 + i - 2;
      uint4 u = make_uint4(0u, 0u, 0u, 0u);
      if (lr >= 0 && lr < 64) u = *(const uint4*)(Pb + (size_t)(tok0 + lr) * 4096 + ch);
      else if (lr < 0) { if (!seg_first) u = *(const uint4*)(Hb + ((size_t)(tile - 1) * 4 + 2 + (lr + 2)) * 3072 + ch); }
      else { if (!seg_last) u = *(const uint4*)(Hb + ((size_t)(tile + 1) * 4 + (lr - 64)) * 3072 + ch); }
      raw[i] = u;
    }
    float w[5][8];
#pragma unroll
    for (int j = 0; j < 5; ++j) {
      const float4 a = *(const float4*)(P.gdn_conv_w + j * 3072 + ch), b = *(const float4*)(P.gdn_conv_w + j * 3072 + ch + 4);
      w[j][0] = a.x; w[j][1] = a.y; w[j][2] = a.z; w[j][3] = a.w; w[j][4] = b.x; w[j][5] = b.y; w[j][6] = b.z; w[j][7] = b.w;
    }
    __syncthreads();
#pragma unroll
    for (int i = 0; i < 16; ++i) {
      float y[8];
#pragma unroll
      for (int e = 0; e < 8; ++e) {
        float acc = 0.f;
#pragma unroll
        for (int j = 0; j < 5; ++j) {
          const unsigned d = u4c(raw[i + j], e >> 1);
          const float v = (e & 1) ? __uint_as_float(d & 0xffff0000u) : __uint_as_float(d << 16);
          acc += w[j][e] * v;
        }
        y[e] = siluf_(acc);
      }
      if (slab < 4) {
        float ss = 0.f;
#pragma unroll
        for (int e = 0; e < 8; ++e) ss += y[e] * y[e];
        ss += __shfl_xor(ss, 1); ss += __shfl_xor(ss, 2); ss += __shfl_xor(ss, 4); ss += __shfl_xor(ss, 8);
        const float rn = rsqrtf(ss + 1e-6f);
#pragma unroll
        for (int e = 0; e < 8; ++e) y[e] *= rn;
      }
      uint4 o;
      o.x = pack2bf(y[0], y[1]); o.y = pack2bf(y[2], y[3]); o.z = pack2bf(y[4], y[5]); o.w = pack2bf(y[6], y[7]);
      *(uint4*)(Pb + (size_t)(tok0 + tq * 16 + i) * 4096 + ch) = o;
    }
    __syncthreads();
  }
}

DI void gdn_prep(const Params& P, const bf16_t* __restrict__ Pb, const float* __restrict__ AB, bf16_t* __restrict__ Ob, int c_lo, int c_hi, int set, unsigned* ctr, unsigned char* smem) {
  bf16_t* sK = (bf16_t*)smem;
  bf16_t* sQ = sK + 64 * 136;
  bf16_t* sV = sQ + 64 * 136;
  float* sL = (float*)(sV + 64 * 136);
  float* sG = sL + 64 * 68;
  float* sBt = sG + 64;
  bf16_t* Wb = (bf16_t*)(P.ws + WS_WT + WT_G_W) + (size_t)set * 512 * 8192;
  bf16_t* Aq = (bf16_t*)(P.ws + WS_WT + (set ? WT_G_HALO : WT_G_AQK));
  float* Gc = (float*)(P.ws + WS_WT + WT_G_GC) + set * 512 * 64;
  int* s_item = (int*)(sBt + 64);
  const int nc = c_hi - c_lo;
  for (;;) {
    __syncthreads();
    if (threadIdx.x == 0) *s_item = (int)atomicAdd(ctr, 1u);
    __syncthreads();
    const int item = *s_item;
    if (item >= 64 * nc) break;
    const int tid = opaque((int)threadIdx.x), lane = tid & 63, w = tid >> 6;
    const int chain = item % 64, lc = item / 64;
    const int cidx = c_lo + lc;
    const int b = chain >> 4, hd = (chain >> 1) & 7, dir = chain & 1;
    const int slot = chain * GDN_R + lc;
    bf16_t* Ub = Ob + (((size_t)(dir * 32 + b * 8 + hd)) * TPB + cidx * 64) * 128;
    __syncthreads();
#pragma unroll
    for (int p = 0; p < 4; ++p) {
      const int e = tid + p * 256; const int row = e >> 4, kc = (e & 15) * 8;
      const int tok = b * TPB + gdn_pos(cidx * 64 + row, dir);
      const bf16_t* src = Pb + (size_t)tok * 4096 + hd * 128 + kc;
      *(uint4*)(sQ + row * 136 + kc) = *(const uint4*)(src);
      *(uint4*)(sK + row * 136 + kc) = *(const uint4*)(src + 1024);
      *(uint4*)(sV + row * 136 + kc) = *(const uint4*)(src + 2048);
    }
    if (tid < 64) {
      const int tok = b * TPB + gdn_pos(cidx * 64 + tid, dir);
      const float araw = AB[(size_t)tok * 32 + dir * 8 + hd] + P.gdn_dt_bias[dir * 8 + hd];
      const float sp = araw > 20.f ? araw : log1pf(__expf(araw));
      float gl = -__expf(P.gdn_a_log[dir * 8 + hd]) * sp;
      const float beta = sigmoidf_(AB[(size_t)tok * 32 + 16 + dir * 8 + hd]);
#pragma unroll
      for (int o = 1; o < 64; o <<= 1) { float t = __shfl_up(gl, o); if (lane >= o) gl += t; }
      sG[tid] = gl; sBt[tid] = beta; sBt[68 + tid] = beta * __expf(gl);
      Gc[slot * 64 + tid] = gl;
    }
    __syncthreads();
    {
      const int mi = w >> 1, ni = w & 1, r = lane & 31, h = lane >> 5;
      f32x16 kk, qk;
#pragma unroll
      for (int i = 0; i < 16; ++i) { kk[i] = 0.f; qk[i] = 0.f; }
#pragma unroll
      for (int ks = 0; ks < 8; ++ks) {
        bf16x8 ak = *(const bf16x8*)(sK + (mi * 32 + r) * 136 + ks * 16 + h * 8);
        bf16x8 aq = *(const bf16x8*)(sQ + (mi * 32 + r) * 136 + ks * 16 + h * 8);
        bf16x8 bk = *(const bf16x8*)(sK + (ni * 32 + r) * 136 + ks * 16 + h * 8);
        kk = __builtin_amdgcn_mfma_f32_32x32x16_bf16(ak, bk, kk, 0, 0, 0);
        qk = __builtin_amdgcn_mfma_f32_32x32x16_bf16(aq, bk, qk, 0, 0, 0);
      }
      const int col = ni * 32 + r;
      const float gcol = sG[col];
#pragma unroll
      for (int i = 0; i < 16; ++i) {
        const int row = mi * 32 + crow(i, h);
        const float grow = sG[row];
        const float dec = (col <= row) ? __expf(grow - gcol) : 0.f;
        sL[row * 68 + col] = (col < row) ? sBt[row] * kk[i] * dec : 0.f;
        Aq[((size_t)slot * 64 + row) * 64 + col] = f2bf(0.08838834764831845f * qk[i] * dec);
      }
    }
    __syncthreads();
    {
      float x[64];
#pragma unroll
      for (int i = 0; i < 64; ++i) x[i] = 0.f;
      const bool isv = tid < 128;
      const bf16_t* srcm = isv ? (sV + tid) : (sK + (tid - 128));
      const float* scl = isv ? sBt : (sBt + 68);
#pragma unroll
      for (int rr = 0; rr < 64; rr += 2) {
        const int ro0 = opaque(rr * 68);
        float a0 = bf2f(srcm[rr * 136]) * scl[rr];
        float a1 = bf2f(srcm[(rr + 1) * 136]) * scl[rr + 1];
        float l10 = 0.f;
#pragma unroll
        for (int c4 = 0; c4 < (rr + 4) / 4; ++c4) {
          const float4 p4 = *(const float4*)(sL + ro0 + c4 * 4);
          const float4 q4 = *(const float4*)(sL + ro0 + 68 + c4 * 4);
          a0 -= p4.x * x[c4 * 4 + 0]; a0 -= p4.y * x[c4 * 4 + 1]; a0 -= p4.z * x[c4 * 4 + 2]; a0 -= p4.w * x[c4 * 4 + 3];
          a1 -= q4.x * x[c4 * 4 + 0]; a1 -= q4.y * x[c4 * 4 + 1]; a1 -= q4.z * x[c4 * 4 + 2]; a1 -= q4.w * x[c4 * 4 + 3];
          if (c4 == rr / 4) l10 = ((rr & 3) == 0) ? q4.x : (((rr & 3) == 2) ? q4.z : 0.f);
        }
        a1 -= l10 * a0;
        asm volatile("" : "+v"(a0), "+v"(a1) :: "memory");
        x[rr] = a0; x[rr + 1] = a1;
      }
      bf16_t* dst = isv ? (Ub + tid) : (Wb + (size_t)slot * 64 * 128 + (tid - 128));
#pragma unroll
      for (int rr = 0; rr < 64; ++rr) dst[rr * 128] = f2bf(x[rr]);
    }
  }
}

struct ChainRegs { bf16x8 a1[8]; bf16x8 aq[4]; uint4 kt[4]; float g; };
DI void chain_load(ChainRegs& R, const bf16_t* __restrict__ Pb, const bf16_t* __restrict__ Wb, const bf16_t* __restrict__ Ub,
                   const bf16_t* __restrict__ Aq, const float* __restrict__ Gc, int slot, int cidx, int b, int hd, int dir, int dvb,
                   int tid, int w, int r, int h) {
  const int strip = w & 1;
  const bf16_t* arow;
  if (w < 2) arow = Wb + ((size_t)slot * 64 + strip * 32 + r) * 128;
  else { const int tok = b * TPB + gdn_pos(cidx * 64 + strip * 32 + r, dir); arow = Pb + (size_t)tok * 4096 + hd * 128; }
#pragma unroll
  for (int ks = 0; ks < 8; ++ks) R.a1[ks] = *(const bf16x8*)(arow + ks * 16 + h * 8);
  if (w < 2) {
    const bf16_t* ub = Ub + (((size_t)(dir * 32 + b * 8 + hd)) * TPB + cidx * 64) * 128 + dvb * 32 + r;
#pragma unroll
    for (int i = 0; i < 16; ++i) R.aq[i >> 3][i & 7] = (short)ub[(strip * 32 + crow(i, h)) * 128];
  } else {
    const bf16_t* aqrow = Aq + ((size_t)slot * 64 + strip * 32 + r) * 64;
#pragma unroll
    for (int ks = 0; ks < 4; ++ks) R.aq[ks] = *(const bf16x8*)(aqrow + ks * 16 + h * 8);
  }
  R.g = (tid < 64) ? Gc[slot * 64 + tid] : 0.f;
}
DI void chain_load_k(ChainRegs& R, const bf16_t* __restrict__ Pb, int cidx, int b, int hd, int dir, int tid) {
#pragma unroll
  for (int p = 0; p < 4; ++p) {
    const int e = tid + p * 256; const int row = e >> 4, kc = (e & 15) * 8;
    const int tok = b * TPB + gdn_pos(cidx * 64 + row, dir);
    R.kt[p] = *(const uint4*)(Pb + (size_t)tok * 4096 + 1024 + hd * 128 + kc);
  }
}
DI void gdn_chain(const Params& P, const bf16_t* __restrict__ Pb, bf16_t* Ob, int c_lo, int c_hi, int set, unsigned char* smem, bool save = true) {
  if (blockIdx.x >= 256) return;
  bf16_t* sSt = (bf16_t*)smem;
  bf16_t* sVn = sSt + 32 * 136;
  bf16_t* sVd = sVn + 32 * 72;
  bf16_t* sKt = sVd + 32 * 72;
  float* sG = (float*)(sKt + 64 * 136);
  const bf16_t* Wb = (const bf16_t*)(P.ws + WS_WT + WT_G_W) + (size_t)set * 512 * 8192;
  const bf16_t* Ub = Ob;
  const bf16_t* Aq = (const bf16_t*)(P.ws + WS_WT + (set ? WT_G_HALO : WT_G_AQK));
  const float* Gc = (const float*)(P.ws + WS_WT + WT_G_GC) + set * 512 * 64;
  float* Sst = (float*)(P.ws + WS_SST);
  const int tid = opaque((int)threadIdx.x), lane = tid & 63, w = tid >> 6, r = lane & 31, h = lane >> 5;
  const int chain = blockIdx.x >> 2, dvb = blockIdx.x & 3;
  const int b = chain >> 4, hd = (chain >> 1) & 7, dir = chain & 1;
  const int strip = w & 1;
  f32x16 S;
  if (c_lo == 0) {
#pragma unroll
    for (int i = 0; i < 16; ++i) S[i] = 0.f;
  } else {
#pragma unroll
    for (int i = 0; i < 16; ++i) S[i] = Sst[((size_t)blockIdx.x * 16 + i) * 256 + tid];
  }
  ChainRegs cur, nxt;
  chain_load(cur, Pb, Wb, Ub, Aq, Gc, chain * GDN_R, c_lo, b, hd, dir, dvb, tid, w, r, h);
  chain_load_k(cur, Pb, c_lo, b, hd, dir, tid);
  nxt = cur;
  const int tid0 = tid;
  for (int cidx = c_lo; cidx < c_hi; ++cidx) {
    const int tid = opaque(tid0), lane = tid & 63, w = tid >> 6, r = lane & 31, h = lane >> 5, strip = w & 1;
    const int slot = chain * GDN_R + (cidx - c_lo);
    __syncthreads();
#pragma unroll
    for (int q = 0; q < 4; ++q) {
      bf16x4 v;
#pragma unroll
      for (int e = 0; e < 4; ++e) v[e] = (short)f2bf(S[q * 4 + e]);
      *(bf16x4*)(sSt + r * 136 + w * 32 + 8 * q + 4 * h) = v;
    }
    if (tid < 64) {
      const float g63w = __shfl(cur.g, 63);
      sG[tid] = __expf(g63w - cur.g);
      sG[64 + tid] = 0.08838834764831845f * __expf(cur.g);
      if (tid == 63) sG[128] = __expf(cur.g);
    }
#pragma unroll
    for (int p = 0; p < 4; ++p) {
      const int e = tid + p * 256; const int row = e >> 4, kc = (e & 15) * 8;
      *(uint4*)(sKt + row * 136 + kc) = cur.kt[p];
    }
    if (cidx + 1 < c_hi) chain_load(nxt, Pb, Wb, Ub, Aq, Gc, slot + 1, cidx + 1, b, hd, dir, dvb, tid, w, r, h);
    __syncthreads();
    f32x16 acc1, acc1b;
#pragma unroll
    for (int i = 0; i < 16; ++i) { acc1[i] = 0.f; acc1b[i] = 0.f; }
#pragma unroll
    for (int ks = 0; ks < 8; ks += 2) {
      bf16x8 bfr0 = *(const bf16x8*)(sSt + r * 136 + ks * 16 + h * 8);
      bf16x8 bfr1 = *(const bf16x8*)(sSt + r * 136 + (ks + 1) * 16 + h * 8);
      acc1 = __builtin_amdgcn_mfma_f32_32x32x16_bf16(cur.a1[ks], bfr0, acc1, 0, 0, 0);
      acc1b = __builtin_amdgcn_mfma_f32_32x32x16_bf16(cur.a1[ks + 1], bfr1, acc1b, 0, 0, 0);
    }
#pragma unroll
    for (int i = 0; i < 16; ++i) acc1[i] += acc1b[i];
    if (w < 2) {
#pragma unroll
      for (int q = 0; q < 4; ++q) {
        bf16x4 vn, vd;
#pragma unroll
        for (int e = 0; e < 4; ++e) {
          const int row = strip * 32 + 8 * q + 4 * h + e;
          const float v = bf2f((bf16_t)cur.aq[(q * 4 + e) >> 3][(q * 4 + e) & 7]) - acc1[q * 4 + e];
          vn[e] = (short)f2bf(v);
          vd[e] = (short)f2bf(v * sG[row]);
        }
        *(bf16x4*)(sVn + r * 72 + strip * 32 + 8 * q + 4 * h) = vn;
        *(bf16x4*)(sVd + r * 72 + strip * 32 + 8 * q + 4 * h) = vd;
      }
    }
    __syncthreads();
    if (cidx + 1 < c_hi) chain_load_k(nxt, Pb, cidx + 1, b, hd, dir, tid);
    if (w >= 2) {
      f32x16 av;
#pragma unroll
      for (int i = 0; i < 16; ++i) av[i] = 0.f;
#pragma unroll
      for (int ks = 0; ks < 4; ++ks) {
        bf16x8 bfr = *(const bf16x8*)(sVn + r * 72 + ks * 16 + h * 8);
        av = __builtin_amdgcn_mfma_f32_32x32x16_bf16(cur.aq[ks], bfr, av, 0, 0, 0);
      }
      bf16_t* ob = Ob + (((size_t)(dir * 32 + b * 8 + hd)) * TPB + cidx * 64) * 128 + dvb * 32 + r;
#pragma unroll
      for (int i = 0; i < 16; ++i) {
        const int row = strip * 32 + crow(i, h);
        const float o = sG[64 + row] * acc1[i] + av[i];
        ob[(size_t)row * 128] = f2bf(o);
      }
    }
    {
      const float eg = sG[128];
      f32x16 d0, d1;
#pragma unroll
      for (int i = 0; i < 16; ++i) { d0[i] = 0.f; d1[i] = 0.f; }
#pragma unroll
      for (int ks = 0; ks < 4; ++ks) {
        bf16x8 af;
#pragma unroll
        for (int j = 0; j < 8; ++j) af[j] = (short)sKt[(ks * 16 + h * 8 + j) * 136 + w * 32 + r];
        bf16x8 bfr = *(const bf16x8*)(sVd + r * 72 + ks * 16 + h * 8);
        if (ks & 1) d1 = __builtin_amdgcn_mfma_f32_32x32x16_bf16(af, bfr, d1, 0, 0, 0);
        else d0 = __builtin_amdgcn_mfma_f32_32x32x16_bf16(af, bfr, d0, 0, 0, 0);
      }
#pragma unroll
      for (int i = 0; i < 16; ++i) S[i] = S[i] * eg + (d0[i] + d1[i]);
    }
    cur = nxt;
  }
  if (save) {
#pragma unroll
    for (int i = 0; i < 16; ++i) Sst[((size_t)blockIdx.x * 16 + i) * 256 + tid] = S[i];
  }
}

DI void gdn_post(const Params& P, const bf16_t* Pb, const bf16_t* __restrict__ Ob, bf16_t* Y, int ldy) {
  const int gw = blockIdx.x * 4 + (opaque((int)threadIdx.x) >> 6), nw = gridDim.x * 4;
  for (int tok = gw; tok < NT; tok += nw) {
    const int lane = opaque((int)threadIdx.x) & 63;
    const int l16 = lane & 15, hq = lane >> 4;
    const float4 ga = *(const float4*)(P.gdn_norm_g + l16 * 8), gb = *(const float4*)(P.gdn_norm_g + l16 * 8 + 4);
    const float gn[8] = {ga.x, ga.y, ga.z, ga.w, gb.x, gb.y, gb.z, gb.w};
    const int b = tok / TPB, pos = tok % TPB;
    const int sf = pos, sr = pos < CTX ? CTX - 1 - pos : (TPB + CTX - 1) - pos;
#pragma unroll
    for (int it = 0; it < 2; ++it) {
      const int hd = it * 4 + hq;
      const uint4 uf = *(const uint4*)(Ob + (((size_t)(0 * 32 + b * 8 + hd)) * TPB + sf) * 128 + l16 * 8);
      const uint4 ur = *(const uint4*)(Ob + (((size_t)(1 * 32 + b * 8 + hd)) * TPB + sr) * 128 + l16 * 8);
      const uint4 uz = *(const uint4*)(Pb + (size_t)tok * 4096 + 3072 + hd * 128 + l16 * 8);
      float o[8], z[8];
#pragma unroll
      for (int k = 0; k < 4; ++k) {
        const unsigned f = u4c(uf, k), r = u4c(ur, k), zz = u4c(uz, k);
        o[2 * k] = __uint_as_float(f << 16) + __uint_as_float(r << 16);
        o[2 * k + 1] = __uint_as_float(f & 0xffff0000u) + __uint_as_float(r & 0xffff0000u);
        z[2 * k] = __uint_as_float(zz << 16); z[2 * k + 1] = __uint_as_float(zz & 0xffff0000u);
      }
      float ss = 0.f;
#pragma unroll
      for (int e = 0; e < 8; ++e) ss += o[e] * o[e];
      ss += __shfl_xor(ss, 1); ss += __shfl_xor(ss, 2); ss += __shfl_xor(ss, 4); ss += __shfl_xor(ss, 8);
      const float rstd = rsqrtf(ss * (1.f / 128.f) + 1e-6f);
      float y[8];
#pragma unroll
      for (int e = 0; e < 8; ++e) y[e] = o[e] * rstd * gn[e] * siluf_(z[e]);
      uint4 ov;
      ov.x = pack2bf(y[0], y[1]); ov.y = pack2bf(y[2], y[3]); ov.z = pack2bf(y[4], y[5]); ov.w = pack2bf(y[6], y[7]);
      *(uint4*)(Y + (size_t)tok * ldy + hd * 128 + l16 * 8) = ov;
    }
  }
}

#ifndef DUP_MASK
#define DUP_MASK 0
#endif
#define NREP(cat) (((DUP_MASK >> (cat)) & 1) ? 2 : 1)
constexpr int PH_S5 = 6;
constexpr int PH_GDN = 5 + GDN_ROUNDS;
constexpr int PH_NA = 3;
constexpr int L0_BASE = 3;
constexpr int E1_PH = L0_BASE + PH_S5;
constexpr int L1_BASE = E1_PH + 1;
constexpr int E2_PH = L1_BASE + PH_GDN;
constexpr int L2_BASE = E2_PH + 1;
constexpr int E3_PH = L2_BASE + PH_NA;
constexpr int PB3_PH = E3_PH + 1;
constexpr int L3_BASE = PB3_PH + 1;
constexpr int E4_PH = L3_BASE + PH_S5;
constexpr int NPHASES = E4_PH + 1;

DI void s5_layer_phase(const Params& P, int j, int sub, unsigned char* smem) {
  unsigned char* big = P.ws + WS_BIG;
  bf16_t* Pb = (bf16_t*)(big);
  bf16_t* A = (bf16_t*)(big + 5 * UNIT);
  float* Sloc = (float*)(big + 2 * UNIT);
  bf16_t* Sin = (bf16_t*)(big + 4 * UNIT);
  bf16_t* Y1 = (bf16_t*)(big + 5 * UNIT);
  bf16_t* Y2 = (bf16_t*)(big + 2 * UNIT);
  float* O = (float*)(big + 3 * UNIT);
  unsigned char* wt = P.ws + WS_WT;
  switch (sub) {
    case 0: {
      for (int rep_ = 0; rep_ < NREP(6); ++rep_) s5_pre_c(P, j);
      Gemm g = gemm_plain(A, (const bf16_t*)(wt + WT_S5_IN), NT, 2048, 1024, EPI_BF16, Pb, 2048);
      for (int rep_ = 0; rep_ < NREP(0); ++rep_) gemm_phase(g, smem);
    } break;
    case 1: {
      Gemm g{};
      g.A = Pb; g.a_rs = 16 * 2048; g.a_kbs = 2048; g.a_bs = 16; g.A2 = Pb; g.a2_rs = g.a_rs; g.a2_kbs = g.a_kbs; g.a2_bs = 16; g.K1 = 256;
      g.Bt = (const bf16_t*)(wt + WT_S5_BPT); g.b_bs = 256 * 256; g.M = 1088; g.N = 256; g.K = 256; g.batch = 64; g.epi = EPI_F32;
      g.C = Sloc; g.ldc = 256; g.c_bs = 1088 * 256;
      for (int rep_ = 0; rep_ < NREP(0); ++rep_) gemm_phase(g, smem);
    } break;
    case 2: for (int rep_ = 0; rep_ < NREP(3); ++rep_) s5_carry(P, Sloc, Sin); break;
    case 3: {
      Gemm g{};
      g.A = Pb; g.a_rs = 16 * 2048; g.a_kbs = 2048; g.a_bs = 16; g.K1 = 256;
      g.A2 = Sin; g.a2_rs = 256; g.a2_kbs = 16; g.a2_bs = 1088 * 256;
      g.Bt = (const bf16_t*)(wt + WT_S5_OPT); g.b_bs = 256 * 512; g.M = 1088; g.N = 256; g.K = 512; g.batch = 64; g.epi = EPI_S5Y;
      g.C = Y1;
      for (int rep_ = 0; rep_ < NREP(0); ++rep_) gemm_phase(g, smem);
    } break;
    case 4: {
      Gemm g = gemm_plain(Y1, (const bf16_t*)(wt + WT_S5_GLU), NT, 2048, 1024, EPI_GLU, Y2, 1024);
      g.zsrc = Pb; g.bias = P.s5_glu_b + j * 2048;
      for (int rep_ = 0; rep_ < NREP(0); ++rep_) gemm_phase(g, smem);
    } break;
    case 5: {
      Gemm g = gemm_plain(Y2, (const bf16_t*)(wt + WT_S5_OUT), NT, 1024, 1024, EPI_F32, O, 1024);
      for (int rep_ = 0; rep_ < NREP(0); ++rep_) gemm_phase(g, smem);
    } break;
    default: break;
  }
}
DI void s5_convert(const Params& P, int j, float* lds) {
  unsigned char* wt = P.ws + WS_WT;
  convert_wt(P.s5_in_w + (size_t)j * 1024 * 2048, 1024, 2048, 2048, (bf16_t*)(wt + WT_S5_IN), 0, lds);
  convert_wt(P.s5_glu_w + (size_t)j * 1024 * 2048, 1024, 2048, 2048, (bf16_t*)(wt + WT_S5_GLU), 1, lds);
  convert_wt(P.s5_out_w + (size_t)j * 1024 * 1024, 1024, 1024, 1024, (bf16_t*)(wt + WT_S5_OUT), 0, lds);
}

DI void run_phase(const Params& P, int ph, unsigned char* smem) {
  unsigned char* big = P.ws + WS_BIG;
  unsigned char* wt = P.ws + WS_WT;
  float* lds = (float*)smem;
  if (ph == 0) { for (int rep_ = 0; rep_ < NREP(6); ++rep_) { adaln_phase(P, lds); s5_convert(P, 0, lds); s5_pre_a(P, 0); } return; }
  if (ph == 1) { for (int rep_ = 0; rep_ < NREP(6); ++rep_) { adaln_reduce(P); s5_pre_b(P, 0); } return; }
  if (ph == 2) { ew_phase(P, -1, 0, nullptr, (bf16_t*)(big + 5 * UNIT)); return; }
  if (ph >= L0_BASE && ph < E1_PH) { s5_layer_phase(P, 0, ph - L0_BASE, smem); return; }
  if (ph == E1_PH) {
    ew_phase(P, 0, 1, (const float*)(big + 3 * UNIT), (bf16_t*)(big + 5 * UNIT));
    for (int rep_ = 0; rep_ < NREP(6); ++rep_) {
    convert_wt(P.gdn_in_w, 1024, 4128, 4224, (bf16_t*)(wt + WT_G_IN), 0, lds);
    convert_wt(P.gdn_out_w, 1024, 1024, 1024, (bf16_t*)(wt + WT_G_OUT), 0, lds); }
    return;
  }
  if (ph >= L1_BASE && ph < E2_PH) {
    const int sub = ph - L1_BASE;
    bf16_t* Pb = (bf16_t*)big;
    bf16_t* A = (bf16_t*)(big + 5 * UNIT);
    bf16_t* Ob = (bf16_t*)(big + 4 * UNIT);
    float* AB = (float*)(P.ws + WS_AB);
    bf16_t* Hb = (bf16_t*)(wt + WT_G_HALO);
    if (sub == 0) {
      Gemm g = gemm_plain(A, (const bf16_t*)(wt + WT_G_IN), NT, 4224, 1024, EPI_GDNIN, Pb, 4096);
      g.C2 = AB; g.C3 = Hb;
      for (int rep_ = 0; rep_ < NREP(0); ++rep_) gemm_phase(g, smem);
    } else if (sub == 1) {
      gdn_conv(P, Pb, Hb);
    } else if (sub < 3 + GDN_ROUNDS) {
      unsigned* ctr = (unsigned*)(P.ws + WS_BAR) + XCD_BAR_WORDS;
      const int rd = sub - 3;
      if (rd >= 0) { const int c_lo = rd * GDN_R, c_hi = imin(GDN_NCH, c_lo + GDN_R); gdn_chain(P, Pb, Ob, c_lo, c_hi, rd & 1, smem); }
      const int pr = rd + 1;
      if (pr < GDN_ROUNDS) { const int c_lo = pr * GDN_R, c_hi = imin(GDN_NCH, c_lo + GDN_R); gdn_prep(P, Pb, AB, Ob, c_lo, c_hi, pr & 1, ctr + pr * 16, smem); }
    } else if (sub == 3 + GDN_ROUNDS) {
      for (int rep_ = 0; rep_ < NREP(6); ++rep_) gdn_post(P, Pb, Ob, Pb, 4096);
    } else {
      Gemm g = gemm_plain(Pb, (const bf16_t*)(wt + WT_G_OUT), NT, 1024, 1024, EPI_F32, (float*)(big + 4 * UNIT), 1024);
      g.a_rs = 4096; g.a2_rs = 4096;
      for (int rep_ = 0; rep_ < NREP(0); ++rep_) gemm_phase(g, smem);
    }
    return;
  }
  if (ph == E2_PH) {
    ew_phase(P, 1, 2, (const float*)(big + 4 * UNIT), (bf16_t*)(big));
    for (int rep_ = 0; rep_ < NREP(6); ++rep_) {
    convert_wt(P.na_in_w, 1024, 4096, 4096, (bf16_t*)(wt + WT_N_IN), 0, lds);
    convert_wt(P.na_out_w, 1024, 1024, 1024, (bf16_t*)(wt + WT_N_OUT), 0, lds); }
    return;
  }
  if (ph >= L2_BASE && ph < E3_PH) {
    const int sub = ph - L2_BASE;
    bf16_t* A = (bf16_t*)big;
    bf16_t* Pb = (bf16_t*)(big + 1 * UNIT);
    bf16_t* Vt = (bf16_t*)(big + 5 * UNIT);
    bf16_t* Y1 = (bf16_t*)big;
    float* O = (float*)(big + 1 * UNIT);
    if (sub == 0) {
      Gemm g = gemm_plain(A, (const bf16_t*)(wt + WT_N_IN), NT, 4096, 1024, EPI_NAIN, Pb, 4096);
      g.C2 = Vt;
      for (int rep_ = 0; rep_ < NREP(0); ++rep_) gemm_phase(g, smem);
    } else if (sub == 1) {
      for (int rep_ = 0; rep_ < NREP(1); ++rep_) na_attn(P, Pb, Vt, Y1, smem);
    } else {
      Gemm g = gemm_plain(Y1, (const bf16_t*)(wt + WT_N_OUT), NT, 1024, 1024, EPI_F32, O, 1024);
      for (int rep_ = 0; rep_ < NREP(0); ++rep_) gemm_phase(g, smem);
    }
    return;
  }
  if (ph == E3_PH) {
    ew_phase(P, 2, 3, (const float*)(big + 1 * UNIT), (bf16_t*)(big + 5 * UNIT));
    for (int rep_ = 0; rep_ < NREP(6); ++rep_) { s5_convert(P, 1, lds); s5_pre_a(P, 1); }
    return;
  }
  if (ph == PB3_PH) { for (int rep_ = 0; rep_ < NREP(6); ++rep_) s5_pre_b(P, 1); return; }
  if (ph >= L3_BASE && ph < E4_PH) { s5_layer_phase(P, 1, ph - L3_BASE, smem); return; }
  if (ph == E4_PH) { ew_phase(P, 3, -1, (const float*)(big + 3 * UNIT), nullptr); return; }
}

#ifndef NO_MEGA
__global__ void __launch_bounds__(NTHREADS, 2) mega(Params P) {
  extern __shared__ __attribute__((aligned(16))) unsigned char smem[];
  __shared__ uint4 xb_words;
  cg::grid_group grid = cg::this_grid();
  if (threadIdx.x == 0) xb_words = make_uint4(0u, 0u, 0u, 0u);
  __syncthreads();
  XcdBarrier xb = xcd_barrier_post((unsigned*)(P.ws + WS_BAR), (volatile LAS unsigned*)&xb_words);
  if (P.ph_lo < 0) grid.sync();
  for (int ph = P.ph_lo; ph < P.ph_hi; ++ph) {
    run_phase(P, ph, smem);
    if (ph + 1 < P.ph_hi) { xcd_barrier(xb); if (DUP_MASK & 32) xcd_barrier(xb); }
  }
}

#ifndef MULTI_LAUNCH
#define MULTI_LAUNCH 0
#endif

extern "C" void kernel_launch(void* const* d_in, const int* in_sizes, int n_in, void* d_out, int out_size, void* d_ws, size_t ws_size, hipStream_t stream) {
  static int grid_blocks = 0;
  if (!grid_blocks) {
    int dev = 0, cus = 0, per_cu = 0;
    hipGetDevice(&dev);
    hipDeviceGetAttribute(&cus, hipDeviceAttributeMultiprocessorCount, dev);
    hipFuncSetAttribute((const void*)mega, hipFuncAttributeMaxDynamicSharedMemorySize, GEMM_LDS_BYTES);
    hipOccupancyMaxActiveBlocksPerMultiprocessor(&per_cu, (const void*)mega, NTHREADS, GEMM_LDS_BYTES);
    if (per_cu > 2) per_cu = 2;
    if (per_cu < 1) per_cu = 1;
    grid_blocks = cus * per_cu;
    if (ws_size < WS_END) fprintf(stderr, "kernel_launch: workspace too small: %zu < %zu\n", ws_size, (size_t)WS_END);
  }
  Params p{};
  const float** f = (const float**)&p;
  for (int i = 0; i < 29; ++i) f[i] = (const float*)d_in[i];
  p.out = (float*)d_out; p.ws = (unsigned char*)d_ws;
#if MULTI_LAUNCH
  for (int ph = 0; ph < NPHASES; ++ph) {
    p.ph_lo = ph; p.ph_hi = ph + 1;
    hipLaunchKernelGGL(mega, dim3(grid_blocks), dim3(NTHREADS), GEMM_LDS_BYTES, stream, p);
  }
#else
  p.ph_lo = 0; p.ph_hi = NPHASES;
  hipMemsetAsync((unsigned char*)d_ws + WS_BAR, 0, 16384, stream);
  void* args[] = {&p};
  hipError_t e = hipLaunchCooperativeKernel((const void*)mega, dim3(grid_blocks), dim3(NTHREADS), args, GEMM_LDS_BYTES, stream);
  if (e != hipSuccess) fprintf(stderr, "cooperative launch failed: %s (grid %d)\n", hipGetErrorString(e), grid_blocks);
#endif
}
#endif
```

```cpp
#include <hip/hip_runtime.h>
#include <hip/hip_cooperative_groups.h>
#include <cstdio>
namespace cg = cooperative_groups;

typedef unsigned short bf16_t;
typedef __attribute__((ext_vector_type(8))) short bf16x8;
typedef __attribute__((ext_vector_type(4))) short bf16x4;
typedef __attribute__((ext_vector_type(16))) float f32x16;
typedef __attribute__((ext_vector_type(4))) float f32x4;
#define DI __device__ __forceinline__
typedef __attribute__((address_space(3))) unsigned lds_u32;

constexpr int D = 1024;
constexpr int NB = 4;
constexpr int SEQ = 4096;
constexpr int CTX = 256;
constexpr int TPB = SEQ + CTX;
constexpr int NT = NB * TPB;
constexpr int NTHREADS = 256;
constexpr int GDN_R = 8;
constexpr int GDN_NCH = 68;
constexpr int GDN_ROUNDS = (GDN_NCH + GDN_R - 1) / GDN_R;

constexpr size_t MiB = 1024 * 1024;
constexpr size_t UNIT = (size_t)NT * 1024 * 2;
constexpr size_t WS_MOD = 0;
constexpr size_t WS_BAR = 245760;
constexpr size_t WS_HCTX = 262144;
constexpr size_t WS_AB = WS_HCTX + 4 * MiB;
constexpr size_t WS_SST = WS_AB + (size_t)NT * 32 * 4;
constexpr size_t WS_WT = WS_SST + 4 * MiB;
constexpr size_t WT_S5_IN = 0;
constexpr size_t WT_S5_GLU = WT_S5_IN + 4 * MiB;
constexpr size_t WT_S5_OUT = WT_S5_GLU + 4 * MiB;
constexpr size_t WT_S5_APOW = WT_S5_OUT + 2 * MiB;
constexpr size_t WT_S5_BBAR = WT_S5_APOW + 2 * 64 * 17 * 64 * 8;
constexpr size_t WT_S5_KTAB = WT_S5_BBAR + 2 * 64 * 64 * 16 * 8;
constexpr size_t WT_S5_OPT = WT_S5_KTAB + 2 * 64 * 16 * 256 * 4;
constexpr size_t WT_S5_BPT = WT_S5_OPT + (size_t)64 * 256 * 512 * 2;
constexpr size_t WT_S5_END = WT_S5_BPT + (size_t)64 * 256 * 256 * 2;
constexpr size_t WT_G_IN = 0;
constexpr size_t WT_G_OUT = WT_G_IN + (size_t)4224 * 1024 * 2;
constexpr size_t WT_G_HALO = WT_G_OUT + 2 * MiB;
constexpr size_t WT_G_W = WT_G_HALO + (size_t)272 * 4 * 3072 * 2;
constexpr size_t WT_G_AQK = WT_G_W + (size_t)2 * 64 * GDN_R * 64 * 128 * 2;
constexpr size_t WT_G_GC = WT_G_AQK + (size_t)64 * GDN_R * 64 * 64 * 2;
constexpr size_t WT_G_END = WT_G_GC + (size_t)2 * 64 * GDN_R * 64 * 4;
static_assert((size_t)64 * GDN_R * 64 * 64 * 2 <= (size_t)272 * 4 * 3072 * 2, "Aqk set 1 must fit the halo region");
constexpr size_t WT_N_IN = 0;
constexpr size_t WT_N_OUT = 8 * MiB;
constexpr size_t WT_SIZE = (WT_S5_END > WT_G_END ? WT_S5_END : WT_G_END);
constexpr size_t WS_BIG = (WS_WT + WT_SIZE + 255) / 256 * 256;
constexpr size_t WS_END = WS_BIG + 6 * UNIT;
static_assert(WS_END <= 256 * MiB, "workspace too large");

struct Params {
  const float *x, *c, *ctx, *c_ctx, *ada_w, *ada_b, *pre_g, *post_g;
  const float *s5_in_w, *s5_lam_re, *s5_lam_im, *s5_log_dt, *s5_b_re, *s5_b_im, *s5_c_re, *s5_c_im, *s5_d, *s5_glu_w, *s5_glu_b, *s5_out_w;
  const float *gdn_in_w, *gdn_conv_w, *gdn_a_log, *gdn_dt_bias, *gdn_norm_g, *gdn_out_w;
  const float *na_in_w, *na_rpb, *na_out_w;
  float* out;
  unsigned char* ws;
  int ph_lo, ph_hi;
};

DI bf16_t f2bf(float x) { return __builtin_bit_cast(unsigned short, (__bf16)x); }
typedef __attribute__((ext_vector_type(2))) __bf16 bf16v2;
typedef __attribute__((ext_vector_type(2))) float f32v2;
DI unsigned pack2bf(float lo, float hi) { f32v2 v = {lo, hi}; return __builtin_bit_cast(unsigned, __builtin_convertvector(v, bf16v2)); }
DI float bf2f(bf16_t b) { return __uint_as_float(((unsigned)b) << 16); }
DI float wsum(float v) {
#pragma unroll
  for (int o = 32; o > 0; o >>= 1) v += __shfl_xor(v, o);
  return v;
}
DI float sigmoidf_(float x) { return __builtin_amdgcn_rcpf(1.f + __expf(-x)); }
DI float siluf_(float x) { return x * __builtin_amdgcn_rcpf(1.f + __expf(-x)); }
DI float geluf_(float x) { float u = 1.5957691216057308f * (x + 0.044715f * x * x * x); return x * __builtin_amdgcn_rcpf(1.f + __expf(-u)); }
DI int crow(int i, int h) { return (i & 3) + 8 * (i >> 2) + 4 * h; }
DI void lds_barrier() { asm volatile("s_waitcnt lgkmcnt(0)" ::: "memory"); __builtin_amdgcn_s_barrier(); asm volatile("" ::: "memory"); }
DI int opaque(int v) { asm volatile("" : "+v"(v)); return v; }
DI int imin(int a, int b) { return a < b ? a : b; }
DI int imax(int a, int b) { return a > b ? a : b; }


#define XB_TMO      128
#define XB_XCNT(j)  (256  + 64 * (j))
#define XB_XSUB(j)  (1280 + 64 * (j))
#define XB_XGEN(j)  (2304 + 64 * (j))
#define XB_TOP      3328
#define XB_TOPGEN   3392
#define XCD_BAR_WORDS 3456
#define XB_SPIN_CAP (1u << 18)
#define LAS __attribute__((address_space(3)))
DI unsigned xb_ld(unsigned* p)              { return __hip_atomic_load(p, __ATOMIC_RELAXED, __HIP_MEMORY_SCOPE_AGENT); }
DI unsigned xb_add(unsigned* p, unsigned v) { return __hip_atomic_fetch_add(p, v, __ATOMIC_RELAXED, __HIP_MEMORY_SCOPE_AGENT); }
DI unsigned xb_xcc_id() { return (unsigned)__builtin_amdgcn_s_getreg((3 << 11) | 20) & 0xFu; }
#define XB_SPIN(cond, bar) do { unsigned _sp = 0; while (cond) { __builtin_amdgcn_s_sleep(1); \
    if ((++_sp & 255u) == 0u) { if (xb_ld(&(bar)[XB_TMO])) break; if (_sp > XB_SPIN_CAP) { atomicAdd(&(bar)[XB_TMO], 1u); break; } } } } while (0)
struct XcdBarrier { unsigned* bar; unsigned x; volatile LAS unsigned* st; };
DI XcdBarrier xcd_barrier_post(unsigned* bar, volatile LAS unsigned* st) {
  XcdBarrier b; b.bar = bar; b.x = xb_xcc_id(); b.st = st;
  if (threadIdx.x == 0) (void)xb_add(&bar[XB_XCNT(b.x)], 1u);
  return b;
}
DI void xcd_barrier_complete(unsigned* bar, unsigned x, unsigned& nloc, unsigned& nx) {
  const unsigned G = gridDim.x * gridDim.y * gridDim.z;
  unsigned sum, cnt, mine, sp = 0u;
  for (;;) {
    sum = 0u; cnt = 0u; mine = 0u;
#pragma unroll
    for (unsigned j = 0; j < 16; ++j) { const unsigned c = xb_ld(&bar[XB_XCNT(j)]); sum += c; cnt += (c > 0u) ? 1u : 0u; mine = (j == x) ? c : mine; }
    if (sum == G) break;
    __builtin_amdgcn_s_sleep(1);
    if ((++sp & 255u) == 0u) { if (xb_ld(&bar[XB_TMO])) break; if (sp > XB_SPIN_CAP) { atomicAdd(&bar[XB_TMO], 1u); break; } }
  }
  nloc = mine > 0u ? mine : 1u; nx = cnt > 0u ? cnt : 1u;
}
DI void xcd_barrier(const XcdBarrier& b) {
  asm volatile("s_waitcnt vmcnt(0)" ::: "memory");
  __syncthreads();
  if (threadIdx.x == 0) {
    unsigned* bar = b.bar;
    __builtin_amdgcn_s_waitcnt(0);
    unsigned nloc = b.st[0], nx = b.st[1];
    if (nloc == 0u) { xcd_barrier_complete(bar, b.x, nloc, nx); b.st[0] = nloc; b.st[1] = nx; }
    const unsigned old = xb_add(&bar[XB_XSUB(b.x)], 1u);
    const unsigned gen = old / nloc;
    if (old + 1u == (gen + 1u) * nloc) {
      __builtin_amdgcn_fence(__ATOMIC_RELEASE, "agent");
      asm volatile("s_waitcnt vmcnt(0)" ::: "memory");
      const unsigned og = xb_add(&bar[XB_TOP], 1u);
      const unsigned tg = og / nx;
      if (og + 1u == (tg + 1u) * nx) xb_add(&bar[XB_TOPGEN], 1u);
      else XB_SPIN(xb_ld(&bar[XB_TOPGEN]) == tg, bar);
      __builtin_amdgcn_fence(__ATOMIC_ACQUIRE, "agent");
      xb_add(&bar[XB_XGEN(b.x)], 1u);
      asm volatile("s_waitcnt vmcnt(0)" ::: "memory");
    } else {
      XB_SPIN(xb_ld(&bar[XB_XGEN(b.x)]) == gen, bar);
      __builtin_amdgcn_fence(__ATOMIC_ACQUIRE, "agent");
      asm volatile("s_waitcnt vmcnt(0)" ::: "memory");
    }
  }
  __syncthreads();
}

DI void convert_wt(const float* __restrict__ W, int K, int N, int Npad, bf16_t* __restrict__ Wt, int mode, float* lds) {
  const int tk = K / 64, tn = Npad / 64;
  for (int t = blockIdx.x; t < tk * tn; t += gridDim.x) {
    const int tid = opaque((int)threadIdx.x);
    const int k0 = (t % tk) * 64, n0 = (t / tk) * 64;
    __syncthreads();
#pragma unroll
    for (int p = 0; p < 4; ++p) {
      const int kk = (tid >> 4) + p * 16, n4 = (tid & 15) * 4;
      float4 v = make_float4(0.f, 0.f, 0.f, 0.f);
      if (n0 + n4 < N) v = *(const float4*)(W + (size_t)(k0 + kk) * N + n0 + n4);
      lds[(n4 + 0) * 65 + kk] = v.x; lds[(n4 + 1) * 65 + kk] = v.y; lds[(n4 + 2) * 65 + kk] = v.z; lds[(n4 + 3) * 65 + kk] = v.w;
    }
    __syncthreads();
    {
      const int nn = tid >> 2, ks = (tid & 3) * 16;
      const int n = n0 + nn; int dst = n;
      if (mode == 1) dst = (n < 1024) ? ((n >> 5) * 64 + (n & 31)) : (((n - 1024) >> 5) * 64 + 32 + ((n - 1024) & 31));
      const float* s = lds + nn * 65 + ks;
      uint4 o0, o1;
      o0.x = pack2bf(s[0], s[1]); o0.y = pack2bf(s[2], s[3]); o0.z = pack2bf(s[4], s[5]); o0.w = pack2bf(s[6], s[7]);
      o1.x = pack2bf(s[8], s[9]); o1.y = pack2bf(s[10], s[11]); o1.z = pack2bf(s[12], s[13]); o1.w = pack2bf(s[14], s[15]);
      uint4* d = (uint4*)(Wt + (size_t)dst * K + k0 + ks);
      d[0] = o0; d[1] = o1;
    }
  }
}

DI void adaln_phase(const Params& P, float* lds) {
  float* part = (float*)(P.ws + WS_BIG);
  float* sc = lds;
  float* red = lds + 5 * 1024;
  bool loaded = false;
  for (int item = blockIdx.x; item < 4 * 48 * 8; item += gridDim.x) {
    const int tid = opaque((int)threadIdx.x);
    if (!loaded) {
      for (int e = tid; e < 5 * 1024; e += 256) {
        int j = e >> 10, k = e & 1023;
        float v = (j < 4) ? P.c[j * 1024 + k] : P.c_ctx[k];
        sc[e] = siluf_(v);
      }
      loaded = true;
    }
    __syncthreads();
    const int ksl = item & 7, cg_ = (item >> 3) % 48, layer = item / (8 * 48);
    const int n0 = cg_ * 64;
    const int col = tid & 63, ks = tid >> 6;
    const int kb = ksl * 128 + ks * 32;
    const float* W = P.ada_w + (size_t)layer * 1024 * 3072 + (size_t)kb * 3072 + n0 + col;
    float wv[32];
#pragma unroll
    for (int i = 0; i < 32; ++i) wv[i] = W[(size_t)i * 3072];
    float a0 = 0, a1 = 0, a2 = 0, a3 = 0, a4 = 0;
#pragma unroll
    for (int i = 0; i < 32; ++i) {
      const int k = kb + i; const float w = wv[i];
      a0 += sc[k] * w; a1 += sc[1024 + k] * w; a2 += sc[2048 + k] * w; a3 += sc[3072 + k] * w; a4 += sc[4096 + k] * w;
    }
    red[(ks * 5 + 0) * 64 + col] = a0; red[(ks * 5 + 1) * 64 + col] = a1; red[(ks * 5 + 2) * 64 + col] = a2;
    red[(ks * 5 + 3) * 64 + col] = a3; red[(ks * 5 + 4) * 64 + col] = a4;
    __syncthreads();
    for (int e = tid; e < 5 * 64; e += 256) {
      int j = e >> 6, cc = e & 63;
      float s = red[(0 * 5 + j) * 64 + cc] + red[(1 * 5 + j) * 64 + cc] + red[(2 * 5 + j) * 64 + cc] + red[(3 * 5 + j) * 64 + cc];
      part[(size_t)ksl * 61440 + (layer * 5 + j) * 3072 + n0 + cc] = s;
    }
  }
}

DI void adaln_reduce(const Params& P) {
  float* mod = (float*)(P.ws + WS_MOD);
  const float* part = (const float*)(P.ws + WS_BIG);
  for (int id = blockIdx.x * 256 + opaque((int)threadIdx.x); id < 61440; id += gridDim.x * 256) {
    float s = P.ada_b[(id / 15360) * 3072 + (id % 3072)];
#pragma unroll
    for (int k = 0; k < 8; ++k) s += part[(size_t)k * 61440 + id];
    mod[id] = s;
  }
}

DI void ew_phase(const Params& P, int prev, int next, const float* __restrict__ O, bf16_t* __restrict__ A) {
  const float* mod = (const float*)(P.ws + WS_MOD);
  float* hctx = (float*)(P.ws + WS_HCTX);
  const int gw = blockIdx.x * 4 + (opaque((int)threadIdx.x) >> 6), nw = gridDim.x * 4;
  for (int tok = gw; tok < NT; tok += nw) {
    const int lane = opaque((int)threadIdx.x) & 63;
    const int b = tok / TPB, pos = tok % TPB;
    const bool isctx = pos < CTX;
    if (isctx && prev == 3) continue;
    const int cj = isctx ? 4 : b;
    const float* hs; float* hd;
    if (isctx) { hd = hctx + (size_t)(b * CTX + pos) * D; hs = (prev <= 0) ? P.ctx + (size_t)(b * CTX + pos) * D : hd; }
    else { hd = P.out + (size_t)(b * SEQ + pos - CTX) * D; hs = (prev <= 0) ? P.x + (size_t)(b * SEQ + pos - CTX) * D : hd; }
    float4 h[4];
#pragma unroll
    for (int j = 0; j < 4; ++j) h[j] = *(const float4*)(hs + j * 256 + lane * 4);
    if (prev >= 0) {
      float4 o[4]; float ss = 0;
#pragma unroll
      for (int j = 0; j < 4; ++j) { o[j] = *(const float4*)(O + (size_t)tok * D + j * 256 + lane * 4); ss += o[j].x * o[j].x + o[j].y * o[j].y + o[j].z * o[j].z + o[j].w * o[j].w; }
      ss = wsum(ss);
      const float rstd = rsqrtf(ss * (1.f / 1024.f) + 1e-6f);
      const float* gt = mod + (prev * 5 + cj) * 3072 + 2048;
      const float* pg = P.post_g + prev * 1024;
#pragma unroll
      for (int j = 0; j < 4; ++j) {
        float4 g4 = *(const float4*)(gt + j * 256 + lane * 4), p4 = *(const float4*)(pg + j * 256 + lane * 4);
        h[j].x += g4.x * o[j].x * rstd * p4.x; h[j].y += g4.y * o[j].y * rstd * p4.y;
        h[j].z += g4.z * o[j].z * rstd * p4.z; h[j].w += g4.w * o[j].w * rstd * p4.w;
        *(float4*)(hd + j * 256 + lane * 4) = h[j];
      }
    }
    if (next >= 0) {
      float ss = 0;
#pragma unroll
      for (int j = 0; j < 4; ++j) ss += h[j].x * h[j].x + h[j].y * h[j].y + h[j].z * h[j].z + h[j].w * h[j].w;
      ss = wsum(ss);
      const float rstd = rsqrtf(ss * (1.f / 1024.f) + 1e-6f);
      const float* sh = mod + (next * 5 + cj) * 3072;
      const float* scl = sh + 1024;
      const float* pg = P.pre_g + next * 1024;
#pragma unroll
      for (int j = 0; j < 4; ++j) {
        float4 s4 = *(const float4*)(sh + j * 256 + lane * 4), c4 = *(const float4*)(scl + j * 256 + lane * 4), p4 = *(const float4*)(pg + j * 256 + lane * 4);
        bf16x4 r;
        r[0] = (short)f2bf(h[j].x * rstd * p4.x * (1.f + c4.x) + s4.x);
        r[1] = (short)f2bf(h[j].y * rstd * p4.y * (1.f + c4.y) + s4.y);
        r[2] = (short)f2bf(h[j].z * rstd * p4.z * (1.f + c4.z) + s4.z);
        r[3] = (short)f2bf(h[j].w * rstd * p4.w * (1.f + c4.w) + s4.w);
        *(bf16x4*)(A + (size_t)tok * D + j * 256 + lane * 4) = r;
      }
    }
  }
}


DI void st_pair(bf16_t* C, size_t ldc, int row_i, int col, float vi, float vi1, int r) {
  const bool odd = (r & 1) != 0;
  const float recv = __shfl_xor(odd ? vi : vi1, 1);
  const float lo = odd ? recv : vi, hi = odd ? vi1 : recv;
  *(unsigned*)(C + (size_t)(row_i + (odd ? 1 : 0)) * ldc + (col & ~1)) = pack2bf(lo, hi);
}

enum { EPI_BF16 = 0, EPI_F32, EPI_S5Y, EPI_GLU, EPI_NAIN, EPI_GDNIN };
struct Gemm {
  const bf16_t* A; long a_rs, a_kbs, a_bs;
  const bf16_t* A2; long a2_rs, a2_kbs, a2_bs; int K1;
  const bf16_t* Bt; long b_bs;
  int M, N, K, batch, epi;
  void* C; long ldc, c_bs;
  const bf16_t* zsrc; const float* bias; void* C2; void* C3;
};
constexpr int LDS_STRIDE = 72;
constexpr int GEMM_LDS_BYTES = 2 * 2 * 128 * LDS_STRIDE * 2;

DI void gemm_epilogue(const Gemm& g, int bt, int row0, int col0, f32x16 (&acc)[2][2]) {
  const int lane = opaque((int)threadIdx.x) & 63, r = lane & 31, h = lane >> 5;
  const bool full = (g.M & 127) == 0;
  if (g.epi == EPI_BF16) {
    bf16_t* C = (bf16_t*)g.C;
#pragma unroll
    for (int mi = 0; mi < 2; ++mi)
#pragma unroll
      for (int ni = 0; ni < 2; ++ni)
#pragma unroll
        for (int i = 0; i < 16; i += 2) {
          int row = row0 + mi * 32 + crow(i, h), col = col0 + ni * 32 + r;
          if (full) st_pair(C, g.ldc, row, col, acc[mi][ni][i], acc[mi][ni][i + 1], r);
          else {
            if (row < g.M) C[(size_t)row * g.ldc + col] = f2bf(acc[mi][ni][i]);
            if (row + 1 < g.M) C[(size_t)(row + 1) * g.ldc + col] = f2bf(acc[mi][ni][i + 1]);
          }
        }
  } else if (g.epi == EPI_F32) {
    float* C = (float*)g.C + (size_t)bt * g.c_bs;
#pragma unroll
    for (int mi = 0; mi < 2; ++mi)
#pragma unroll
      for (int ni = 0; ni < 2; ++ni)
#pragma unroll
        for (int i = 0; i < 16; ++i) {
          int row = row0 + mi * 32 + crow(i, h), col = col0 + ni * 32 + r;
          if (full || row < g.M) C[(size_t)row * g.ldc + col] = acc[mi][ni][i];
        }
  } else if (g.epi == EPI_S5Y) {
    bf16_t* C = (bf16_t*)g.C;
#pragma unroll
    for (int mi = 0; mi < 2; ++mi)
#pragma unroll
      for (int ni = 0; ni < 2; ++ni)
#pragma unroll
        for (int i = 0; i < 16; ++i) {
          int row = row0 + mi * 32 + crow(i, h), col = col0 + ni * 32 + r;
          if (full || row < g.M) {
            int tok = row * 16 + (col >> 4);
            C[(size_t)tok * D + bt * 16 + (col & 15)] = f2bf(geluf_(acc[mi][ni][i]));
          }
        }
  } else if (g.epi == EPI_GLU) {
    bf16_t* C = (bf16_t*)g.C;
    const int oc = (col0 >> 6) * 32 + r;
    const float ba = g.bias[oc], bb = g.bias[1024 + oc];
#pragma unroll
    for (int mi = 0; mi < 2; ++mi)
#pragma unroll
      for (int i = 0; i < 16; i += 2) {
        const int row = row0 + mi * 32 + crow(i, h);
        float y[2];
#pragma unroll
        for (int u = 0; u < 2; ++u) {
          const float ga = acc[mi][0][i + u] + ba, gb = acc[mi][1][i + u] + bb;
          const float z = bf2f(g.zsrc[(size_t)(row + u) * 2048 + 1024 + oc]);
          y[u] = ga * sigmoidf_(gb) * siluf_(z);
        }
        st_pair(C, D, row, oc, y[0], y[1], r);
      }
  } else if (g.epi == EPI_NAIN) {
    bf16_t* C = (bf16_t*)g.C;
    bf16_t* Vt = (bf16_t*)g.C2;
#pragma unroll
    for (int ni = 0; ni < 2; ++ni) {
      const int col = col0 + ni * 32 + r;
      if (col >= 2048 && col < 3072) {
        const int hh = (col - 2048) >> 6, d = (col - 2048) & 63;
#pragma unroll
        for (int mi = 0; mi < 2; ++mi)
#pragma unroll
          for (int q = 0; q < 4; ++q) {
            int row = row0 + mi * 32 + 8 * q + 4 * h;
            int b = row / TPB, pos = row % TPB;
            bf16x4 v;
            v[0] = (short)f2bf(acc[mi][ni][q * 4 + 0]); v[1] = (short)f2bf(acc[mi][ni][q * 4 + 1]);
            v[2] = (short)f2bf(acc[mi][ni][q * 4 + 2]); v[3] = (short)f2bf(acc[mi][ni][q * 4 + 3]);
            *(bf16x4*)(Vt + ((size_t)((b * 16 + hh) * 64 + d)) * TPB + pos) = v;
          }
      } else {
        const float sc = (col < 1024) ? 0.125f : 1.f;
#pragma unroll
        for (int mi = 0; mi < 2; ++mi)
#pragma unroll
          for (int i = 0; i < 16; i += 2) {
            int row = row0 + mi * 32 + crow(i, h);
            st_pair(C, 4096, row, col, acc[mi][ni][i] * sc, acc[mi][ni][i + 1] * sc, r);
          }
      }
    }
  } else if (g.epi == EPI_GDNIN) {
    bf16_t* C = (bf16_t*)g.C;
    float* AB = (float*)g.C2;
    bf16_t* Hb = (bf16_t*)g.C3;
#pragma unroll
    for (int ni = 0; ni < 2; ++ni) {
      const int col = col0 + ni * 32 + r;
      if (col < 4096) {
#pragma unroll
        for (int mi = 0; mi < 2; ++mi)
#pragma unroll
          for (int i = 0; i < 16; i += 2) {
            const int row = row0 + mi * 32 + crow(i, h);
            st_pair(C, 4096, row, col, acc[mi][ni][i], acc[mi][ni][i + 1], r);
            if (mi == 0 && i == 0) { if (h == 0 && col < 3072) { Hb[((size_t)(row >> 6) * 4 + 0) * 3072 + col] = f2bf(acc[mi][ni][0]); Hb[((size_t)(row >> 6) * 4 + 1) * 3072 + col] = f2bf(acc[mi][ni][1]); } }
            if (mi == 1 && i == 14) { if (h == 1 && col < 3072) { Hb[((size_t)(row >> 6) * 4 + 2) * 3072 + col] = f2bf(acc[mi][ni][14]); Hb[((size_t)(row >> 6) * 4 + 3) * 3072 + col] = f2bf(acc[mi][ni][15]); } }
          }
      } else if (col < 4128) {
#pragma unroll
        for (int mi = 0; mi < 2; ++mi)
#pragma unroll
          for (int i = 0; i < 16; ++i) {
            const int row = row0 + mi * 32 + crow(i, h);
            AB[(size_t)row * 32 + col - 4096] = acc[mi][ni][i];
          }
      }
    }
  }
}

DI void gemm_phase(const Gemm& g, unsigned char* smem) {
  bf16_t* sA = (bf16_t*)smem;
  bf16_t* sB = sA + 2 * 128 * 64;
  const int ntm = (g.M + 127) / 128, ntn = g.N / 128, nk = g.K / 64;
  const int tiles = g.batch * ntm * ntn;
  const int xcd = blockIdx.x & 7, loc = blockIdx.x >> 3, nloc = gridDim.x >> 3;
  const int t_lo = (int)((long)tiles * xcd / 8), t_hi = (int)((long)tiles * (xcd + 1) / 8);
  for (int tile = t_lo + loc; tile < t_hi; tile += nloc) {
    const int tid = opaque((int)threadIdx.x), lane = tid & 63, w = tid >> 6, wm = w >> 1, wn = w & 1;
    int bt = tile / (ntm * ntn); const int rem = tile % (ntm * ntn);
    int tm = rem / ntn, tn = rem % ntn;
    if (g.batch == 1 && ntm == 136) {
      const int li = tile - t_lo;
      const int band = li / (8 * ntn), idx = li - band * 8 * ntn;
      int row, col;
      if (band < 2) {
        const int nb = ntn >> 3, fullt = nb << 6;
        if (idx < fullt) { row = (idx & 63) >> 3; col = (idx >> 6) * 8 + (idx & 7); }
        else { const int wr = ntn - 8 * nb, i2 = idx - fullt; row = i2 / wr; col = 8 * nb + i2 % wr; }
      } else { row = 0; col = idx; }
      if (band == 1) col = ntn - 1 - col;
      bt = 0; tm = xcd * 17 + band * 8 + row; tn = col;
    }
    f32x16 acc[2][2];
#pragma unroll
    for (int mi = 0; mi < 2; ++mi)
#pragma unroll
      for (int ni = 0; ni < 2; ++ni)
#pragma unroll
        for (int i = 0; i < 16; ++i) acc[mi][ni][i] = 0.f;
#define STAGE1(KT, BUF, p) { \
        const int q = p * 256 + tid; \
        const int row = q >> 3, pc = q & 7; \
        const int c = pc ^ ((row >> 1) & 7); \
        const int grow = imin(tm * 128 + row, g.M - 1); \
        const int k = (KT) * 64 + c * 8; \
        const bf16_t* pa; \
        if (k < g.K1) pa = g.A + (long)bt * g.a_bs + (long)grow * g.a_rs + (long)(k >> 4) * g.a_kbs + (k & 15); \
        else { const int k2 = k - g.K1; pa = g.A2 + (long)bt * g.a2_bs + (long)grow * g.a2_rs + (long)(k2 >> 4) * g.a2_kbs + (k2 & 15); } \
        const bf16_t* pb = g.Bt + (long)bt * g.b_bs + (long)(tn * 128 + row) * g.K + k; \
        __builtin_amdgcn_global_load_lds((const unsigned*)pa, (lds_u32*)(sA + (BUF) * 8192 + q * 8), 16, 0, 0); \
        __builtin_amdgcn_global_load_lds((const unsigned*)pb, (lds_u32*)(sB + (BUF) * 8192 + q * 8), 16, 0, 0); }
#define STAGE(KT, BUF) { STAGE1(KT, BUF, 0) STAGE1(KT, BUF, 1) STAGE1(KT, BUF, 2) STAGE1(KT, BUF, 3) }
#define COMPUTE(BUF) { \
      const int ra0_ = wm * 64 + (lane & 31), ra1_ = ra0_ + 32, rb0_ = wn * 64 + (lane & 31), rb1_ = rb0_ + 32; \
      _Pragma("unroll") for (int ks = 0; ks < 4; ++ks) { \
        const int c = ks * 2 + (lane >> 5); \
        bf16x8 af0 = *(const bf16x8*)(sA + (BUF) * 8192 + ra0_ * 64 + ((c ^ ((ra0_ >> 1) & 7)) << 3)); \
        bf16x8 af1 = *(const bf16x8*)(sA + (BUF) * 8192 + ra1_ * 64 + ((c ^ ((ra1_ >> 1) & 7)) << 3)); \
        bf16x8 bf0 = *(const bf16x8*)(sB + (BUF) * 8192 + rb0_ * 64 + ((c ^ ((rb0_ >> 1) & 7)) << 3)); \
        bf16x8 bf1 = *(const bf16x8*)(sB + (BUF) * 8192 + rb1_ * 64 + ((c ^ ((rb1_ >> 1) & 7)) << 3)); \
        acc[0][0] = __builtin_amdgcn_mfma_f32_32x32x16_bf16(af0, bf0, acc[0][0], 0, 0, 0); \
        acc[0][1] = __builtin_amdgcn_mfma_f32_32x32x16_bf16(af0, bf1, acc[0][1], 0, 0, 0); \
        acc[1][0] = __builtin_amdgcn_mfma_f32_32x32x16_bf16(af1, bf0, acc[1][0], 0, 0, 0); \
        acc[1][1] = __builtin_amdgcn_mfma_f32_32x32x16_bf16(af1, bf1, acc[1][1], 0, 0, 0); \
      } }
    lds_barrier();
    STAGE(0, 0);
    asm volatile("s_waitcnt vmcnt(0)" ::: "memory");
    lds_barrier();
    for (int kt = 0; kt < nk; kt += 2) {
      STAGE(kt + 1, 1);
      COMPUTE(0);
      asm volatile("s_waitcnt vmcnt(0)" ::: "memory");
      lds_barrier();
      if (kt + 2 < nk) STAGE(kt + 2, 0);
      COMPUTE(1);
      asm volatile("s_waitcnt vmcnt(0)" ::: "memory");
      lds_barrier();
    }
#undef STAGE
#undef STAGE1
#undef COMPUTE
    gemm_epilogue(g, bt, tm * 128 + wm * 64, tn * 128 + wn * 64, acc);
  }
}

DI Gemm gemm_plain(const bf16_t* A, const bf16_t* Bt, int M, int N, int K, int epi, void* C, long ldc) {
  Gemm g{};
  g.A = A; g.a_rs = K; g.a_kbs = 16; g.a_bs = 0; g.A2 = A; g.K1 = K; g.a2_rs = K; g.a2_kbs = 16; g.a2_bs = 0;
  g.Bt = Bt; g.b_bs = 0; g.M = M; g.N = N; g.K = K; g.batch = 1; g.epi = epi; g.C = C; g.ldc = ldc; g.c_bs = 0;
  return g;
}

DI void sincos_red(double ang, float& s, float& c) {
  const double twopi = 6.283185307179586476925286766559;
  double t = ang / twopi; t = t - rint(t);
  float x = (float)(t * twopi);
  s = sinf(x); c = cosf(x);
}
DI void s5_pre_a(const Params& P, int j) {
  float2* apow = (float2*)(P.ws + WS_WT + WT_S5_APOW);
  float2* bbar = (float2*)(P.ws + WS_WT + WT_S5_BBAR);
  for (int id = blockIdx.x * 256 + opaque((int)threadIdx.x); id < 2 * 64 * 64; id += gridDim.x * 256) {
    const int d = id >> 12, g = (id >> 6) & 63, p = id & 63;
    const int base = ((j * 2 + d) * 64 + g);
    const double lr = P.s5_lam_re[base * 64 + p], li = P.s5_lam_im[base * 64 + p];
    const double dt = (double)expf(P.s5_log_dt[base]);
    float are = 1.f, aim = 0.f;
    for (int k = 0; k <= 16; ++k) {
      float mag = expf((float)(k * lr * dt)); float s, c; sincos_red(k * li * dt, s, c);
      apow[((d * 64 + g) * 17 + k) * 64 + p] = make_float2(mag * c, mag * s);
      if (k == 1) { are = mag * c; aim = mag * s; }
    }
    const float lrf = (float)lr, lif = (float)li;
    const float den = lrf * lrf + lif * lif;
    const float fre = ((are - 1.f) * lrf + aim * lif) / den, fim = (aim * lrf - (are - 1.f) * lif) / den;
    for (int c = 0; c < 16; ++c) {
      float br = P.s5_b_re[(size_t)(base * 64 + p) * 16 + c], bi = P.s5_b_im[(size_t)(base * 64 + p) * 16 + c];
      bbar[((d * 64 + g) * 64 + p) * 16 + c] = make_float2(fre * br - fim * bi, fre * bi + fim * br);
    }
  }
}
DI void s5_pre_b(const Params& P, int j) {
  const float2* apow = (const float2*)(P.ws + WS_WT + WT_S5_APOW);
  const float2* bbar = (const float2*)(P.ws + WS_WT + WT_S5_BBAR);
  float* ktab = (float*)(P.ws + WS_WT + WT_S5_KTAB);
  bf16_t* opt = (bf16_t*)(P.ws + WS_WT + WT_S5_OPT);
  bf16_t* bpt = (bf16_t*)(P.ws + WS_WT + WT_S5_BPT);
  const int gt = blockIdx.x * 256 + opaque((int)threadIdx.x), gn = gridDim.x * 256;
  for (int id = gt; id < 2 * 64 * 16 * 256; id += gn) {
    const int c2 = id & 15, c = (id >> 4) & 15, k = (id >> 8) & 15, g = (id >> 12) & 63, d = id >> 18;
    const int base = ((j * 2 + d) * 64 + g);
    const float* cr = P.s5_c_re + (size_t)(base * 16 + c) * 64;
    const float* ci = P.s5_c_im + (size_t)(base * 16 + c) * 64;
    float s = 0.f;
    for (int p = 0; p < 64; ++p) {
      float2 a = apow[((d * 64 + g) * 17 + k) * 64 + p];
      float2 b = bbar[((d * 64 + g) * 64 + p) * 16 + c2];
      float xr = cr[p] * a.x - ci[p] * a.y, xi = cr[p] * a.y + ci[p] * a.x;
      s += xr * b.x - xi * b.y;
    }
    ktab[id] = s;
  }
  for (int id = gt; id < 64 * 256 * 256; id += gn) {
    const int kk = id & 255, n = (id >> 8) & 255, g = id >> 16;
    const int i = kk >> 4, c2 = kk & 15, d = n >> 7, ri = (n >> 6) & 1, p = n & 63;
    const int e = d == 0 ? 15 - i : i;
    float2 a = apow[((d * 64 + g) * 17 + e) * 64 + p];
    float2 b = bbar[((d * 64 + g) * 64 + p) * 16 + c2];
    float re = a.x * b.x - a.y * b.y, im = a.x * b.y + a.y * b.x;
    bpt[id] = f2bf(ri ? im : re);
  }
  for (int id = gt; id < 64 * 256 * 256; id += gn) {
    const int kk = id & 255, n = (id >> 8) & 255, g = id >> 16;
    const int jj = n >> 4, c = n & 15, d = kk >> 7, ri = (kk >> 6) & 1, p = kk & 63;
    const int e = d == 0 ? jj + 1 : 16 - jj;
    const int base = ((j * 2 + d) * 64 + g);
    float2 a = apow[((d * 64 + g) * 17 + e) * 64 + p];
    float cr = P.s5_c_re[(size_t)(base * 16 + c) * 64 + p], ci = P.s5_c_im[(size_t)(base * 16 + c) * 64 + p];
    float re = cr * a.x - ci * a.y, im = cr * a.y + ci * a.x;
    opt[((size_t)g * 256 + n) * 512 + 256 + kk] = f2bf(ri ? -im : re);
  }
}
DI void s5_pre_c(const Params& P, int j) {
  const float* ktab = (const float*)(P.ws + WS_WT + WT_S5_KTAB);
  bf16_t* opt = (bf16_t*)(P.ws + WS_WT + WT_S5_OPT);
  for (int id = blockIdx.x * 256 + opaque((int)threadIdx.x); id < 64 * 256 * 256; id += gridDim.x * 256) {
    const int kk = id & 255, n = (id >> 8) & 255, g = id >> 16;
    const int jj = n >> 4, c = n & 15, i = kk >> 4, c2 = kk & 15;
    float v = 0.f;
    if (i <= jj) v += ktab[(((0 * 64 + g) * 16 + (jj - i)) * 16 + c) * 16 + c2];
    if (i >= jj) v += ktab[(((1 * 64 + g) * 16 + (i - jj)) * 16 + c) * 16 + c2];
    if (i == jj && c == c2) v += P.s5_d[j * 1024 + g * 16 + c];
    opt[((size_t)g * 256 + n) * 512 + kk] = f2bf(v);
  }
}
DI void s5_carry(const Params& P, const float* __restrict__ Sloc, bf16_t* __restrict__ Sin) {
  const float2* apow = (const float2*)(P.ws + WS_WT + WT_S5_APOW);
  const int wv = opaque((int)threadIdx.x) >> 6;
  for (int task = blockIdx.x + gridDim.x * wv; task < 512; task += gridDim.x * 4) {
    const int p = opaque((int)threadIdx.x) & 63;
    const int d = task & 1, b = (task >> 1) & 3, g = task >> 3;
    const float2 a = apow[((d * 64 + g) * 17 + 16) * 64 + p];
    const size_t base = ((size_t)g * 1088 + b * 272) * 256 + d * 128 + p;
    float sr = 0.f, si = 0.f;
    for (int s0 = 0; s0 < 272; s0 += 16) {
      float lr[16], li[16];
#pragma unroll
      for (int u = 0; u < 16; ++u) {
        const int step = s0 + u;
        const int q = d == 0 ? step : (step < 16 ? 15 - step : 287 - step);
        const size_t o = base + (size_t)q * 256;
        lr[u] = Sloc[o]; li[u] = Sloc[o + 64];
      }
#pragma unroll
      for (int u = 0; u < 16; ++u) {
        const int step = s0 + u;
        const int q = d == 0 ? step : (step < 16 ? 15 - step : 287 - step);
        const size_t o = base + (size_t)q * 256;
        Sin[o] = f2bf(sr); Sin[o + 64] = f2bf(si);
        const float nr = a.x * sr - a.y * si + lr[u], ni = a.x * si + a.y * sr + li[u];
        sr = nr; si = ni;
      }
    }
  }
}

template <bool WIN>
DI void na_step(const bf16_t* sK, const bf16_t* sV, const bf16x8 (&qf)[2], float& m, float& lsum, f32x4 (&O)[4],
                const float* __restrict__ rpb, int hd, int r, int r0, int step, int cs, int wq, int start, int lq, int lg) {
  constexpr int NTILE = WIN ? 4 : 8;
  f32x4 S[NTILE];
#pragma unroll
  for (int t = 0; t < NTILE; ++t) {
    const int kidx = WIN ? ((t >> 1) * 64 + cs + (t & 1) * 16 + lq) : (t * 16 + lq);
    f32x4 s = f32x4{0.f, 0.f, 0.f, 0.f};
#pragma unroll
    for (int kk = 0; kk < 2; ++kk) {
      bf16x8 kf = *(const bf16x8*)(sK + kidx * 72 + kk * 32 + lg * 8);
      s = __builtin_amdgcn_mfma_f32_16x16x32_bf16(kf, qf[kk], s, 0, 0, 0);
    }
    S[t] = s;
  }
  if (WIN) {
#pragma unroll
    for (int t = 0; t < NTILE; ++t) {
      const int ro = r0 + step * 2 + (t >> 1) - r + 7;
#pragma unroll
      for (int e = 0; e < 4; ++e) {
        const int col = cs + (t & 1) * 16 + lg * 4 + e;
        const bool valid = (col >= start) && (col < start + 16);
        const int co = imin(imax(col - wq + 15, 0), 30);
        const float bias = rpb[(hd * 15 + ro) * 31 + co];
        S[t][e] = valid ? S[t][e] + bias : -1e30f;
      }
    }
  }
  float mx = -1e30f;
#pragma unroll
  for (int t = 0; t < NTILE; ++t)
#pragma unroll
    for (int e = 0; e < 4; ++e) mx = fmaxf(mx, S[t][e]);
  mx = fmaxf(mx, __shfl_xor(mx, 16)); mx = fmaxf(mx, __shfl_xor(mx, 32));
  const float mnew = fmaxf(m, mx);
  const float alpha = __expf(m - mnew);
  float ps = 0.f;
#pragma unroll
  for (int t = 0; t < NTILE; ++t)
#pragma unroll
    for (int e = 0; e < 4; ++e) { float pv = __expf(S[t][e] - mnew); S[t][e] = pv; ps += pv; }
  lsum = lsum * alpha + ps; m = mnew;
#pragma unroll
  for (int dt = 0; dt < 4; ++dt) O[dt] *= alpha;
#pragma unroll
  for (int pr = 0; pr < NTILE / 2; ++pr) {
    bf16x8 pf;
#pragma unroll
    for (int e = 0; e < 4; ++e) { pf[e] = (short)f2bf(S[2 * pr][e]); pf[4 + e] = (short)f2bf(S[2 * pr + 1][e]); }
    const int pos0 = WIN ? (pr * 64 + cs + lg * 4) : (pr * 32 + lg * 4);
#pragma unroll
    for (int dt = 0; dt < 4; ++dt) {
      const bf16_t* vb = sV + (dt * 16 + lq) * 136;
      bf16x4 lo = *(const bf16x4*)(vb + pos0), hi = *(const bf16x4*)(vb + pos0 + 16);
      bf16x8 vf = __builtin_shufflevector(lo, hi, 0, 1, 2, 3, 4, 5, 6, 7);
      O[dt] = __builtin_amdgcn_mfma_f32_16x16x32_bf16(vf, pf, O[dt], 0, 0, 0);
    }
  }
}

DI void na_attn(const Params& P, const bf16_t* __restrict__ Pb, const bf16_t* __restrict__ Vt, bf16_t* __restrict__ Y, unsigned char* smem) {
  bf16_t* sK = (bf16_t*)smem;
  bf16_t* sV = sK + 128 * 72;
  const float* rpb = P.na_rpb;
  const int xcd_ = blockIdx.x & 7, nloc_ = gridDim.x >> 3;
  for (int job = xcd_ * 544 + (blockIdx.x >> 3); job < (xcd_ + 1) * 544; job += nloc_) {
    const int tid = opaque((int)threadIdx.x);
    const int lane = tid & 63, wv = tid >> 6;
    const int lq = lane & 15, lg = lane >> 4;
    int b, hd, r = 0, r0 = 0, cs = 0, w0 = 0, qtok, s_lo;
    if (job < 4096) { b = job >> 10; hd = (job >> 6) & 15; r = job & 63; w0 = wv * 16; r0 = imin(imax(r - 4, 0), 56); cs = imin(imax(w0 - 8, 0), 32); qtok = b * TPB + CTX + r * 64 + w0 + lq; s_lo = 0; }
    else { int jj = job - 4096; b = jj >> 6; hd = (jj >> 2) & 15; qtok = b * TPB + (jj & 3) * 64 + wv * 16 + lq; s_lo = 4; }
    bf16x8 qf[2];
#pragma unroll
    for (int kk = 0; kk < 2; ++kk) qf[kk] = *(const bf16x8*)(Pb + (size_t)qtok * 4096 + hd * 64 + kk * 32 + lg * 8);
    float m = -1e30f, lsum = 0.f;
    f32x4 O[4];
#pragma unroll
    for (int dt = 0; dt < 4; ++dt) O[dt] = f32x4{0.f, 0.f, 0.f, 0.f};
    const int wq = w0 + lq;
    const int start = imin(imax(wq - 8, 0), 48);
    uint4 rk0, rk1, rk2, rk3, rv0, rv1, rv2, rv3;
    const bf16_t* vrow = Vt + (size_t)((b * 16 + hd) * 64) * TPB;
#define NA_LOAD1(p, RK, RV, STEP) { \
      const int e = tid + p * 256; \
      const int key = e >> 3, part = e & 7; \
      const int ktok = (STEP) < 4 ? (b * TPB + CTX + (r0 + (STEP) * 2 + (key >> 6)) * 64 + (key & 63)) : (b * TPB + ((STEP) - 4) * 128 + key); \
      RK = *(const uint4*)(Pb + (size_t)ktok * 4096 + 1024 + hd * 64 + part * 8); \
      const int d = e >> 4, seg = e & 15; \
      const int vpos = (STEP) < 4 ? (CTX + (r0 + (STEP) * 2 + (seg >> 3)) * 64 + (seg & 7) * 8) : (((STEP) - 4) * 128 + seg * 8); \
      RV = *(const uint4*)(vrow + (size_t)d * TPB + vpos); }
#define NA_LOAD(STEP) { NA_LOAD1(0, rk0, rv0, STEP) NA_LOAD1(1, rk1, rv1, STEP) NA_LOAD1(2, rk2, rv2, STEP) NA_LOAD1(3, rk3, rv3, STEP) }
#define NA_STORE1(p, RK, RV) { \
      const int e = tid + p * 256; \
      *(uint4*)(sK + (e >> 3) * 72 + (e & 7) * 8) = RK; \
      *(uint4*)(sV + (e >> 4) * 136 + (e & 15) * 8) = RV; }
#define NA_STORE() { NA_STORE1(0, rk0, rv0) NA_STORE1(1, rk1, rv1) NA_STORE1(2, rk2, rv2) NA_STORE1(3, rk3, rv3) }
    NA_LOAD(s_lo);
    for (int step = s_lo; step < 6; ++step) {
      __syncthreads();
      NA_STORE();
      __syncthreads();
      if (step + 1 < 6) NA_LOAD(step + 1);
      if (step < 4) na_step<true>(sK, sV, qf, m, lsum, O, rpb, hd, r, r0, step, cs, wq, start, lq, lg);
      else na_step<false>(sK, sV, qf, m, lsum, O, rpb, hd, r, r0, step, cs, wq, start, lq, lg);
    }
#undef NA_LOAD
#undef NA_LOAD1
#undef NA_STORE
#undef NA_STORE1
    lsum += __shfl_xor(lsum, 16); lsum += __shfl_xor(lsum, 32);
    const float inv = 1.f / lsum;
#pragma unroll
    for (int dt = 0; dt < 4; ++dt) {
      const int dcol = hd * 64 + dt * 16 + lg * 4;
      bf16x4 z4 = *(const bf16x4*)(Pb + (size_t)qtok * 4096 + 3072 + dcol);
      bf16x4 o4;
#pragma unroll
      for (int e = 0; e < 4; ++e) o4[e] = (short)f2bf(O[dt][e] * inv * siluf_(bf2f((bf16_t)z4[e])));
      *(bf16x4*)(Y + (size_t)qtok * D + dcol) = o4;
    }
  }
}

DI int gdn_pos(int s, int dir) { return dir == 0 ? s : (s < CTX ? CTX - 1 - s : (TPB + CTX - 1) - s); }

DI unsigned u4c(const uint4& u, int k) { return k == 0 ? u.x : (k == 1 ? u.y : (k == 2 ? u.z : u.w)); }
DI void gdn_conv(const Params& P, bf16_t* __restrict__ Pb, const bf16_t* __restrict__ Hb) {
  for (int item = blockIdx.x; item < 272 * 6; item += gridDim.x) {
    const int tid = opaque((int)threadIdx.x), c8 = tid & 63, tq = tid >> 6;
    const int tile = item / 6, slab = item % 6;
    const int ch = slab * 512 + c8 * 8;
    const int tok0 = tile * 64;
    const int seg_first = ((tok0 % TPB) == 0) || ((tok0 % TPB) == CTX);
    const int seg_last = (((tok0 + 64) % TPB) == 0) || (((tok0 + 64) % TPB) == CTX);
    uint4 raw[20];
#pragma unroll
    for (int i = 0; i < 20; ++i) {
      const int lr = tq * 16 + i - 2;
      uint4 u = make_uint4(0u, 0u, 0u, 0u);
      if (lr >= 0 && lr < 64) u = *(const uint4*)(Pb + (size_t)(tok0 + lr) * 4096 + ch);
      else if (lr < 0) { if (!seg_first) u = *(const uint4*)(Hb + ((size_t)(tile - 1) * 4 + 2 + (lr + 2)) * 3072 + ch); }
      else { if (!seg_last) u = *(const uint4*)(Hb + ((size_t)(tile + 1) * 4 + (lr - 64)) * 3072 + ch); }
      raw[i] = u;
    }
    float w[5][8];
#pragma unroll
    for (int j = 0; j < 5; ++j) {
      const float4 a = *(const float4*)(P.gdn_conv_w + j * 3072 + ch), b = *(const float4*)(P.gdn_conv_w + j * 3072 + ch + 4);
      w[j][0] = a.x; w[j][1] = a.y; w[j][2] = a.z; w[j][3] = a.w; w[j][4] = b.x; w[j][5] = b.y; w[j][6] = b.z; w[j][7] = b.w;
    }
    __syncthreads();
#pragma unroll
    for (int i = 0; i < 16; ++i) {
      float y[8];
#pragma unroll
      for (int e = 0; e < 8; ++e) {
        float acc = 0.f;
#pragma unroll
        for (int j = 0; j < 5; ++j) {
          const unsigned d = u4c(raw[i + j], e >> 1);
          const float v = (e & 1) ? __uint_as_float(d & 0xffff0000u) : __uint_as_float(d << 16);
          acc += w[j][e] * v;
        }
        y[e] = siluf_(acc);
      }
      if (slab < 4) {
        float ss = 0.f;
#pragma unroll
        for (int e = 0; e < 8; ++e) ss += y[e] * y[e];
        ss += __shfl_xor(ss, 1); ss += __shfl_xor(ss, 2); ss += __shfl_xor(ss, 4); ss += __shfl_xor(ss, 8);
        const float rn = rsqrtf(ss + 1e-6f);
#pragma unroll
        for (int e = 0; e < 8; ++e) y[e] *= rn;
      }
      uint4 o;
      o.x = pack2bf(y[0], y[1]); o.y = pack2bf(y[2], y[3]); o.z = pack2bf(y[4], y[5]); o.w = pack2bf(y[6], y[7]);
      *(uint4*)(Pb + (size_t)(tok0 + tq * 16 + i) * 4096 + ch) = o;
    }
    __syncthreads();
  }
}

DI void gdn_prep(const Params& P, const bf16_t* __restrict__ Pb, const float* __restrict__ AB, bf16_t* __restrict__ Ob, int c_lo, int c_hi, int set, unsigned* ctr, unsigned char* smem) {
  bf16_t* sK = (bf16_t*)smem;
  bf16_t* sQ = sK + 64 * 136;
  bf16_t* sV = sQ + 64 * 136;
  float* sL = (float*)(sV + 64 * 136);
  float* sG = sL + 64 * 68;
  float* sBt = sG + 64;
  bf16_t* Wb = (bf16_t*)(P.ws + WS_WT + WT_G_W) + (size_t)set * 512 * 8192;
  bf16_t* Aq = (bf16_t*)(P.ws + WS_WT + (set ? WT_G_HALO : WT_G_AQK));
  float* Gc = (float*)(P.ws + WS_WT + WT_G_GC) + set * 512 * 64;
  int* s_item = (int*)(sBt + 64);
  const int nc = c_hi - c_lo;
  for (;;) {
    __syncthreads();
    if (threadIdx.x == 0) *s_item = (int)atomicAdd(ctr, 1u);
    __syncthreads();
    const int item = *s_item;
    if (item >= 64 * nc) break;
    const int tid = opaque((int)threadIdx.x), lane = tid & 63, w = tid >> 6;
    const int chain = item % 64, lc = item / 64;
    const int cidx = c_lo + lc;
    const int b = chain >> 4, hd = (chain >> 1) & 7, dir = chain & 1;
    const int slot = chain * GDN_R + lc;
    bf16_t* Ub = Ob + (((size_t)(dir * 32 + b * 8 + hd)) * TPB + cidx * 64) * 128;
    __syncthreads();
#pragma unroll
    for (int p = 0; p < 4; ++p) {
      const int e = tid + p * 256; const int row = e >> 4, kc = (e & 15) * 8;
      const int tok = b * TPB + gdn_pos(cidx * 64 + row, dir);
      const bf16_t* src = Pb + (size_t)tok * 4096 + hd * 128 + kc;
      *(uint4*)(sQ + row * 136 + kc) = *(const uint4*)(src);
      *(uint4*)(sK + row * 136 + kc) = *(const uint4*)(src + 1024);
      *(uint4*)(sV + row * 136 + kc) = *(const uint4*)(src + 2048);
    }
    if (tid < 64) {
      const int tok = b * TPB + gdn_pos(cidx * 64 + tid, dir);
      const float araw = AB[(size_t)tok * 32 + dir * 8 + hd] + P.gdn_dt_bias[dir * 8 + hd];
      const float sp = araw > 20.f ? araw : log1pf(__expf(araw));
      float gl = -__expf(P.gdn_a_log[dir * 8 + hd]) * sp;
      const float beta = sigmoidf_(AB[(size_t)tok * 32 + 16 + dir * 8 + hd]);
#pragma unroll
      for (int o = 1; o < 64; o <<= 1) { float t = __shfl_up(gl, o); if (lane >= o) gl += t; }
      sG[tid] = gl; sBt[tid] = beta; sBt[68 + tid] = beta * __expf(gl);
      Gc[slot * 64 + tid] = gl;
    }
    __syncthreads();
    {
      const int mi = w >> 1, ni = w & 1, r = lane & 31, h = lane >> 5;
      f32x16 kk, qk;
#pragma unroll
      for (int i = 0; i < 16; ++i) { kk[i] = 0.f; qk[i] = 0.f; }
#pragma unroll
      for (int ks = 0; ks < 8; ++ks) {
        bf16x8 ak = *(const bf16x8*)(sK + (mi * 32 + r) * 136 + ks * 16 + h * 8);
        bf16x8 aq = *(const bf16x8*)(sQ + (mi * 32 + r) * 136 + ks * 16 + h * 8);
        bf16x8 bk = *(const bf16x8*)(sK + (ni * 32 + r) * 136 + ks * 16 + h * 8);
        kk = __builtin_amdgcn_mfma_f32_32x32x16_bf16(ak, bk, kk, 0, 0, 0);
        qk = __builtin_amdgcn_mfma_f32_32x32x16_bf16(aq, bk, qk, 0, 0, 0);
      }
      const int col = ni * 32 + r;
      const float gcol = sG[col];
#pragma unroll
      for (int i = 0; i < 16; ++i) {
        const int row = mi * 32 + crow(i, h);
        const float grow = sG[row];
        const float dec = (col <= row) ? __expf(grow - gcol) : 0.f;
        sL[row * 68 + col] = (col < row) ? sBt[row] * kk[i] * dec : 0.f;
        Aq[((size_t)slot * 64 + row) * 64 + col] = f2bf(0.08838834764831845f * qk[i] * dec);
      }
    }
    __syncthreads();
    {
      float x[64];
#pragma unroll
      for (int i = 0; i < 64; ++i) x[i] = 0.f;
      const bool isv = tid < 128;
      const bf16_t* srcm = isv ? (sV + tid) : (sK + (tid - 128));
      const float* scl = isv ? sBt : (sBt + 68);
#pragma unroll
      for (int rr = 0; rr < 64; rr += 2) {
        const int ro0 = opaque(rr * 68);
        float a0 = bf2f(srcm[rr * 136]) * scl[rr];
        float a1 = bf2f(srcm[(rr + 1) * 136]) * scl[rr + 1];
        float l10 = 0.f;
#pragma unroll
        for (int c4 = 0; c4 < (rr + 4) / 4; ++c4) {
          const float4 p4 = *(const float4*)(sL + ro0 + c4 * 4);
          const float4 q4 = *(const float4*)(sL + ro0 + 68 + c4 * 4);
          a0 -= p4.x * x[c4 * 4 + 0]; a0 -= p4.y * x[c4 * 4 + 1]; a0 -= p4.z * x[c4 * 4 + 2]; a0 -= p4.w * x[c4 * 4 + 3];
          a1 -= q4.x * x[c4 * 4 + 0]; a1 -= q4.y * x[c4 * 4 + 1]; a1 -= q4.z * x[c4 * 4 + 2]; a1 -= q4.w * x[c4 * 4 + 3];
          if (c4 == rr / 4) l10 = ((rr & 3) == 0) ? q4.x : (((rr & 3) == 2) ? q4.z : 0.f);
        }
        a1 -= l10 * a0;
        asm volatile("" : "+v"(a0), "+v"(a1) :: "memory");
        x[rr] = a0; x[rr + 1] = a1;
      }
      bf16_t* dst = isv ? (Ub + tid) : (Wb + (size_t)slot * 64 * 128 + (tid - 128));
#pragma unroll
      for (int rr = 0; rr < 64; ++rr) dst[rr * 128] = f2bf(x[rr]);
    }
  }
}

struct ChainRegs { bf16x8 a1[8]; bf16x8 aq[4]; uint4 kt[4]; float g; };
DI void chain_load(ChainRegs& R, const bf16_t* __restrict__ Pb, const bf16_t* __restrict__ Wb, const bf16_t* __restrict__ Ub,
                   const bf16_t* __restrict__ Aq, const float* __restrict__ Gc, int slot, int cidx, int b, int hd, int dir, int dvb,
                   int tid, int w, int r, int h) {
  const int strip = w & 1;
  const bf16_t* arow;
  if (w < 2) arow = Wb + ((size_t)slot * 64 + strip * 32 + r) * 128;
  else { const int tok = b * TPB + gdn_pos(cidx * 64 + strip * 32 + r, dir); arow = Pb + (size_t)tok * 4096 + hd * 128; }
#pragma unroll
  for (int ks = 0; ks < 8; ++ks) R.a1[ks] = *(const bf16x8*)(arow + ks * 16 + h * 8);
  if (w < 2) {
    const bf16_t* ub = Ub + (((size_t)(dir * 32 + b * 8 + hd)) * TPB + cidx * 64) * 128 + dvb * 32 + r;
#pragma unroll
    for (int i = 0; i < 16; ++i) R.aq[i >> 3][i & 7] = (short)ub[(strip * 32 + crow(i, h)) * 128];
  } else {
    const bf16_t* aqrow = Aq + ((size_t)slot * 64 + strip * 32 + r) * 64;
#pragma unroll
    for (int ks = 0; ks < 4; ++ks) R.aq[ks] = *(const bf16x8*)(aqrow + ks * 16 + h * 8);
  }
  R.g = (tid < 64) ? Gc[slot * 64 + tid] : 0.f;
}
DI void chain_load_k(ChainRegs& R, const bf16_t* __restrict__ Pb, int cidx, int b, int hd, int dir, int tid) {
#pragma unroll
  for (int p = 0; p < 4; ++p) {
    const int e = tid + p * 256; const int row = e >> 4, kc = (e & 15) * 8;
    const int tok = b * TPB + gdn_pos(cidx * 64 + row, dir);
    R.kt[p] = *(const uint4*)(Pb + (size_t)tok * 4096 + 1024 + hd * 128 + kc);
  }
}
DI void gdn_chain(const Params& P, const bf16_t* __restrict__ Pb, bf16_t* Ob, int c_lo, int c_hi, int set, unsigned char* smem, bool save = true) {
  if (blockIdx.x >= 256) return;
  bf16_t* sSt = (bf16_t*)smem;
  bf16_t* sVn = sSt + 32 * 136;
  bf16_t* sVd = sVn + 32 * 72;
  bf16_t* sKt = sVd + 32 * 72;
  float* sG = (float*)(sKt + 64 * 136);
  const bf16_t* Wb = (const bf16_t*)(P.ws + WS_WT + WT_G_W) + (size_t)set * 512 * 8192;
  const bf16_t* Ub = Ob;
  const bf16_t* Aq = (const bf16_t*)(P.ws + WS_WT + (set ? WT_G_HALO : WT_G_AQK));
  const float* Gc = (const float*)(P.ws + WS_WT + WT_G_GC) + set * 512 * 64;
  float* Sst = (float*)(P.ws + WS_SST);
  const int tid = opaque((int)threadIdx.x), lane = tid & 63, w = tid >> 6, r = lane & 31, h = lane >> 5;
  const int chain = blockIdx.x >> 2, dvb = blockIdx.x & 3;
  const int b = chain >> 4, hd = (chain >> 1) & 7, dir = chain & 1;
  const int strip = w & 1;
  f32x16 S;
  if (c_lo == 0) {
#pragma unroll
    for (int i = 0; i < 16; ++i) S[i] = 0.f;
  } else {
#pragma unroll
    for (int i = 0; i < 16; ++i) S[i] = Sst[((size_t)blockIdx.x * 16 + i) * 256 + tid];
  }
  ChainRegs cur, nxt;
  chain_load(cur, Pb, Wb, Ub, Aq, Gc, chain * GDN_R, c_lo, b, hd, dir, dvb, tid, w, r, h);
  chain_load_k(cur, Pb, c_lo, b, hd, dir, tid);
  nxt = cur;
  const int tid0 = tid;
  for (int cidx = c_lo; cidx < c_hi; ++cidx) {
    const int tid = opaque(tid0), lane = tid & 63, w = tid >> 6, r = lane & 31, h = lane >> 5, strip = w & 1;
    const int slot = chain * GDN_R + (cidx - c_lo);
    __syncthreads();
#pragma unroll
    for (int q = 0; q < 4; ++q) {
      bf16x4 v;
#pragma unroll
      for (int e = 0; e < 4; ++e) v[e] = (short)f2bf(S[q * 4 + e]);
      *(bf16x4*)(sSt + r * 136 + w * 32 + 8 * q + 4 * h) = v;
    }
    if (tid < 64) {
      const float g63w = __shfl(cur.g, 63);
      sG[tid] = __expf(g63w - cur.g);
      sG[64 + tid] = 0.08838834764831845f * __expf(cur.g);
      if (tid == 63) sG[128] = __expf(cur.g);
    }
#pragma unroll
    for (int p = 0; p < 4; ++p) {
      const int e = tid + p * 256; const int row = e >> 4, kc = (e & 15) * 8;
      *(uint4*)(sKt + row * 136 + kc) = cur.kt[p];
    }
    if (cidx + 1 < c_hi) chain_load(nxt, Pb, Wb, Ub, Aq, Gc, slot + 1, cidx + 1, b, hd, dir, dvb, tid, w, r, h);
    __syncthreads();
    f32x16 acc1, acc1b;
#pragma unroll
    for (int i = 0; i < 16; ++i) { acc1[i] = 0.f; acc1b[i] = 0.f; }
#pragma unroll
    for (int ks = 0; ks < 8; ks += 2) {
      bf16x8 bfr0 = *(const bf16x8*)(sSt + r * 136 + ks * 16 + h * 8);
      bf16x8 bfr1 = *(const bf16x8*)(sSt + r * 136 + (ks + 1) * 16 + h * 8);
      acc1 = __builtin_amdgcn_mfma_f32_32x32x16_bf16(cur.a1[ks], bfr0, acc1, 0, 0, 0);
      acc1b = __builtin_amdgcn_mfma_f32_32x32x16_bf16(cur.a1[ks + 1], bfr1, acc1b, 0, 0, 0);
    }
#pragma unroll
    for (int i = 0; i < 16; ++i) acc1[i] += acc1b[i];
    if (w < 2) {
#pragma unroll
      for (int q = 0; q < 4; ++q) {
        bf16x4 vn, vd;
#pragma unroll
        for (int e = 0; e < 4; ++e) {
          const int row = strip * 32 + 8 * q + 4 * h + e;
          const float v = bf2f((bf16_t)cur.aq[(q * 4 + e) >> 3][(q * 4 + e) & 7]) - acc1[q * 4 + e];
          vn[e] = (short)f2bf(v);
          vd[e] = (short)f2bf(v * sG[row]);
        }
        *(bf16x4*)(sVn + r * 72 + strip * 32 + 8 * q + 4 * h) = vn;
        *(bf16x4*)(sVd + r * 72 + strip * 32 + 8 * q + 4 * h) = vd;
      }
    }
    __syncthreads();
    if (cidx + 1 < c_hi) chain_load_k(nxt, Pb, cidx + 1, b, hd, dir, tid);
    if (w >= 2) {
      f32x16 av;
#pragma unroll
      for (int i = 0; i < 16; ++i) av[i] = 0.f;
#pragma unroll
      for (int ks = 0; ks < 4; ++ks) {
        bf16x8 bfr = *(const bf16x8*)(sVn + r * 72 + ks * 16 + h * 8);
        av = __builtin_amdgcn_mfma_f32_32x32x16_bf16(cur.aq[ks], bfr, av, 0, 0, 0);
      }
      bf16_t* ob = Ob + (((size_t)(dir * 32 + b * 8 + hd)) * TPB + cidx * 64) * 128 + dvb * 32 + r;
#pragma unroll
      for (int i = 0; i < 16; ++i) {
        const int row = strip * 32 + crow(i, h);
        const float o = sG[64 + row] * acc1[i] + av[i];
        ob[(size_t)row * 128] = f2bf(o);
      }
    }
    {
      const float eg = sG[128];
      f32x16 d0, d1;
#pragma unroll
      for (int i = 0; i < 16; ++i) { d0[i] = 0.f; d1[i] = 0.f; }
#pragma unroll
      for (int ks = 0; ks < 4; ++ks) {
        bf16x8 af;
#pragma unroll
        for (int j = 0; j < 8; ++j) af[j] = (short)sKt[(ks * 16 + h * 8 + j) * 136 + w * 32 + r];
        bf16x8 bfr = *(const bf16x8*)(sVd + r * 72 + ks * 16 + h * 8);
        if (ks & 1) d1 = __builtin_amdgcn_mfma_f32_32x32x16_bf16(af, bfr, d1, 0, 0, 0);
        else d0 = __builtin_amdgcn_mfma_f32_32x32x16_bf16(af, bfr, d0, 0, 0, 0);
      }
#pragma unroll
      for (int i = 0; i < 16; ++i) S[i] = S[i] * eg + (d0[i] + d1[i]);
    }
    cur = nxt;
  }
  if (save) {
#pragma unroll
    for (int i = 0; i < 16; ++i) Sst[((size_t)blockIdx.x * 16 + i) * 256 + tid] = S[i];
  }
}

DI void gdn_post(const Params& P, const bf16_t* Pb, const bf16_t* __restrict__ Ob, bf16_t* Y, int ldy) {
  const int gw = blockIdx.x * 4 + (opaque((int)threadIdx.x) >> 6), nw = gridDim.x * 4;
  for (int tok = gw; tok < NT; tok += nw) {
    const int lane = opaque((int)threadIdx.x) & 63;
    const int l16 = lane & 15, hq = lane >> 4;
    const float4 ga = *(const float4*)(P.gdn_norm_g + l16 * 8), gb = *(const float4*)(P.gdn_norm_g + l16 * 8 + 4);
    const float gn[8] = {ga.x, ga.y, ga.z, ga.w, gb.x, gb.y, gb.z, gb.w};
    const int b = tok / TPB, pos = tok % TPB;
    const int sf = pos, sr = pos < CTX ? CTX - 1 - pos : (TPB + CTX - 1) - pos;
#pragma unroll
    for (int it = 0; it < 2; ++it) {
      const int hd = it * 4 + hq;
      const uint4 uf = *(const uint4*)(Ob + (((size_t)(0 * 32 + b * 8 + hd)) * TPB + sf) * 128 + l16 * 8);
      const uint4 ur = *(const uint4*)(Ob + (((size_t)(1 * 32 + b * 8 + hd)) * TPB + sr) * 128 + l16 * 8);
      const uint4 uz = *(const uint4*)(Pb + (size_t)tok * 4096 + 3072 + hd * 128 + l16 * 8);
      float o[8], z[8];
#pragma unroll
      for (int k = 0; k < 4; ++k) {
        const unsigned f = u4c(uf, k), r = u4c(ur, k), zz = u4c(uz, k);
        o[2 * k] = __uint_as_float(f << 16) + __uint_as_float(r << 16);
        o[2 * k + 1] = __uint_as_float(f & 0xffff0000u) + __uint_as_float(r & 0xffff0000u);
        z[2 * k] = __uint_as_float(zz << 16); z[2 * k + 1] = __uint_as_float(zz & 0xffff0000u);
      }
      float ss = 0.f;
#pragma unroll
      for (int e = 0; e < 8; ++e) ss += o[e] * o[e];
      ss += __shfl_xor(ss, 1); ss += __shfl_xor(ss, 2); ss += __shfl_xor(ss, 4); ss += __shfl_xor(ss, 8);
      const float rstd = rsqrtf(ss * (1.f / 128.f) + 1e-6f);
      float y[8];
#pragma unroll
      for (int e = 0; e < 8; ++e) y[e] = o[e] * rstd * gn[e] * siluf_(z[e]);
      uint4 ov;
      ov.x = pack2bf(y[0], y[1]); ov.y = pack2bf(y[2], y[3]); ov.z = pack2bf(y[4], y[5]); ov.w = pack2bf(y[6], y[7]);
      *(uint4*)(Y + (size_t)tok * ldy + hd * 128 + l16 * 8) = ov;
    }
  }
}

#ifndef DUP_MASK
#define DUP_MASK 0
#endif
#define NREP(cat) (((DUP_MASK >> (cat)) & 1) ? 2 : 1)
constexpr int PH_S5 = 6;
constexpr int PH_GDN = 5 + GDN_ROUNDS;
constexpr int PH_NA = 3;
constexpr int L0_BASE = 3;
constexpr int E1_PH = L0_BASE + PH_S5;
constexpr int L1_BASE = E1_PH + 1;
constexpr int E2_PH = L1_BASE + PH_GDN;
constexpr int L2_BASE = E2_PH + 1;
constexpr int E3_PH = L2_BASE + PH_NA;
constexpr int PB3_PH = E3_PH + 1;
constexpr int L3_BASE = PB3_PH + 1;
constexpr int E4_PH = L3_BASE + PH_S5;
constexpr int NPHASES = E4_PH + 1;

DI void s5_layer_phase(const Params& P, int j, int sub, unsigned char* smem) {
  unsigned char* big = P.ws + WS_BIG;
  bf16_t* Pb = (bf16_t*)(big);
  bf16_t* A = (bf16_t*)(big + 5 * UNIT);
  float* Sloc = (float*)(big + 2 * UNIT);
  bf16_t* Sin = (bf16_t*)(big + 4 * UNIT);
  bf16_t* Y1 = (bf16_t*)(big + 5 * UNIT);
  bf16_t* Y2 = (bf16_t*)(big + 2 * UNIT);
  float* O = (float*)(big + 3 * UNIT);
  unsigned char* wt = P.ws + WS_WT;
  switch (sub) {
    case 0: {
      for (int rep_ = 0; rep_ < NREP(6); ++rep_) s5_pre_c(P, j);
      Gemm g = gemm_plain(A, (const bf16_t*)(wt + WT_S5_IN), NT, 2048, 1024, EPI_BF16, Pb, 2048);
      for (int rep_ = 0; rep_ < NREP(0); ++rep_) gemm_phase(g, smem);
    } break;
    case 1: {
      Gemm g{};
      g.A = Pb; g.a_rs = 16 * 2048; g.a_kbs = 2048; g.a_bs = 16; g.A2 = Pb; g.a2_rs = g.a_rs; g.a2_kbs = g.a_kbs; g.a2_bs = 16; g.K1 = 256;
      g.Bt = (const bf16_t*)(wt + WT_S5_BPT); g.b_bs = 256 * 256; g.M = 1088; g.N = 256; g.K = 256; g.batch = 64; g.epi = EPI_F32;
      g.C = Sloc; g.ldc = 256; g.c_bs = 1088 * 256;
      for (int rep_ = 0; rep_ < NREP(0); ++rep_) gemm_phase(g, smem);
    } break;
    case 2: for (int rep_ = 0; rep_ < NREP(3); ++rep_) s5_carry(P, Sloc, Sin); break;
    case 3: {
      Gemm g{};
      g.A = Pb; g.a_rs = 16 * 2048; g.a_kbs = 2048; g.a_bs = 16; g.K1 = 256;
      g.A2 = Sin; g.a2_rs = 256; g.a2_kbs = 16; g.a2_bs = 1088 * 256;
      g.Bt = (const bf16_t*)(wt + WT_S5_OPT); g.b_bs = 256 * 512; g.M = 1088; g.N = 256; g.K = 512; g.batch = 64; g.epi = EPI_S5Y;
      g.C = Y1;
      for (int rep_ = 0; rep_ < NREP(0); ++rep_) gemm_phase(g, smem);
    } break;
    case 4: {
      Gemm g = gemm_plain(Y1, (const bf16_t*)(wt + WT_S5_GLU), NT, 2048, 1024, EPI_GLU, Y2, 1024);
      g.zsrc = Pb; g.bias = P.s5_glu_b + j * 2048;
      for (int rep_ = 0; rep_ < NREP(0); ++rep_) gemm_phase(g, smem);
    } break;
    case 5: {
      Gemm g = gemm_plain(Y2, (const bf16_t*)(wt + WT_S5_OUT), NT, 1024, 1024, EPI_F32, O, 1024);
      for (int rep_ = 0; rep_ < NREP(0); ++rep_) gemm_phase(g, smem);
    } break;
    default: break;
  }
}
DI void s5_convert(const Params& P, int j, float* lds) {
  unsigned char* wt = P.ws + WS_WT;
  convert_wt(P.s5_in_w + (size_t)j * 1024 * 2048, 1024, 2048, 2048, (bf16_t*)(wt + WT_S5_IN), 0, lds);
  convert_wt(P.s5_glu_w + (size_t)j * 1024 * 2048, 1024, 2048, 2048, (bf16_t*)(wt + WT_S5_GLU), 1, lds);
  convert_wt(P.s5_out_w + (size_t)j * 1024 * 1024, 1024, 1024, 1024, (bf16_t*)(wt + WT_S5_OUT), 0, lds);
}

DI void run_phase(const Params& P, int ph, unsigned char* smem) {
  unsigned char* big = P.ws + WS_BIG;
  unsigned char* wt = P.ws + WS_WT;
  float* lds = (float*)smem;
  if (ph == 0) { for (int rep_ = 0; rep_ < NREP(6); ++rep_) { adaln_phase(P, lds); s5_convert(P, 0, lds); s5_pre_a(P, 0); } return; }
  if (ph == 1) { for (int rep_ = 0; rep_ < NREP(6); ++rep_) { adaln_reduce(P); s5_pre_b(P, 0); } return; }
  if (ph == 2) { ew_phase(P, -1, 0, nullptr, (bf16_t*)(big + 5 * UNIT)); return; }
  if (ph >= L0_BASE && ph < E1_PH) { s5_layer_phase(P, 0, ph - L0_BASE, smem); return; }
  if (ph == E1_PH) {
    ew_phase(P, 0, 1, (const float*)(big + 3 * UNIT), (bf16_t*)(big + 5 * UNIT));
    for (int rep_ = 0; rep_ < NREP(6); ++rep_) {
    convert_wt(P.gdn_in_w, 1024, 4128, 4224, (bf16_t*)(wt + WT_G_IN), 0, lds);
    convert_wt(P.gdn_out_w, 1024, 1024, 1024, (bf16_t*)(wt + WT_G_OUT), 0, lds); }
    return;
  }
  if (ph >= L1_BASE && ph < E2_PH) {
    const int sub = ph - L1_BASE;
    bf16_t* Pb = (bf16_t*)big;
    bf16_t* A = (bf16_t*)(big + 5 * UNIT);
    bf16_t* Ob = (bf16_t*)(big + 4 * UNIT);
    float* AB = (float*)(P.ws + WS_AB);
    bf16_t* Hb = (bf16_t*)(wt + WT_G_HALO);
    if (sub == 0) {
      Gemm g = gemm_plain(A, (const bf16_t*)(wt + WT_G_IN), NT, 4224, 1024, EPI_GDNIN, Pb, 4096);
      g.C2 = AB; g.C3 = Hb;
      for (int rep_ = 0; rep_ < NREP(0); ++rep_) gemm_phase(g, smem);
    } else if (sub == 1) {
      gdn_conv(P, Pb, Hb);
    } else if (sub < 3 + GDN_ROUNDS) {
      unsigned* ctr = (unsigned*)(P.ws + WS_BAR) + XCD_BAR_WORDS;
      const int rd = sub - 3;
      if (rd >= 0) { const int c_lo = rd * GDN_R, c_hi = imin(GDN_NCH, c_lo + GDN_R); gdn_chain(P, Pb, Ob, c_lo, c_hi, rd & 1, smem); }
      const int pr = rd + 1;
      if (pr < GDN_ROUNDS) { const int c_lo = pr * GDN_R, c_hi = imin(GDN_NCH, c_lo + GDN_R); gdn_prep(P, Pb, AB, Ob, c_lo, c_hi, pr & 1, ctr + pr * 16, smem); }
    } else if (sub == 3 + GDN_ROUNDS) {
      for (int rep_ = 0; rep_ < NREP(6); ++rep_) gdn_post(P, Pb, Ob, Pb, 4096);
    } else {
      Gemm g = gemm_plain(Pb, (const bf16_t*)(wt + WT_G_OUT), NT, 1024, 1024, EPI_F32, (float*)(big + 4 * UNIT), 1024);
      g.a_rs = 4096; g.a2_rs = 4096;
      for (int rep_ = 0; rep_ < NREP(0); ++rep_) gemm_phase(g, smem);
    }
    return;
  }
  if (ph == E2_PH) {
    ew_phase(P, 1, 2, (const float*)(big + 4 * UNIT), (bf16_t*)(big));
    for (int rep_ = 0; rep_ < NREP(6); ++rep_) {
    convert_wt(P.na_in_w, 1024, 4096, 4096, (bf16_t*)(wt + WT_N_IN), 0, lds);
    convert_wt(P.na_out_w, 1024, 1024, 1024, (bf16_t*)(wt + WT_N_OUT), 0, lds); }
    return;
  }
  if (ph >= L2_BASE && ph < E3_PH) {
    const int sub = ph - L2_BASE;
    bf16_t* A = (bf16_t*)big;
    bf16_t* Pb = (bf16_t*)(big + 1 * UNIT);
    bf16_t* Vt = (bf16_t*)(big + 5 * UNIT);
    bf16_t* Y1 = (bf16_t*)big;
    float* O = (float*)(big + 1 * UNIT);
    if (sub == 0) {
      Gemm g = gemm_plain(A, (const bf16_t*)(wt + WT_N_IN), NT, 4096, 1024, EPI_NAIN, Pb, 4096);
      g.C2 = Vt;
      for (int rep_ = 0; rep_ < NREP(0); ++rep_) gemm_phase(g, smem);
    } else if (sub == 1) {
      for (int rep_ = 0; rep_ < NREP(1); ++rep_) na_attn(P, Pb, Vt, Y1, smem);
    } else {
      Gemm g = gemm_plain(Y1, (const bf16_t*)(wt + WT_N_OUT), NT, 1024, 1024, EPI_F32, O, 1024);
      for (int rep_ = 0; rep_ < NREP(0); ++rep_) gemm_phase(g, smem);
    }
    return;
  }
  if (ph == E3_PH) {
    ew_phase(P, 2, 3, (const float*)(big + 1 * UNIT), (bf16_t*)(big + 5 * UNIT));
    for (int rep_ = 0; rep_ < NREP(6); ++rep_) { s5_convert(P, 1, lds); s5_pre_a(P, 1); }
    return;
  }
  if (ph == PB3_PH) { for (int rep_ = 0; rep_ < NREP(6); ++rep_) s5_pre_b(P, 1); return; }
  if (ph >= L3_BASE && ph < E4_PH) { s5_layer_phase(P, 1, ph - L3_BASE, smem); return; }
  if (ph == E4_PH) { ew_phase(P, 3, -1, (const float*)(big + 3 * UNIT), nullptr); return; }
}

#ifndef NO_MEGA
__global__ void __launch_bounds__(NTHREADS, 2) mega(Params P) {
  extern __shared__ __attribute__((aligned(16))) unsigned char smem[];
  __shared__ uint4 xb_words;
  cg::grid_group grid = cg::this_grid();
  if (threadIdx.x == 0) xb_words = make_uint4(0u, 0u, 0u, 0u);
  __syncthreads();
  XcdBarrier xb = xcd_barrier_post((unsigned*)(P.ws + WS_BAR), (volatile LAS unsigned*)&xb_words);
  if (P.ph_lo < 0) grid.sync();
  for (int ph = P.ph_lo; ph < P.ph_hi; ++ph) {
    run_phase(P, ph, smem);
    if (ph + 1 < P.ph_hi) { xcd_barrier(xb); if (DUP_MASK & 32) xcd_barrier(xb); }
  }
}

#ifndef MULTI_LAUNCH
#define MULTI_LAUNCH 0
#endif

extern "C" void kernel_launch(void* const* d_in, const int* in_sizes, int n_in, void* d_out, int out_size, void* d_ws, size_t ws_size, hipStream_t stream) {
  static int grid_blocks = 0;
  if (!grid_blocks) {
    int dev = 0, cus = 0, per_cu = 0;
    hipGetDevice(&dev);
    hipDeviceGetAttribute(&cus, hipDeviceAttributeMultiprocessorCount, dev);
    hipFuncSetAttribute((const void*)mega, hipFuncAttributeMaxDynamicSharedMemorySize, GEMM_LDS_BYTES);
    hipOccupancyMaxActiveBlocksPerMultiprocessor(&per_cu, (const void*)mega, NTHREADS, GEMM_LDS_BYTES);
    if (per_cu > 2) per_cu = 2;
    if (per_cu < 1) per_cu = 1;
    grid_blocks = cus * per_cu;
    if (ws_size < WS_END) fprintf(stderr, "kernel_launch: workspace too small: %zu < %zu\n", ws_size, (size_t)WS_END);
  }
  Params p{};
  const float** f = (const float**)&p;
  for (int i = 0; i < 29; ++i) f[i] = (const float*)d_in[i];
  p.out = (float*)d_out; p.ws = (unsigned char*)d_ws;
#if MULTI_LAUNCH
  for (int ph = 0; ph < NPHASES; ++ph) {
    p.ph_lo = ph; p.ph_hi = ph + 1;
    hipLaunchKernelGGL(mega, dim3(grid_blocks), dim3(NTHREADS), GEMM_LDS_BYTES, stream, p);
  }
#else
  p.ph_lo = 0; p.ph_hi = NPHASES;
  hipMemsetAsync((unsigned char*)d_ws + WS_BAR, 0, 16384, stream);
  void* args[] = {&p};
  hipError_t e = hipLaunchCooperativeKernel((const void*)mega, dim3(grid_blocks), dim3(NTHREADS), args, GEMM_LDS_BYTES, stream);
  if (e != hipSuccess) fprintf(stderr, "cooperative launch failed: %s (grid %d)\n", hipGetErrorString(e), grid_blocks);
#endif
}
#endif
```

```cpp
#include <hip/hip_runtime.h>
#include <hip/hip_cooperative_groups.h>
#include <cstdio>
namespace cg = cooperative_groups;

typedef unsigned short bf16_t;
typedef __attribute__((ext_vector_type(8))) short bf16x8;
typedef __attribute__((ext_vector_type(4))) short bf16x4;
typedef __attribute__((ext_vector_type(16))) float f32x16;
typedef __attribute__((ext_vector_type(4))) float f32x4;
#define DI __device__ __forceinline__
typedef __attribute__((address_space(3))) unsigned lds_u32;

constexpr int D = 1024;
constexpr int NB = 4;
constexpr int SEQ = 4096;
constexpr int CTX = 256;
constexpr int TPB = SEQ + CTX;
constexpr int NT = NB * TPB;
constexpr int NTHREADS = 256;
constexpr int GDN_R = 8;
constexpr int GDN_NCH = 68;
constexpr int GDN_ROUNDS = (GDN_NCH + GDN_R - 1) / GDN_R;

constexpr size_t MiB = 1024 * 1024;
constexpr size_t UNIT = (size_t)NT * 1024 * 2;
constexpr size_t WS_MOD = 0;
constexpr size_t WS_BAR = 245760;
constexpr size_t WS_HCTX = 262144;
constexpr size_t WS_AB = WS_HCTX + 4 * MiB;
constexpr size_t WS_SST = WS_AB + (size_t)NT * 32 * 4;
constexpr size_t WS_WT = WS_SST + 4 * MiB;
constexpr size_t WT_S5_IN = 0;
constexpr size_t WT_S5_GLU = WT_S5_IN + 4 * MiB;
constexpr size_t WT_S5_OUT = WT_S5_GLU + 4 * MiB;
constexpr size_t WT_S5_APOW = WT_S5_OUT + 2 * MiB;
constexpr size_t WT_S5_BBAR = WT_S5_APOW + 2 * 64 * 17 * 64 * 8;
constexpr size_t WT_S5_KTAB = WT_S5_BBAR + 2 * 64 * 64 * 16 * 8;
constexpr size_t WT_S5_OPT = WT_S5_KTAB + 2 * 64 * 16 * 256 * 4;
constexpr size_t WT_S5_BPT = WT_S5_OPT + (size_t)64 * 256 * 512 * 2;
constexpr size_t WT_S5_END = WT_S5_BPT + (size_t)64 * 256 * 256 * 2;
constexpr size_t WT_G_IN = 0;
constexpr size_t WT_G_OUT = WT_G_IN + (size_t)4224 * 1024 * 2;
constexpr size_t WT_G_HALO = WT_G_OUT + 2 * MiB;
constexpr size_t WT_G_W = WT_G_HALO + (size_t)272 * 4 * 3072 * 2;
constexpr size_t WT_G_AQK = WT_G_W + (size_t)2 * 64 * GDN_R * 64 * 128 * 2;
constexpr size_t WT_G_GC = WT_G_AQK + (size_t)64 * GDN_R * 64 * 64 * 2;
constexpr size_t WT_G_END = WT_G_GC + (size_t)2 * 64 * GDN_R * 64 * 4;
static_assert((size_t)64 * GDN_R * 64 * 64 * 2 <= (size_t)272 * 4 * 3072 * 2, "Aqk set 1 must fit the halo region");
constexpr size_t WT_N_IN = 0;
constexpr size_t WT_N_OUT = 8 * MiB;
constexpr size_t WT_SIZE = (WT_S5_END > WT_G_END ? WT_S5_END : WT_G_END);
constexpr size_t WS_BIG = (WS_WT + WT_SIZE + 255) / 256 * 256;
constexpr size_t WS_END = WS_BIG + 6 * UNIT;
static_assert(WS_END <= 256 * MiB, "workspace too large");

struct Params {
  const float *x, *c, *ctx, *c_ctx, *ada_w, *ada_b, *pre_g, *post_g;
  const float *s5_in_w, *s5_lam_re, *s5_lam_im, *s5_log_dt, *s5_b_re, *s5_b_im, *s5_c_re, *s5_c_im, *s5_d, *s5_glu_w, *s5_glu_b, *s5_out_w;
  const float *gdn_in_w, *gdn_conv_w, *gdn_a_log, *gdn_dt_bias, *gdn_norm_g, *gdn_out_w;
  const float *na_in_w, *na_rpb, *na_out_w;
  float* out;
  unsigned char* ws;
  int ph_lo, ph_hi;
};

DI bf16_t f2bf(float x) { return __builtin_bit_cast(unsigned short, (__bf16)x); }
typedef __attribute__((ext_vector_type(2))) __bf16 bf16v2;
typedef __attribute__((ext_vector_type(2))) float f32v2;
DI unsigned pack2bf(float lo, float hi) { f32v2 v = {lo, hi}; return __builtin_bit_cast(unsigned, __builtin_convertvector(v, bf16v2)); }
DI float bf2f(bf16_t b) { return __uint_as_float(((unsigned)b) << 16); }
DI float wsum(float v) {
#pragma unroll
  for (int o = 32; o > 0; o >>= 1) v += __shfl_xor(v, o);
  return v;
}
DI float sigmoidf_(float x) { return __builtin_amdgcn_rcpf(1.f + __expf(-x)); }
DI float siluf_(float x) { return x * __builtin_amdgcn_rcpf(1.f + __expf(-x)); }
DI float geluf_(float x) { float u = 1.5957691216057308f * (x + 0.044715f * x * x * x); return x * __builtin_amdgcn_rcpf(1.f + __expf(-u)); }
DI int crow(int i, int h) { return (i & 3) + 8 * (i >> 2) + 4 * h; }
DI void lds_barrier() { asm volatile("s_waitcnt lgkmcnt(0)" ::: "memory"); __builtin_amdgcn_s_barrier(); asm volatile("" ::: "memory"); }
DI int opaque(int v) { asm volatile("" : "+v"(v)); return v; }
DI int imin(int a, int b) { return a < b ? a : b; }
DI int imax(int a, int b) { return a > b ? a : b; }


#define XB_TMO      128
#define XB_XCNT(j)  (256  + 64 * (j))
#define XB_XSUB(j)  (1280 + 64 * (j))
#define XB_XGEN(j)  (2304 + 64 * (j))
#define XB_TOP      3328
#define XB_TOPGEN   3392
#define XCD_BAR_WORDS 3456
#define XB_SPIN_CAP (1u << 18)
#define LAS __attribute__((address_space(3)))
DI unsigned xb_ld(unsigned* p)              { return __hip_atomic_load(p, __ATOMIC_RELAXED, __HIP_MEMORY_SCOPE_AGENT); }
DI unsigned xb_add(unsigned* p, unsigned v) { return __hip_atomic_fetch_add(p, v, __ATOMIC_RELAXED, __HIP_MEMORY_SCOPE_AGENT); }
DI unsigned xb_xcc_id() { return (unsigned)__builtin_amdgcn_s_getreg((3 << 11) | 20) & 0xFu; }
#define XB_SPIN(cond, bar) do { unsigned _sp = 0; while (cond) { __builtin_amdgcn_s_sleep(1); \
    if ((++_sp & 255u) == 0u) { if (xb_ld(&(bar)[XB_TMO])) break; if (_sp > XB_SPIN_CAP) { atomicAdd(&(bar)[XB_TMO], 1u); break; } } } } while (0)
struct XcdBarrier { unsigned* bar; unsigned x; volatile LAS unsigned* st; };
DI XcdBarrier xcd_barrier_post(unsigned* bar, volatile LAS unsigned* st) {
  XcdBarrier b; b.bar = bar; b.x = xb_xcc_id(); b.st = st;
  if (threadIdx.x == 0) (void)xb_add(&bar[XB_XCNT(b.x)], 1u);
  return b;
}
DI void xcd_barrier_complete(unsigned* bar, unsigned x, unsigned& nloc, unsigned& nx) {
  const unsigned G = gridDim.x * gridDim.y * gridDim.z;
  unsigned sum, cnt, mine, sp = 0u;
  for (;;) {
    sum = 0u; cnt = 0u; mine = 0u;
#pragma unroll
    for (unsigned j = 0; j < 16; ++j) { const unsigned c = xb_ld(&bar[XB_XCNT(j)]); sum += c; cnt += (c > 0u) ? 1u : 0u; mine = (j == x) ? c : mine; }
    if (sum == G) break;
    __builtin_amdgcn_s_sleep(1);
    if ((++sp & 255u) == 0u) { if (xb_ld(&bar[XB_TMO])) break; if (sp > XB_SPIN_CAP) { atomicAdd(&bar[XB_TMO], 1u); break; } }
  }
  nloc = mine > 0u ? mine : 1u; nx = cnt > 0u ? cnt : 1u;
}
DI void xcd_barrier(const XcdBarrier& b) {
  asm volatile("s_waitcnt vmcnt(0)" ::: "memory");
  __syncthreads();
  if (threadIdx.x == 0) {
    unsigned* bar = b.bar;
    __builtin_amdgcn_s_waitcnt(0);
    unsigned nloc = b.st[0], nx = b.st[1];
    if (nloc == 0u) { xcd_barrier_complete(bar, b.x, nloc, nx); b.st[0] = nloc; b.st[1] = nx; }
    const unsigned old = xb_add(&bar[XB_XSUB(b.x)], 1u);
    const unsigned gen = old / nloc;
    if (old + 1u == (gen + 1u) * nloc) {
      __builtin_amdgcn_fence(__ATOMIC_RELEASE, "agent");
      asm volatile("s_waitcnt vmcnt(0)" ::: "memory");
      const unsigned og = xb_add(&bar[XB_TOP], 1u);
      const unsigned tg = og / nx;
      if (og + 1u == (tg + 1u) * nx) xb_add(&bar[XB_TOPGEN], 1u);
      else XB_SPIN(xb_ld(&bar[XB_TOPGEN]) == tg, bar);
      __builtin_amdgcn_fence(__ATOMIC_ACQUIRE, "agent");
      xb_add(&bar[XB_XGEN(b.x)], 1u);
      asm volatile("s_waitcnt vmcnt(0)" ::: "memory");
    } else {
      XB_SPIN(xb_ld(&bar[XB_XGEN(b.x)]) == gen, bar);
      __builtin_amdgcn_fence(__ATOMIC_ACQUIRE, "agent");
      asm volatile("s_waitcnt vmcnt(0)" ::: "memory");
    }
  }
  __syncthreads();
}

DI void convert_wt(const float* __restrict__ W, int K, int N, int Npad, bf16_t* __restrict__ Wt, int mode, float* lds) {
  const int tk = K / 64, tn = Npad / 64;
  for (int t = blockIdx.x; t < tk * tn; t += gridDim.x) {
    const int tid = opaque((int)threadIdx.x);
    const int k0 = (t % tk) * 64, n0 = (t / tk) * 64;
    __syncthreads();
#pragma unroll
    for (int p = 0; p < 4; ++p) {
      const int kk = (tid >> 4) + p * 16, n4 = (tid & 15) * 4;
      float4 v = make_float4(0.f, 0.f, 0.f, 0.f);
      if (n0 + n4 < N) v = *(const float4*)(W + (size_t)(k0 + kk) * N + n0 + n4);
      lds[(n4 + 0) * 65 + kk] = v.x; lds[(n4 + 1) * 65 + kk] = v.y; lds[(n4 + 2) * 65 + kk] = v.z; lds[(n4 + 3) * 65 + kk] = v.w;
    }
    __syncthreads();
    {
      const int nn = tid >> 2, ks = (tid & 3) * 16;
      const int n = n0 + nn; int dst = n;
      if (mode == 1) dst = (n < 1024) ? ((n >> 5) * 64 + (n & 31)) : (((n - 1024) >> 5) * 64 + 32 + ((n - 1024) & 31));
      const float* s = lds + nn * 65 + ks;
      uint4 o0, o1;
      o0.x = pack2bf(s[0], s[1]); o0.y = pack2bf(s[2], s[3]); o0.z = pack2bf(s[4], s[5]); o0.w = pack2bf(s[6], s[7]);
      o1.x = pack2bf(s[8], s[9]); o1.y = pack2bf(s[10], s[11]); o1.z = pack2bf(s[12], s[13]); o1.w = pack2bf(s[14], s[15]);
      uint4* d = (uint4*)(Wt + (size_t)dst * K + k0 + ks);
      d[0] = o0; d[1] = o1;
    }
  }
}

DI void adaln_phase(const Params& P, float* lds) {
  float* part = (float*)(P.ws + WS_BIG);
  float* sc = lds;
  float* red = lds + 5 * 1024;
  bool loaded = false;
  for (int item = blockIdx.x; item < 4 * 48 * 8; item += gridDim.x) {
    const int tid = opaque((int)threadIdx.x);
    if (!loaded) {
      for (int e = tid; e < 5 * 1024; e += 256) {
        int j = e >> 10, k = e & 1023;
        float v = (j < 4) ? P.c[j * 1024 + k] : P.c_ctx[k];
        sc[e] = siluf_(v);
      }
      loaded = true;
    }
    __syncthreads();
    const int ksl = item & 7, cg_ = (item >> 3) % 48, layer = item / (8 * 48);
    const int n0 = cg_ * 64;
    const int col = tid & 63, ks = tid >> 6;
    const int kb = ksl * 128 + ks * 32;
    const float* W = P.ada_w + (size_t)layer * 1024 * 3072 + (size_t)kb * 3072 + n0 + col;
    float wv[32];
#pragma unroll
    for (int i = 0; i < 32; ++i) wv[i] = W[(size_t)i * 3072];
    float a0 = 0, a1 = 0, a2 = 0, a3 = 0, a4 = 0;
#pragma unroll
    for (int i = 0; i < 32; ++i) {
      const int k = kb + i; const float w = wv[i];
      a0 += sc[k] * w; a1 += sc[1024 + k] * w; a2 += sc[2048 + k] * w; a3 += sc[3072 + k] * w; a4 += sc[4096 + k] * w;
    }
    red[(ks * 5 + 0) * 64 + col] = a0; red[(ks * 5 + 1) * 64 + col] = a1; red[(ks * 5 + 2) * 64 + col] = a2;
    red[(ks * 5 + 3) * 64 + col] = a3; red[(ks * 5 + 4) * 64 + col] = a4;
    __syncthreads();
    for (int e = tid; e < 5 * 64; e += 256) {
      int j = e >> 6, cc = e & 63;
      float s = red[(0 * 5 + j) * 64 + cc] + red[(1 * 5 + j) * 64 + cc] + red[(2 * 5 + j) * 64 + cc] + red[(3 * 5 + j) * 64 + cc];
      part[(size_t)ksl * 61440 + (layer * 5 + j) * 3072 + n0 + cc] = s;
    }
  }
}

DI void adaln_reduce(const Params& P) {
  float* mod = (float*)(P.ws + WS_MOD);
  const float* part = (const float*)(P.ws + WS_BIG);
  for (int id = blockIdx.x * 256 + opaque((int)threadIdx.x); id < 61440; id += gridDim.x * 256) {
    float s = P.ada_b[(id / 15360) * 3072 + (id % 3072)];
#pragma unroll
    for (int k = 0; k < 8; ++k) s += part[(size_t)k * 61440 + id];
    mod[id] = s;
  }
}

DI void ew_phase(const Params& P, int prev, int next, const float* __restrict__ O, bf16_t* __restrict__ A) {
  const float* mod = (const float*)(P.ws + WS_MOD);
  float* hctx = (float*)(P.ws + WS_HCTX);
  const int gw = blockIdx.x * 4 + (opaque((int)threadIdx.x) >> 6), nw = gridDim.x * 4;
  for (int tok = gw; tok < NT; tok += nw) {
    const int lane = opaque((int)threadIdx.x) & 63;
    const int b = tok / TPB, pos = tok % TPB;
    const bool isctx = pos < CTX;
    if (isctx && prev == 3) continue;
    const int cj = isctx ? 4 : b;
    const float* hs; float* hd;
    if (isctx) { hd = hctx + (size_t)(b * CTX + pos) * D; hs = (prev <= 0) ? P.ctx + (size_t)(b * CTX + pos) * D : hd; }
    else { hd = P.out + (size_t)(b * SEQ + pos - CTX) * D; hs = (prev <= 0) ? P.x + (size_t)(b * SEQ + pos - CTX) * D : hd; }
    float4 h[4];
#pragma unroll
    for (int j = 0; j < 4; ++j) h[j] = *(const float4*)(hs + j * 256 + lane * 4);
    if (prev >= 0) {
      float4 o[4]; float ss = 0;
#pragma unroll
      for (int j = 0; j < 4; ++j) { o[j] = *(const float4*)(O + (size_t)tok * D + j * 256 + lane * 4); ss += o[j].x * o[j].x + o[j].y * o[j].y + o[j].z * o[j].z + o[j].w * o[j].w; }
      ss = wsum(ss);
      const float rstd = rsqrtf(ss * (1.f / 1024.f) + 1e-6f);
      const float* gt = mod + (prev * 5 + cj) * 3072 + 2048;
      const float* pg = P.post_g + prev * 1024;
#pragma unroll
      for (int j = 0; j < 4; ++j) {
        float4 g4 = *(const float4*)(gt + j * 256 + lane * 4), p4 = *(const float4*)(pg + j * 256 + lane * 4);
        h[j].x += g4.x * o[j].x * rstd * p4.x; h[j].y += g4.y * o[j].y * rstd * p4.y;
        h[j].z += g4.z * o[j].z * rstd * p4.z; h[j].w += g4.w * o[j].w * rstd * p4.w;
        *(float4*)(hd + j * 256 + lane * 4) = h[j];
      }
    }
    if (next >= 0) {
      float ss = 0;
#pragma unroll
      for (int j = 0; j < 4; ++j) ss += h[j].x * h[j].x + h[j].y * h[j].y + h[j].z * h[j].z + h[j].w * h[j].w;
      ss = wsum(ss);
      const float rstd = rsqrtf(ss * (1.f / 1024.f) + 1e-6f);
      const float* sh = mod + (next * 5 + cj) * 3072;
      const float* scl = sh + 1024;
      const float* pg = P.pre_g + next * 1024;
#pragma unroll
      for (int j = 0; j < 4; ++j) {
        float4 s4 = *(const float4*)(sh + j * 256 + lane * 4), c4 = *(const float4*)(scl + j * 256 + lane * 4), p4 = *(const float4*)(pg + j * 256 + lane * 4);
        bf16x4 r;
        r[0] = (short)f2bf(h[j].x * rstd * p4.x * (1.f + c4.x) + s4.x);
        r[1] = (short)f2bf(h[j].y * rstd * p4.y * (1.f + c4.y) + s4.y);
        r[2] = (short)f2bf(h[j].z * rstd * p4.z * (1.f + c4.z) + s4.z);
        r[3] = (short)f2bf(h[j].w * rstd * p4.w * (1.f + c4.w) + s4.w);
        *(bf16x4*)(A + (size_t)tok * D + j * 256 + lane * 4) = r;
      }
    }
  }
}


DI void st_pair(bf16_t* C, size_t ldc, int row_i, int col, float vi, float vi1, int r) {
  const bool odd = (r & 1) != 0;
  const float recv = __shfl_xor(odd ? vi : vi1, 1);
  const float lo = odd ? recv : vi, hi = odd ? vi1 : recv;
  *(unsigned*)(C + (size_t)(row_i + (odd ? 1 : 0)) * ldc + (col & ~1)) = pack2bf(lo, hi);
}

enum { EPI_BF16 = 0, EPI_F32, EPI_S5Y, EPI_GLU, EPI_NAIN, EPI_GDNIN };
struct Gemm {
  const bf16_t* A; long a_rs, a_kbs, a_bs;
  const bf16_t* A2; long a2_rs, a2_kbs, a2_bs; int K1;
  const bf16_t* Bt; long b_bs;
  int M, N, K, batch, epi;
  void* C; long ldc, c_bs;
  const bf16_t* zsrc; const float* bias; void* C2; void* C3;
};
constexpr int LDS_STRIDE = 72;
constexpr int GEMM_LDS_BYTES = 2 * 2 * 128 * LDS_STRIDE * 2;

DI void gemm_epilogue(const Gemm& g, int bt, int row0, int col0, f32x16 (&acc)[2][2]) {
  const int lane = opaque((int)threadIdx.x) & 63, r = lane & 31, h = lane >> 5;
  const bool full = (g.M & 127) == 0;
  if (g.epi == EPI_BF16) {
    bf16_t* C = (bf16_t*)g.C;
#pragma unroll
    for (int mi = 0; mi < 2; ++mi)
#pragma unroll
      for (int ni = 0; ni < 2; ++ni)
#pragma unroll
        for (int i = 0; i < 16; i += 2) {
          int row = row0 + mi * 32 + crow(i, h), col = col0 + ni * 32 + r;
          if (full) st_pair(C, g.ldc, row, col, acc[mi][ni][i], acc[mi][ni][i + 1], r);
          else {
            if (row < g.M) C[(size_t)row * g.ldc + col] = f2bf(acc[mi][ni][i]);
            if (row + 1 < g.M) C[(size_t)(row + 1) * g.ldc + col] = f2bf(acc[mi][ni][i + 1]);
          }
        }
  } else if (g.epi == EPI_F32) {
    float* C = (float*)g.C + (size_t)bt * g.c_bs;
#pragma unroll
    for (int mi = 0; mi < 2; ++mi)
#pragma unroll
      for (int ni = 0; ni < 2; ++ni)
#pragma unroll
        for (int i = 0; i < 16; ++i) {
          int row = row0 + mi * 32 + crow(i, h), col = col0 + ni * 32 + r;
          if (full || row < g.M) C[(size_t)row * g.ldc + col] = acc[mi][ni][i];
        }
  } else if (g.epi == EPI_S5Y) {
    bf16_t* C = (bf16_t*)g.C;
#pragma unroll
    for (int mi = 0; mi < 2; ++mi)
#pragma unroll
      for (int ni = 0; ni < 2; ++ni)
#pragma unroll
        for (int i = 0; i < 16; ++i) {
          int row = row0 + mi * 32 + crow(i, h), col = col0 + ni * 32 + r;
          if (full || row < g.M) {
            int tok = row * 16 + (col >> 4);
            C[(size_t)tok * D + bt * 16 + (col & 15)] = f2bf(geluf_(acc[mi][ni][i]));
          }
        }
  } else if (g.epi == EPI_GLU) {
    bf16_t* C = (bf16_t*)g.C;
    const int oc = (col0 >> 6) * 32 + r;
    const float ba = g.bias[oc], bb = g.bias[1024 + oc];
#pragma unroll
    for (int mi = 0; mi < 2; ++mi)
#pragma unroll
      for (int i = 0; i < 16; i += 2) {
        const int row = row0 + mi * 32 + crow(i, h);
        float y[2];
#pragma unroll
        for (int u = 0; u < 2; ++u) {
          const float ga = acc[mi][0][i + u] + ba, gb = acc[mi][1][i + u] + bb;
          const float z = bf2f(g.zsrc[(size_t)(row + u) * 2048 + 1024 + oc]);
          y[u] = ga * sigmoidf_(gb) * siluf_(z);
        }
        st_pair(C, D, row, oc, y[0], y[1], r);
      }
  } else if (g.epi == EPI_NAIN) {
    bf16_t* C = (bf16_t*)g.C;
    bf16_t* Vt = (bf16_t*)g.C2;
#pragma unroll
    for (int ni = 0; ni < 2; ++ni) {
      const int col = col0 + ni * 32 + r;
      if (col >= 2048 && col < 3072) {
        const int hh = (col - 2048) >> 6, d = (col - 2048) & 63;
#pragma unroll
        for (int mi = 0; mi < 2; ++mi)
#pragma unroll
          for (int q = 0; q < 4; ++q) {
            int row = row0 + mi * 32 + 8 * q + 4 * h;
            int b = row / TPB, pos = row % TPB;
            bf16x4 v;
            v[0] = (short)f2bf(acc[mi][ni][q * 4 + 0]); v[1] = (short)f2bf(acc[mi][ni][q * 4 + 1]);
            v[2] = (short)f2bf(acc[mi][ni][q * 4 + 2]); v[3] = (short)f2bf(acc[mi][ni][q * 4 + 3]);
            *(bf16x4*)(Vt + ((size_t)((b * 16 + hh) * 64 + d)) * TPB + pos) = v;
          }
      } else {
        const float sc = (col < 1024) ? 0.125f : 1.f;
#pragma unroll
        for (int mi = 0; mi < 2; ++mi)
#pragma unroll
          for (int i = 0; i < 16; i += 2) {
            int row = row0 + mi * 32 + crow(i, h);
            st_pair(C, 4096, row, col, acc[mi][ni][i] * sc, acc[mi][ni][i + 1] * sc, r);
          }
      }
    }
  } else if (g.epi == EPI_GDNIN) {
    bf16_t* C = (bf16_t*)g.C;
    float* AB = (float*)g.C2;
    bf16_t* Hb = (bf16_t*)g.C3;
#pragma unroll
    for (int ni = 0; ni < 2; ++ni) {
      const int col = col0 + ni * 32 + r;
      if (col < 4096) {
#pragma unroll
        for (int mi = 0; mi < 2; ++mi)
#pragma unroll
          for (int i = 0; i < 16; i += 2) {
            const int row = row0 + mi * 32 + crow(i, h);
            st_pair(C, 4096, row, col, acc[mi][ni][i], acc[mi][ni][i + 1], r);
            if (mi == 0 && i == 0) { if (h == 0 && col < 3072) { Hb[((size_t)(row >> 6) * 4 + 0) * 3072 + col] = f2bf(acc[mi][ni][0]); Hb[((size_t)(row >> 6) * 4 + 1) * 3072 + col] = f2bf(acc[mi][ni][1]); } }
            if (mi == 1 && i == 14) { if (h == 1 && col < 3072) { Hb[((size_t)(row >> 6) * 4 + 2) * 3072 + col] = f2bf(acc[mi][ni][14]); Hb[((size_t)(row >> 6) * 4 + 3) * 3072 + col] = f2bf(acc[mi][ni][15]); } }
          }
      } else if (col < 4128) {
#pragma unroll
        for (int mi = 0; mi < 2; ++mi)
#pragma unroll
          for (int i = 0; i < 16; ++i) {
            const int row = row0 + mi * 32 + crow(i, h);
            AB[(size_t)row * 32 + col - 4096] = acc[mi][ni][i];
          }
      }
    }
  }
}

DI void gemm_phase(const Gemm& g, unsigned char* smem) {
  bf16_t* sA = (bf16_t*)smem;
  bf16_t* sB = sA + 2 * 128 * 64;
  const int ntm = (g.M + 127) / 128, ntn = g.N / 128, nk = g.K / 64;
  const int tiles = g.batch * ntm * ntn;
  const int xcd = blockIdx.x & 7, loc = blockIdx.x >> 3, nloc = gridDim.x >> 3;
  const int t_lo = (int)((long)tiles * xcd / 8), t_hi = (int)((long)tiles * (xcd + 1) / 8);
  for (int tile = t_lo + loc; tile < t_hi; tile += nloc) {
    const int tid = opaque((int)threadIdx.x), lane = tid & 63, w = tid >> 6, wm = w >> 1, wn = w & 1;
    int bt = tile / (ntm * ntn); const int rem = tile % (ntm * ntn);
    int tm = rem / ntn, tn = rem % ntn;
    if (g.batch == 1 && ntm == 136) {
      const int li = tile - t_lo;
      const int band = li / (8 * ntn), idx = li - band * 8 * ntn;
      int row, col;
      if (band < 2) {
        const int nb = ntn >> 3, fullt = nb << 6;
        if (idx < fullt) { row = (idx & 63) >> 3; col = (idx >> 6) * 8 + (idx & 7); }
        else { const int wr = ntn - 8 * nb, i2 = idx - fullt; row = i2 / wr; col = 8 * nb + i2 % wr; }
      } else { row = 0; col = idx; }
      if (band == 1) col = ntn - 1 - col;
      bt = 0; tm = xcd * 17 + band * 8 + row; tn = col;
    }
    f32x16 acc[2][2];
#pragma unroll
    for (int mi = 0; mi < 2; ++mi)
#pragma unroll
      for (int ni = 0; ni < 2; ++ni)
#pragma unroll
        for (int i = 0; i < 16; ++i) acc[mi][ni][i] = 0.f;
#define STAGE1(KT, BUF, p) { \
        const int q = p * 256 + tid; \
        const int row = q >> 3, pc = q & 7; \
        const int c = pc ^ ((row >> 1) & 7); \
        const int grow = imin(tm * 128 + row, g.M - 1); \
        const int k = (KT) * 64 + c * 8; \
        const bf16_t* pa; \
        if (k < g.K1) pa = g.A + (long)bt * g.a_bs + (long)grow * g.a_rs + (long)(k >> 4) * g.a_kbs + (k & 15); \
        else { const int k2 = k - g.K1; pa = g.A2 + (long)bt * g.a2_bs + (long)grow * g.a2_rs + (long)(k2 >> 4) * g.a2_kbs + (k2 & 15); } \
        const bf16_t* pb = g.Bt + (long)bt * g.b_bs + (long)(tn * 128 + row) * g.K + k; \
        __builtin_amdgcn_global_load_lds((const unsigned*)pa, (lds_u32*)(sA + (BUF) * 8192 + q * 8), 16, 0, 0); \
        __builtin_amdgcn_global_load_lds((const unsigned*)pb, (lds_u32*)(sB + (BUF) * 8192 + q * 8), 16, 0, 0); }
#define STAGE(KT, BUF) { STAGE1(KT, BUF, 0) STAGE1(KT, BUF, 1) STAGE1(KT, BUF, 2) STAGE1(KT, BUF, 3) }
#define COMPUTE(BUF) { \
      const int ra0_ = wm * 64 + (lane & 31), ra1_ = ra0_ + 32, rb0_ = wn * 64 + (lane & 31), rb1_ = rb0_ + 32; \
      _Pragma("unroll") for (int ks = 0; ks < 4; ++ks) { \
        const int c = ks * 2 + (lane >> 5); \
        bf16x8 af0 = *(const bf16x8*)(sA + (BUF) * 8192 + ra0_ * 64 + ((c ^ ((ra0_ >> 1) & 7)) << 3)); \
        bf16x8 af1 = *(const bf16x8*)(sA + (BUF) * 8192 + ra1_ * 64 + ((c ^ ((ra1_ >> 1) & 7)) << 3)); \
        bf16x8 bf0 = *(const bf16x8*)(sB + (BUF) * 8192 + rb0_ * 64 + ((c ^ ((rb0_ >> 1) & 7)) << 3)); \
        bf16x8 bf1 = *(const bf16x8*)(sB + (BUF) * 8192 + rb1_ * 64 + ((c ^ ((rb1_ >> 1) & 7)) << 3)); \
        acc[0][0] = __builtin_amdgcn_mfma_f32_32x32x16_bf16(af0, bf0, acc[0][0], 0, 0, 0); \
        acc[0][1] = __builtin_amdgcn_mfma_f32_32x32x16_bf16(af0, bf1, acc[0][1], 0, 0, 0); \
        acc[1][0] = __builtin_amdgcn_mfma_f32_32x32x16_bf16(af1, bf0, acc[1][0], 0, 0, 0); \
        acc[1][1] = __builtin_amdgcn_mfma_f32_32x32x16_bf16(af1, bf1, acc[1][1], 0, 0, 0); \
      } }
    lds_barrier();
    STAGE(0, 0);
    asm volatile("s_waitcnt vmcnt(0)" ::: "memory");
    lds_barrier();
    for (int kt = 0; kt < nk; kt += 2) {
      STAGE(kt + 1, 1);
      COMPUTE(0);
      asm volatile("s_waitcnt vmcnt(0)" ::: "memory");
      lds_barrier();
      if (kt + 2 < nk) STAGE(kt + 2, 0);
      COMPUTE(1);
      asm volatile("s_waitcnt vmcnt(0)" ::: "memory");
      lds_barrier();
    }
#undef STAGE
#undef STAGE1
#undef COMPUTE
    gemm_epilogue(g, bt, tm * 128 + wm * 64, tn * 128 + wn * 64, acc);
  }
}

DI Gemm gemm_plain(const bf16_t* A, const bf16_t* Bt, int M, int N, int K, int epi, void* C, long ldc) {
  Gemm g{};
  g.A = A; g.a_rs = K; g.a_kbs = 16; g.a_bs = 0; g.A2 = A; g.K1 = K; g.a2_rs = K; g.a2_kbs = 16; g.a2_bs = 0;
  g.Bt = Bt; g.b_bs = 0; g.M = M; g.N = N; g.K = K; g.batch = 1; g.epi = epi; g.C = C; g.ldc = ldc; g.c_bs = 0;
  return g;
}

DI void sincos_red(double ang, float& s, float& c) {
  const double twopi = 6.283185307179586476925286766559;
  double t = ang / twopi; t = t - rint(t);
  float x = (float)(t * twopi);
  s = sinf(x); c = cosf(x);
}
DI void s5_pre_a(const Params& P, int j) {
  float2* apow = (float2*)(P.ws + WS_WT + WT_S5_APOW);
  float2* bbar = (float2*)(P.ws + WS_WT + WT_S5_BBAR);
  for (int id = blockIdx.x * 256 + opaque((int)threadIdx.x); id < 2 * 64 * 64; id += gridDim.x * 256) {
    const int d = id >> 12, g = (id >> 6) & 63, p = id & 63;
    const int base = ((j * 2 + d) * 64 + g);
    const double lr = P.s5_lam_re[base * 64 + p], li = P.s5_lam_im[base * 64 + p];
    const double dt = (double)expf(P.s5_log_dt[base]);
    float are = 1.f, aim = 0.f;
    for (int k = 0; k <= 16; ++k) {
      float mag = expf((float)(k * lr * dt)); float s, c; sincos_red(k * li * dt, s, c);
      apow[((d * 64 + g) * 17 + k) * 64 + p] = make_float2(mag * c, mag * s);
      if (k == 1) { are = mag * c; aim = mag * s; }
    }
    const float lrf = (float)lr, lif = (float)li;
    const float den = lrf * lrf + lif * lif;
    const float fre = ((are - 1.f) * lrf + aim * lif) / den, fim = (aim * lrf - (are - 1.f) * lif) / den;
    for (int c = 0; c < 16; ++c) {
      float br = P.s5_b_re[(size_t)(base * 64 + p) * 16 + c], bi = P.s5_b_im[(size_t)(base * 64 + p) * 16 + c];
      bbar[((d * 64 + g) * 64 + p) * 16 + c] = make_float2(fre * br - fim * bi, fre * bi + fim * br);
    }
  }
}
DI void s5_pre_b(const Params& P, int j) {
  const float2* apow = (const float2*)(P.ws + WS_WT + WT_S5_APOW);
  const float2* bbar = (const float2*)(P.ws + WS_WT + WT_S5_BBAR);
  float* ktab = (float*)(P.ws + WS_WT + WT_S5_KTAB);
  bf16_t* opt = (bf16_t*)(P.ws + WS_WT + WT_S5_OPT);
  bf16_t* bpt = (bf16_t*)(P.ws + WS_WT + WT_S5_BPT);
  const int gt = blockIdx.x * 256 + opaque((int)threadIdx.x), gn = gridDim.x * 256;
  for (int id = gt; id < 2 * 64 * 16 * 256; id += gn) {
    const int c2 = id & 15, c = (id >> 4) & 15, k = (id >> 8) & 15, g = (id >> 12) & 63, d = id >> 18;
    const int base = ((j * 2 + d) * 64 + g);
    const float* cr = P.s5_c_re + (size_t)(base * 16 + c) * 64;
    const float* ci = P.s5_c_im + (size_t)(base * 16 + c) * 64;
    float s = 0.f;
    for (int p = 0; p < 64; ++p) {
      float2 a = apow[((d * 64 + g) * 17 + k) * 64 + p];
      float2 b = bbar[((d * 64 + g) * 64 + p) * 16 + c2];
      float xr = cr[p] * a.x - ci[p] * a.y, xi = cr[p] * a.y + ci[p] * a.x;
      s += xr * b.x - xi * b.y;
    }
    ktab[id] = s;
  }
  for (int id = gt; id < 64 * 256 * 32; id += gn) {
    const int kk = (id & 31) * 8, n = (id >> 5) & 255, g = id >> 13;
    const int i = kk >> 4, c2b = kk & 15, d = n >> 7, ri = (n >> 6) & 1, p = n & 63;
    const int e = d == 0 ? 15 - i : i;
    const float2 a = apow[((d * 64 + g) * 17 + e) * 64 + p];
    const float2* bp = bbar + ((d * 64 + g) * 64 + p) * 16 + c2b;
    float v[8];
#pragma unroll
    for (int u = 0; u < 8; ++u) { const float2 b = bp[u]; v[u] = ri ? (a.x * b.y + a.y * b.x) : (a.x * b.x - a.y * b.y); }
    uint4 o; o.x = pack2bf(v[0], v[1]); o.y = pack2bf(v[2], v[3]); o.z = pack2bf(v[4], v[5]); o.w = pack2bf(v[6], v[7]);
    *(uint4*)(bpt + ((size_t)(g * 256 + n)) * 256 + kk) = o;
  }
  for (int id = gt; id < 64 * 256 * 32; id += gn) {
    const int kk = (id & 31) * 8, n = (id >> 5) & 255, g = id >> 13;
    const int jj = n >> 4, c = n & 15, d = kk >> 7, ri = (kk >> 6) & 1, p0 = kk & 63;
    const int e = d == 0 ? jj + 1 : 16 - jj;
    const int base = ((j * 2 + d) * 64 + g);
    const float2* ap = apow + ((d * 64 + g) * 17 + e) * 64 + p0;
    const float* crp = P.s5_c_re + (size_t)(base * 16 + c) * 64 + p0;
    const float* cip = P.s5_c_im + (size_t)(base * 16 + c) * 64 + p0;
    float v[8];
#pragma unroll
    for (int u = 0; u < 8; ++u) { const float2 a = ap[u]; const float cr = crp[u], ci = cip[u]; v[u] = ri ? -(cr * a.y + ci * a.x) : (cr * a.x - ci * a.y); }
    uint4 o; o.x = pack2bf(v[0], v[1]); o.y = pack2bf(v[2], v[3]); o.z = pack2bf(v[4], v[5]); o.w = pack2bf(v[6], v[7]);
    *(uint4*)(opt + ((size_t)g * 256 + n) * 512 + 256 + kk) = o;
  }
}
DI void s5_pre_c(const Params& P, int j) {
  const float* ktab = (const float*)(P.ws + WS_WT + WT_S5_KTAB);
  bf16_t* opt = (bf16_t*)(P.ws + WS_WT + WT_S5_OPT);
  for (int id = blockIdx.x * 256 + opaque((int)threadIdx.x); id < 64 * 256 * 32; id += gridDim.x * 256) {
    const int kk = (id & 31) * 8, n = (id >> 5) & 255, g = id >> 13;
    const int jj = n >> 4, c = n & 15, i = kk >> 4, c2b = kk & 15;
    float v[8];
#pragma unroll
    for (int u = 0; u < 8; ++u) v[u] = 0.f;
    if (i <= jj) {
      const float* kp = ktab + (((0 * 64 + g) * 16 + (jj - i)) * 16 + c) * 16 + c2b;
#pragma unroll
      for (int u = 0; u < 8; ++u) v[u] += kp[u];
    }
    if (i >= jj) {
      const float* kp = ktab + (((1 * 64 + g) * 16 + (i - jj)) * 16 + c) * 16 + c2b;
#pragma unroll
      for (int u = 0; u < 8; ++u) v[u] += kp[u];
    }
    if (i == jj) {
      const float dv = P.s5_d[j * 1024 + g * 16 + c];
#pragma unroll
      for (int u = 0; u < 8; ++u) if (c2b + u == c) v[u] += dv;
    }
    uint4 o; o.x = pack2bf(v[0], v[1]); o.y = pack2bf(v[2], v[3]); o.z = pack2bf(v[4], v[5]); o.w = pack2bf(v[6], v[7]);
    *(uint4*)(opt + ((size_t)g * 256 + n) * 512 + kk) = o;
  }
}
DI void s5_carry(const Params& P, const float* __restrict__ Sloc, bf16_t* __restrict__ Sin) {
  const float2* apow = (const float2*)(P.ws + WS_WT + WT_S5_APOW);
  const int wv = opaque((int)threadIdx.x) >> 6;
  for (int task = blockIdx.x + gridDim.x * wv; task < 512; task += gridDim.x * 4) {
    const int p = opaque((int)threadIdx.x) & 63;
    const int d = task & 1, b = (task >> 1) & 3, g = task >> 3;
    const float2 a = apow[((d * 64 + g) * 17 + 16) * 64 + p];
    const size_t base = ((size_t)g * 1088 + b * 272) * 256 + d * 128 + p;
    float sr = 0.f, si = 0.f;
    for (int s0 = 0; s0 < 272; s0 += 16) {
      float lr[16], li[16];
#pragma unroll
      for (int u = 0; u < 16; ++u) {
        const int step = s0 + u;
        const int q = d == 0 ? step : (step < 16 ? 15 - step : 287 - step);
        const size_t o = base + (size_t)q * 256;
        lr[u] = Sloc[o]; li[u] = Sloc[o + 64];
      }
#pragma unroll
      for (int u = 0; u < 16; ++u) {
        const int step = s0 + u;
        const int q = d == 0 ? step : (step < 16 ? 15 - step : 287 - step);
        const size_t o = base + (size_t)q * 256;
        Sin[o] = f2bf(sr); Sin[o + 64] = f2bf(si);
        const float nr = a.x * sr - a.y * si + lr[u], ni = a.x * si + a.y * sr + li[u];
        sr = nr; si = ni;
      }
    }
  }
}

template <bool WIN>
DI void na_step(const bf16_t* sK, const bf16_t* sV, const bf16x8 (&qf)[2], float& m, float& lsum, f32x4 (&O)[4],
                const float* __restrict__ rpb, int hd, int r, int r0, int step, int cs, int wq, int start, int lq, int lg) {
  constexpr int NTILE = WIN ? 4 : 8;
  f32x4 S[NTILE];
#pragma unroll
  for (int t = 0; t < NTILE; ++t) {
    const int kidx = WIN ? ((t >> 1) * 64 + cs + (t & 1) * 16 + lq) : (t * 16 + lq);
    f32x4 s = f32x4{0.f, 0.f, 0.f, 0.f};
#pragma unroll
    for (int kk = 0; kk < 2; ++kk) {
      bf16x8 kf = *(const bf16x8*)(sK + kidx * 72 + kk * 32 + lg * 8);
      s = __builtin_amdgcn_mfma_f32_16x16x32_bf16(kf, qf[kk], s, 0, 0, 0);
    }
    S[t] = s;
  }
  if (WIN) {
#pragma unroll
    for (int t = 0; t < NTILE; ++t) {
      const int ro = r0 + step * 2 + (t >> 1) - r + 7;
#pragma unroll
      for (int e = 0; e < 4; ++e) {
        const int col = cs + (t & 1) * 16 + lg * 4 + e;
        const bool valid = (col >= start) && (col < start + 16);
        const int co = imin(imax(col - wq + 15, 0), 30);
        const float bias = rpb[(hd * 15 + ro) * 31 + co];
        S[t][e] = valid ? S[t][e] + bias : -1e30f;
      }
    }
  }
  float mx = -1e30f;
#pragma unroll
  for (int t = 0; t < NTILE; ++t)
#pragma unroll
    for (int e = 0; e < 4; ++e) mx = fmaxf(mx, S[t][e]);
  mx = fmaxf(mx, __shfl_xor(mx, 16)); mx = fmaxf(mx, __shfl_xor(mx, 32));
  const float mnew = fmaxf(m, mx);
  const float alpha = __expf(m - mnew);
  float ps = 0.f;
#pragma unroll
  for (int t = 0; t < NTILE; ++t)
#pragma unroll
    for (int e = 0; e < 4; ++e) { float pv = __expf(S[t][e] - mnew); S[t][e] = pv; ps += pv; }
  lsum = lsum * alpha + ps; m = mnew;
#pragma unroll
  for (int dt = 0; dt < 4; ++dt) O[dt] *= alpha;
#pragma unroll
  for (int pr = 0; pr < NTILE / 2; ++pr) {
    bf16x8 pf;
#pragma unroll
    for (int e = 0; e < 4; ++e) { pf[e] = (short)f2bf(S[2 * pr][e]); pf[4 + e] = (short)f2bf(S[2 * pr + 1][e]); }
    const int pos0 = WIN ? (pr * 64 + cs + lg * 4) : (pr * 32 + lg * 4);
#pragma unroll
    for (int dt = 0; dt < 4; ++dt) {
      const bf16_t* vb = sV + (dt * 16 + lq) * 136;
      bf16x4 lo = *(const bf16x4*)(vb + pos0), hi = *(const bf16x4*)(vb + pos0 + 16);
      bf16x8 vf = __builtin_shufflevector(lo, hi, 0, 1, 2, 3, 4, 5, 6, 7);
      O[dt] = __builtin_amdgcn_mfma_f32_16x16x32_bf16(vf, pf, O[dt], 0, 0, 0);
    }
  }
}

DI void na_attn(const Params& P, const bf16_t* __restrict__ Pb, const bf16_t* __restrict__ Vt, bf16_t* __restrict__ Y, unsigned char* smem) {
  bf16_t* sK = (bf16_t*)smem;
  bf16_t* sV = sK + 128 * 72;
  const float* rpb = P.na_rpb;
  const int xcd_ = blockIdx.x & 7, nloc_ = gridDim.x >> 3;
  for (int job = xcd_ * 544 + (blockIdx.x >> 3); job < (xcd_ + 1) * 544; job += nloc_) {
    const int tid = opaque((int)threadIdx.x);
    const int lane = tid & 63, wv = tid >> 6;
    const int lq = lane & 15, lg = lane >> 4;
    int b, hd, r = 0, r0 = 0, cs = 0, w0 = 0, qtok, s_lo;
    if (job < 4096) { b = job >> 10; hd = (job >> 6) & 15; r = job & 63; w0 = wv * 16; r0 = imin(imax(r - 4, 0), 56); cs = imin(imax(w0 - 8, 0), 32); qtok = b * TPB + CTX + r * 64 + w0 + lq; s_lo = 0; }
    else { int jj = job - 4096; b = jj >> 6; hd = (jj >> 2) & 15; qtok = b * TPB + (jj & 3) * 64 + wv * 16 + lq; s_lo = 4; }
    bf16x8 qf[2];
#pragma unroll
    for (int kk = 0; kk < 2; ++kk) qf[kk] = *(const bf16x8*)(Pb + (size_t)qtok * 4096 + hd * 64 + kk * 32 + lg * 8);
    float m = -1e30f, lsum = 0.f;
    f32x4 O[4];
#pragma unroll
    for (int dt = 0; dt < 4; ++dt) O[dt] = f32x4{0.f, 0.f, 0.f, 0.f};
    const int wq = w0 + lq;
    const int start = imin(imax(wq - 8, 0), 48);
    uint4 rk0, rk1, rk2, rk3, rv0, rv1, rv2, rv3;
    const bf16_t* vrow = Vt + (size_t)((b * 16 + hd) * 64) * TPB;
#define NA_LOAD1(p, RK, RV, STEP) { \
      const int e = tid + p * 256; \
      const int key = e >> 3, part = e & 7; \
      const int ktok = (STEP) < 4 ? (b * TPB + CTX + (r0 + (STEP) * 2 + (key >> 6)) * 64 + (key & 63)) : (b * TPB + ((STEP) - 4) * 128 + key); \
      RK = *(const uint4*)(Pb + (size_t)ktok * 4096 + 1024 + hd * 64 + part * 8); \
      const int d = e >> 4, seg = e & 15; \
      const int vpos = (STEP) < 4 ? (CTX + (r0 + (STEP) * 2 + (seg >> 3)) * 64 + (seg & 7) * 8) : (((STEP) - 4) * 128 + seg * 8); \
      RV = *(const uint4*)(vrow + (size_t)d * TPB + vpos); }
#define NA_LOAD(STEP) { NA_LOAD1(0, rk0, rv0, STEP) NA_LOAD1(1, rk1, rv1, STEP) NA_LOAD1(2, rk2, rv2, STEP) NA_LOAD1(3, rk3, rv3, STEP) }
#define NA_STORE1(p, RK, RV) { \
      const int e = tid + p * 256; \
      *(uint4*)(sK + (e >> 3) * 72 + (e & 7) * 8) = RK; \
      *(uint4*)(sV + (e >> 4) * 136 + (e & 15) * 8) = RV; }
#define NA_STORE() { NA_STORE1(0, rk0, rv0) NA_STORE1(1, rk1, rv1) NA_STORE1(2, rk2, rv2) NA_STORE1(3, rk3, rv3) }
    NA_LOAD(s_lo);
    for (int step = s_lo; step < 6; ++step) {
      __syncthreads();
      NA_STORE();
      __syncthreads();
      if (step + 1 < 6) NA_LOAD(step + 1);
      if (step < 4) na_step<true>(sK, sV, qf, m, lsum, O, rpb, hd, r, r0, step, cs, wq, start, lq, lg);
      else na_step<false>(sK, sV, qf, m, lsum, O, rpb, hd, r, r0, step, cs, wq, start, lq, lg);
    }
#undef NA_LOAD
#undef NA_LOAD1
#undef NA_STORE
#undef NA_STORE1
    lsum += __shfl_xor(lsum, 16); lsum += __shfl_xor(lsum, 32);
    const float inv = 1.f / lsum;
#pragma unroll
    for (int dt = 0; dt < 4; ++dt) {
      const int dcol = hd * 64 + dt * 16 + lg * 4;
      bf16x4 z4 = *(const bf16x4*)(Pb + (size_t)qtok * 4096 + 3072 + dcol);
      bf16x4 o4;
#pragma unroll
      for (int e = 0; e < 4; ++e) o4[e] = (short)f2bf(O[dt][e] * inv * siluf_(bf2f((bf16_t)z4[e])));
      *(bf16x4*)(Y + (size_t)qtok * D + dcol) = o4;
    }
  }
}

DI int gdn_pos(int s, int dir) { return dir == 0 ? s : (s < CTX ? CTX - 1 - s : (TPB + CTX - 1) - s); }

DI unsigned u4c(const uint4& u, int k) { return k == 0 ? u.x : (k == 1 ? u.y : (k == 2 ? u.z : u.w)); }
DI void gdn_conv(const Params& P, bf16_t* __restrict__ Pb, const bf16_t* __restrict__ Hb) {
  for (int item = blockIdx.x; item < 272 * 6; item += gridDim.x) {
    const int tid = opaque((int)threadIdx.x), c8 = tid & 63, tq = tid >> 6;
    const int tile = item / 6, slab = item % 6;
    const int ch = slab * 512 + c8 * 8;
    const int tok0 = tile * 64;
    const int seg_first = ((tok0 % TPB) == 0) || ((tok0 % TPB) == CTX);
    const int seg_last = (((tok0 + 64) % TPB) == 0) || (((tok0 + 64) % TPB) == CTX);
    uint4 raw[20];
#pragma unroll
    for (int i = 0; i < 20; ++i) {
      const int lr = tq * 16 + i - 2;
      uint4 u = make_uint4(0u, 0u, 0u, 0u);
      if (lr >= 0 && lr < 64) u = *(const uint4*)(Pb + (size_t)(tok0 + lr) * 4096 + ch);
      else if (lr < 0) { if (!seg_first) u = *(const uint4*)(Hb + ((size_t)(tile - 1) * 4 + 2 + (lr + 2)) * 3072 + ch); }
      else { if (!seg_last) u = *(const uint4*)(Hb + ((size_t)(tile + 1) * 4 + (lr - 64)) * 3072 + ch); }
      raw[i] = u;
    }
    float w[5][8];
#pragma unroll
    for (int j = 0; j < 5; ++j) {
      const float4 a = *(const float4*)(P.gdn_conv_w + j * 3072 + ch), b = *(const float4*)(P.gdn_conv_w + j * 3072 + ch + 4);
      w[j][0] = a.x; w[j][1] = a.y; w[j][2] = a.z; w[j][3] = a.w; w[j][4] = b.x; w[j][5] = b.y; w[j][6] = b.z; w[j][7] = b.w;
    }
    __syncthreads();
#pragma unroll
    for (int i = 0; i < 16; ++i) {
      float y[8];
#pragma unroll
      for (int e = 0; e < 8; ++e) {
        float acc = 0.f;
#pragma unroll
        for (int j = 0; j < 5; ++j) {
          const unsigned d = u4c(raw[i + j], e >> 1);
          const float v = (e & 1) ? __uint_as_float(d & 0xffff0000u) : __uint_as_float(d << 16);
          acc += w[j][e] * v;
        }
        y[e] = siluf_(acc);
      }
      if (slab < 4) {
        float ss = 0.f;
#pragma unroll
        for (int e = 0; e < 8; ++e) ss += y[e] * y[e];
        ss += __shfl_xor(ss, 1); ss += __shfl_xor(ss, 2); ss += __shfl_xor(ss, 4); ss += __shfl_xor(ss, 8);
        const float rn = rsqrtf(ss + 1e-6f);
#pragma unroll
        for (int e = 0; e < 8; ++e) y[e] *= rn;
      }
      uint4 o;
      o.x = pack2bf(y[0], y[1]); o.y = pack2bf(y[2], y[3]); o.z = pack2bf(y[4], y[5]); o.w = pack2bf(y[6], y[7]);
      *(uint4*)(Pb + (size_t)(tok0 + tq * 16 + i) * 4096 + ch) = o;
    }
    __syncthreads();
  }
}

DI void gdn_prep(const Params& P, const bf16_t* __restrict__ Pb, const float* __restrict__ AB, bf16_t* __restrict__ Ob, int c_lo, int c_hi, int set, unsigned* ctr, unsigned char* smem) {
  bf16_t* sK = (bf16_t*)smem;
  bf16_t* sQ = sK + 64 * 136;
  bf16_t* sV = sQ + 64 * 136;
  float* sL = (float*)(sV + 64 * 136);
  float* sG = sL + 64 * 68;
  float* sBt = sG + 64;
  bf16_t* Wb = (bf16_t*)(P.ws + WS_WT + WT_G_W) + (size_t)set * 512 * 8192;
  bf16_t* Aq = (bf16_t*)(P.ws + WS_WT + (set ? WT_G_HALO : WT_G_AQK));
  float* Gc = (float*)(P.ws + WS_WT + WT_G_GC) + set * 512 * 64;
  int* s_item = (int*)(sBt + 64);
  const int nc = c_hi - c_lo;
  for (;;) {
    __syncthreads();
    if (threadIdx.x == 0) *s_item = (int)atomicAdd(ctr, 1u);
    __syncthreads();
    const int item = *s_item;
    if (item >= 64 * nc) break;
    const int tid = opaque((int)threadIdx.x), lane = tid & 63, w = tid >> 6;
    const int chain = item % 64, lc = item / 64;
    const int cidx = c_lo + lc;
    const int b = chain >> 4, hd = (chain >> 1) & 7, dir = chain & 1;
    const int slot = chain * GDN_R + lc;
    bf16_t* Ub = Ob + (((size_t)(dir * 32 + b * 8 + hd)) * TPB + cidx * 64) * 128;
    __syncthreads();
#pragma unroll
    for (int p = 0; p < 4; ++p) {
      const int e = tid + p * 256; const int row = e >> 4, kc = (e & 15) * 8;
      const int tok = b * TPB + gdn_pos(cidx * 64 + row, dir);
      const bf16_t* src = Pb + (size_t)tok * 4096 + hd * 128 + kc;
      *(uint4*)(sQ + row * 136 + kc) = *(const uint4*)(src);
      *(uint4*)(sK + row * 136 + kc) = *(const uint4*)(src + 1024);
      *(uint4*)(sV + row * 136 + kc) = *(const uint4*)(src + 2048);
    }
    if (tid < 64) {
      const int tok = b * TPB + gdn_pos(cidx * 64 + tid, dir);
      const float araw = AB[(size_t)tok * 32 + dir * 8 + hd] + P.gdn_dt_bias[dir * 8 + hd];
      const float sp = araw > 20.f ? araw : log1pf(__expf(araw));
      float gl = -__expf(P.gdn_a_log[dir * 8 + hd]) * sp;
      const float beta = sigmoidf_(AB[(size_t)tok * 32 + 16 + dir * 8 + hd]);
#pragma unroll
      for (int o = 1; o < 64; o <<= 1) { float t = __shfl_up(gl, o); if (lane >= o) gl += t; }
      sG[tid] = gl; sBt[tid] = beta; sBt[68 + tid] = beta * __expf(gl);
      Gc[slot * 64 + tid] = gl;
    }
    __syncthreads();
    {
      const int mi = w >> 1, ni = w & 1, r = lane & 31, h = lane >> 5;
      f32x16 kk, qk;
#pragma unroll
      for (int i = 0; i < 16; ++i) { kk[i] = 0.f; qk[i] = 0.f; }
#pragma unroll
      for (int ks = 0; ks < 8; ++ks) {
        bf16x8 ak = *(const bf16x8*)(sK + (mi * 32 + r) * 136 + ks * 16 + h * 8);
        bf16x8 aq = *(const bf16x8*)(sQ + (mi * 32 + r) * 136 + ks * 16 + h * 8);
        bf16x8 bk = *(const bf16x8*)(sK + (ni * 32 + r) * 136 + ks * 16 + h * 8);
        kk = __builtin_amdgcn_mfma_f32_32x32x16_bf16(ak, bk, kk, 0, 0, 0);
        qk = __builtin_amdgcn_mfma_f32_32x32x16_bf16(aq, bk, qk, 0, 0, 0);
      }
      const int col = ni * 32 + r;
      const float gcol = sG[col];
#pragma unroll
      for (int i = 0; i < 16; ++i) {
        const int row = mi * 32 + crow(i, h);
        const float grow = sG[row];
        const float dec = (col <= row) ? __expf(grow - gcol) : 0.f;
        sL[row * 68 + col] = (col < row) ? sBt[row] * kk[i] * dec : 0.f;
        Aq[((size_t)slot * 64 + row) * 64 + col] = f2bf(0.08838834764831845f * qk[i] * dec);
      }
    }
    __syncthreads();
    {
      float x[64];
#pragma unroll
      for (int i = 0; i < 64; ++i) x[i] = 0.f;
      const bool isv = tid < 128;
      const bf16_t* srcm = isv ? (sV + tid) : (sK + (tid - 128));
      const float* scl = isv ? sBt : (sBt + 68);
#pragma unroll
      for (int rr = 0; rr < 64; rr += 2) {
        const int ro0 = opaque(rr * 68);
        float a0 = bf2f(srcm[rr * 136]) * scl[rr];
        float a1 = bf2f(srcm[(rr + 1) * 136]) * scl[rr + 1];
        float l10 = 0.f;
#pragma unroll
        for (int c4 = 0; c4 < (rr + 4) / 4; ++c4) {
          const float4 p4 = *(const float4*)(sL + ro0 + c4 * 4);
          const float4 q4 = *(const float4*)(sL + ro0 + 68 + c4 * 4);
          a0 -= p4.x * x[c4 * 4 + 0]; a0 -= p4.y * x[c4 * 4 + 1]; a0 -= p4.z * x[c4 * 4 + 2]; a0 -= p4.w * x[c4 * 4 + 3];
          a1 -= q4.x * x[c4 * 4 + 0]; a1 -= q4.y * x[c4 * 4 + 1]; a1 -= q4.z * x[c4 * 4 + 2]; a1 -= q4.w * x[c4 * 4 + 3];
          if (c4 == rr / 4) l10 = ((rr & 3) == 0) ? q4.x : (((rr & 3) == 2) ? q4.z : 0.f);
        }
        a1 -= l10 * a0;
        asm volatile("" : "+v"(a0), "+v"(a1) :: "memory");
        x[rr] = a0; x[rr + 1] = a1;
      }
      bf16_t* dst = isv ? (Ub + tid) : (Wb + (size_t)slot * 64 * 128 + (tid - 128));
#pragma unroll
      for (int rr = 0; rr < 64; ++rr) dst[rr * 128] = f2bf(x[rr]);
    }
  }
}

struct ChainRegs { bf16x8 a1[8]; bf16x8 aq[4]; uint4 kt[4]; float g; };
DI void chain_load(ChainRegs& R, const bf16_t* __restrict__ Pb, const bf16_t* __restrict__ Wb, const bf16_t* __restrict__ Ub,
                   const bf16_t* __restrict__ Aq, const float* __restrict__ Gc, int slot, int cidx, int b, int hd, int dir, int dvb,
                   int tid, int w, int r, int h) {
  const int strip = w & 1;
  const bf16_t* arow;
  if (w < 2) arow = Wb + ((size_t)slot * 64 + strip * 32 + r) * 128;
  else { const int tok = b * TPB + gdn_pos(cidx * 64 + strip * 32 + r, dir); arow = Pb + (size_t)tok * 4096 + hd * 128; }
#pragma unroll
  for (int ks = 0; ks < 8; ++ks) R.a1[ks] = *(const bf16x8*)(arow + ks * 16 + h * 8);
  if (w < 2) {
    const bf16_t* ub = Ub + (((size_t)(dir * 32 + b * 8 + hd)) * TPB + cidx * 64) * 128 + dvb * 32 + r;
#pragma unroll
    for (int i = 0; i < 16; ++i) R.aq[i >> 3][i & 7] = (short)ub[(strip * 32 + crow(i, h)) * 128];
  } else {
    const bf16_t* aqrow = Aq + ((size_t)slot * 64 + strip * 32 + r) * 64;
#pragma unroll
    for (int ks = 0; ks < 4; ++ks) R.aq[ks] = *(const bf16x8*)(aqrow + ks * 16 + h * 8);
  }
  R.g = (tid < 64) ? Gc[slot * 64 + tid] : 0.f;
}
DI void chain_load_k(ChainRegs& R, const bf16_t* __restrict__ Pb, int cidx, int b, int hd, int dir, int tid) {
#pragma unroll
  for (int p = 0; p < 4; ++p) {
    const int e = tid + p * 256; const int row = e >> 4, kc = (e & 15) * 8;
    const int tok = b * TPB + gdn_pos(cidx * 64 + row, dir);
    R.kt[p] = *(const uint4*)(Pb + (size_t)tok * 4096 + 1024 + hd * 128 + kc);
  }
}
DI void gdn_chain(const Params& P, const bf16_t* __restrict__ Pb, bf16_t* Ob, int c_lo, int c_hi, int set, unsigned char* smem, bool save = true) {
  if (blockIdx.x >= 256) return;
  bf16_t* sSt = (bf16_t*)smem;
  bf16_t* sVn = sSt + 32 * 136;
  bf16_t* sVd = sVn + 32 * 72;
  bf16_t* sKt = sVd + 32 * 72;
  float* sG = (float*)(sKt + 64 * 136);
  const bf16_t* Wb = (const bf16_t*)(P.ws + WS_WT + WT_G_W) + (size_t)set * 512 * 8192;
  const bf16_t* Ub = Ob;
  const bf16_t* Aq = (const bf16_t*)(P.ws + WS_WT + (set ? WT_G_HALO : WT_G_AQK));
  const float* Gc = (const float*)(P.ws + WS_WT + WT_G_GC) + set * 512 * 64;
  float* Sst = (float*)(P.ws + WS_SST);
  const int tid = opaque((int)threadIdx.x), lane = tid & 63, w = tid >> 6, r = lane & 31, h = lane >> 5;
  const int chain = blockIdx.x >> 2, dvb = blockIdx.x & 3;
  const int b = chain >> 4, hd = (chain >> 1) & 7, dir = chain & 1;
  const int strip = w & 1;
  f32x16 S;
  if (c_lo == 0) {
#pragma unroll
    for (int i = 0; i < 16; ++i) S[i] = 0.f;
  } else {
#pragma unroll
    for (int i = 0; i < 16; ++i) S[i] = Sst[((size_t)blockIdx.x * 16 + i) * 256 + tid];
  }
  ChainRegs cur, nxt;
  chain_load(cur, Pb, Wb, Ub, Aq, Gc, chain * GDN_R, c_lo, b, hd, dir, dvb, tid, w, r, h);
  chain_load_k(cur, Pb, c_lo, b, hd, dir, tid);
  nxt = cur;
  const int tid0 = tid;
  for (int cidx = c_lo; cidx < c_hi; ++cidx) {
    const int tid = opaque(tid0), lane = tid & 63, w = tid >> 6, r = lane & 31, h = lane >> 5, strip = w & 1;
    const int slot = chain * GDN_R + (cidx - c_lo);
    __syncthreads();
#pragma unroll
    for (int q = 0; q < 4; ++q) {
      bf16x4 v;
#pragma unroll
      for (int e = 0; e < 4; ++e) v[e] = (short)f2bf(S[q * 4 + e]);
      *(bf16x4*)(sSt + r * 136 + w * 32 + 8 * q + 4 * h) = v;
    }
    if (tid < 64) {
      const float g63w = __shfl(cur.g, 63);
      sG[tid] = __expf(g63w - cur.g);
      sG[64 + tid] = 0.08838834764831845f * __expf(cur.g);
      if (tid == 63) sG[128] = __expf(cur.g);
    }
#pragma unroll
    for (int p = 0; p < 4; ++p) {
      const int e = tid + p * 256; const int row = e >> 4, kc = (e & 15) * 8;
      *(uint4*)(sKt + row * 136 + kc) = cur.kt[p];
    }
    if (cidx + 1 < c_hi) chain_load(nxt, Pb, Wb, Ub, Aq, Gc, slot + 1, cidx + 1, b, hd, dir, dvb, tid, w, r, h);
    __syncthreads();
    f32x16 acc1, acc1b;
#pragma unroll
    for (int i = 0; i < 16; ++i) { acc1[i] = 0.f; acc1b[i] = 0.f; }
#pragma unroll
    for (int ks = 0; ks < 8; ks += 2) {
      bf16x8 bfr0 = *(const bf16x8*)(sSt + r * 136 + ks * 16 + h * 8);
      bf16x8 bfr1 = *(const bf16x8*)(sSt + r * 136 + (ks + 1) * 16 + h * 8);
      acc1 = __builtin_amdgcn_mfma_f32_32x32x16_bf16(cur.a1[ks], bfr0, acc1, 0, 0, 0);
      acc1b = __builtin_amdgcn_mfma_f32_32x32x16_bf16(cur.a1[ks + 1], bfr1, acc1b, 0, 0, 0);
    }
#pragma unroll
    for (int i = 0; i < 16; ++i) acc1[i] += acc1b[i];
    if (w < 2) {
#pragma unroll
      for (int q = 0; q < 4; ++q) {
        bf16x4 vn, vd;
#pragma unroll
        for (int e = 0; e < 4; ++e) {
          const int row = strip * 32 + 8 * q + 4 * h + e;
          const float v = bf2f((bf16_t)cur.aq[(q * 4 + e) >> 3][(q * 4 + e) & 7]) - acc1[q * 4 + e];
          vn[e] = (short)f2bf(v);
          vd[e] = (short)f2bf(v * sG[row]);
        }
        *(bf16x4*)(sVn + r * 72 + strip * 32 + 8 * q + 4 * h) = vn;
        *(bf16x4*)(sVd + r * 72 + strip * 32 + 8 * q + 4 * h) = vd;
      }
    }
    __syncthreads();
    if (cidx + 1 < c_hi) chain_load_k(nxt, Pb, cidx + 1, b, hd, dir, tid);
    if (w >= 2) {
      f32x16 av;
#pragma unroll
      for (int i = 0; i < 16; ++i) av[i] = 0.f;
#pragma unroll
      for (int ks = 0; ks < 4; ++ks) {
        bf16x8 bfr = *(const bf16x8*)(sVn + r * 72 + ks * 16 + h * 8);
        av = __builtin_amdgcn_mfma_f32_32x32x16_bf16(cur.aq[ks], bfr, av, 0, 0, 0);
      }
      bf16_t* ob = Ob + (((size_t)(dir * 32 + b * 8 + hd)) * TPB + cidx * 64) * 128 + dvb * 32 + r;
#pragma unroll
      for (int i = 0; i < 16; ++i) {
        const int row = strip * 32 + crow(i, h);
        const float o = sG[64 + row] * acc1[i] + av[i];
        ob[(size_t)row * 128] = f2bf(o);
      }
    }
    {
      const float eg = sG[128];
      f32x16 d0, d1;
#pragma unroll
      for (int i = 0; i < 16; ++i) { d0[i] = 0.f; d1[i] = 0.f; }
#pragma unroll
      for (int ks = 0; ks < 4; ++ks) {
        bf16x8 af;
#pragma unroll
        for (int j = 0; j < 8; ++j) af[j] = (short)sKt[(ks * 16 + h * 8 + j) * 136 + w * 32 + r];
        bf16x8 bfr = *(const bf16x8*)(sVd + r * 72 + ks * 16 + h * 8);
        if (ks & 1) d1 = __builtin_amdgcn_mfma_f32_32x32x16_bf16(af, bfr, d1, 0, 0, 0);
        else d0 = __builtin_amdgcn_mfma_f32_32x32x16_bf16(af, bfr, d0, 0, 0, 0);
      }
#pragma unroll
      for (int i = 0; i < 16; ++i) S[i] = S[i] * eg + (d0[i] + d1[i]);
    }
    cur = nxt;
  }
  if (save) {
#pragma unroll
    for (int i = 0; i < 16; ++i) Sst[((size_t)blockIdx.x * 16 + i) * 256 + tid] = S[i];
  }
}

DI void gdn_post(const Params& P, const bf16_t* Pb, const bf16_t* __restrict__ Ob, bf16_t* Y, int ldy) {
  const int gw = blockIdx.x * 4 + (opaque((int)threadIdx.x) >> 6), nw = gridDim.x * 4;
  for (int tok = gw; tok < NT; tok += nw) {
    const int lane = opaque((int)threadIdx.x) & 63;
    const int l16 = lane & 15, hq = lane >> 4;
    const float4 ga = *(const float4*)(P.gdn_norm_g + l16 * 8), gb = *(const float4*)(P.gdn_norm_g + l16 * 8 + 4);
    const float gn[8] = {ga.x, ga.y, ga.z, ga.w, gb.x, gb.y, gb.z, gb.w};
    const int b = tok / TPB, pos = tok % TPB;
    const int sf = pos, sr = pos < CTX ? CTX - 1 - pos : (TPB + CTX - 1) - pos;
#pragma unroll
    for (int it = 0; it < 2; ++it) {
      const int hd = it * 4 + hq;
      const uint4 uf = *(const uint4*)(Ob + (((size_t)(0 * 32 + b * 8 + hd)) * TPB + sf) * 128 + l16 * 8);
      const uint4 ur = *(const uint4*)(Ob + (((size_t)(1 * 32 + b * 8 + hd)) * TPB + sr) * 128 + l16 * 8);
      const uint4 uz = *(const uint4*)(Pb + (size_t)tok * 4096 + 3072 + hd * 128 + l16 * 8);
      float o[8], z[8];
#pragma unroll
      for (int k = 0; k < 4; ++k) {
        const unsigned f = u4c(uf, k), r = u4c(ur, k), zz = u4c(uz, k);
        o[2 * k] = __uint_as_float(f << 16) + __uint_as_float(r << 16);
        o[2 * k + 1] = __uint_as_float(f & 0xffff0000u) + __uint_as_float(r & 0xffff0000u);
        z[2 * k] = __uint_as_float(zz << 16); z[2 * k + 1] = __uint_as_float(zz & 0xffff0000u);
      }
      float ss = 0.f;
#pragma unroll
      for (int e = 0; e < 8; ++e) ss += o[e] * o[e];
      ss += __shfl_xor(ss, 1); ss += __shfl_xor(ss, 2); ss += __shfl_xor(ss, 4); ss += __shfl_xor(ss, 8);
      const float rstd = rsqrtf(ss * (1.f / 128.f) + 1e-6f);
      float y[8];
#pragma unroll
      for (int e = 0; e < 8; ++e) y[e] = o[e] * rstd * gn[e] * siluf_(z[e]);
      uint4 ov;
      ov.x = pack2bf(y[0], y[1]); ov.y = pack2bf(y[2], y[3]); ov.z = pack2bf(y[4], y[5]); ov.w = pack2bf(y[6], y[7]);
      *(uint4*)(Y + (size_t)tok * ldy + hd * 128 + l16 * 8) = ov;
    }
  }
}

#ifndef DUP_MASK
#define DUP_MASK 0
#endif
#define NREP(cat) (((DUP_MASK >> (cat)) & 1) ? 2 : 1)
constexpr int PH_S5 = 6;
constexpr int PH_GDN = 5 + GDN_ROUNDS;
constexpr int PH_NA = 3;
constexpr int L0_BASE = 3;
constexpr int E1_PH = L0_BASE + PH_S5;
constexpr int L1_BASE = E1_PH + 1;
constexpr int E2_PH = L1_BASE + PH_GDN;
constexpr int L2_BASE = E2_PH + 1;
constexpr int E3_PH = L2_BASE + PH_NA;
constexpr int PB3_PH = E3_PH + 1;
constexpr int L3_BASE = PB3_PH + 1;
constexpr int E4_PH = L3_BASE + PH_S5;
constexpr int NPHASES = E4_PH + 1;

DI void s5_layer_phase(const Params& P, int j, int sub, unsigned char* smem) {
  unsigned char* big = P.ws + WS_BIG;
  bf16_t* Pb = (bf16_t*)(big);
  bf16_t* A = (bf16_t*)(big + 5 * UNIT);
  float* Sloc = (float*)(big + 2 * UNIT);
  bf16_t* Sin = (bf16_t*)(big + 4 * UNIT);
  bf16_t* Y1 = (bf16_t*)(big + 5 * UNIT);
  bf16_t* Y2 = (bf16_t*)(big + 2 * UNIT);
  float* O = (float*)(big + 3 * UNIT);
  unsigned char* wt = P.ws + WS_WT;
  switch (sub) {
    case 0: {
      for (int rep_ = 0; rep_ < NREP(6); ++rep_) s5_pre_c(P, j);
      Gemm g = gemm_plain(A, (const bf16_t*)(wt + WT_S5_IN), NT, 2048, 1024, EPI_BF16, Pb, 2048);
      for (int rep_ = 0; rep_ < NREP(0); ++rep_) gemm_phase(g, smem);
    } break;
    case 1: {
      Gemm g{};
      g.A = Pb; g.a_rs = 16 * 2048; g.a_kbs = 2048; g.a_bs = 16; g.A2 = Pb; g.a2_rs = g.a_rs; g.a2_kbs = g.a_kbs; g.a2_bs = 16; g.K1 = 256;
      g.Bt = (const bf16_t*)(wt + WT_S5_BPT); g.b_bs = 256 * 256; g.M = 1088; g.N = 256; g.K = 256; g.batch = 64; g.epi = EPI_F32;
      g.C = Sloc; g.ldc = 256; g.c_bs = 1088 * 256;
      for (int rep_ = 0; rep_ < NREP(0); ++rep_) gemm_phase(g, smem);
    } break;
    case 2: for (int rep_ = 0; rep_ < NREP(3); ++rep_) s5_carry(P, Sloc, Sin); break;
    case 3: {
      Gemm g{};
      g.A = Pb; g.a_rs = 16 * 2048; g.a_kbs = 2048; g.a_bs = 16; g.K1 = 256;
      g.A2 = Sin; g.a2_rs = 256; g.a2_kbs = 16; g.a2_bs = 1088 * 256;
      g.Bt = (const bf16_t*)(wt + WT_S5_OPT); g.b_bs = 256 * 512; g.M = 1088; g.N = 256; g.K = 512; g.batch = 64; g.epi = EPI_S5Y;
      g.C = Y1;
      for (int rep_ = 0; rep_ < NREP(0); ++rep_) gemm_phase(g, smem);
    } break;
    case 4: {
      Gemm g = gemm_plain(Y1, (const bf16_t*)(wt + WT_S5_GLU), NT, 2048, 1024, EPI_GLU, Y2, 1024);
      g.zsrc = Pb; g.bias = P.s5_glu_b + j * 2048;
      for (int rep_ = 0; rep_ < NREP(0); ++rep_) gemm_phase(g, smem);
    } break;
    case 5: {
      Gemm g = gemm_plain(Y2, (const bf16_t*)(wt + WT_S5_OUT), NT, 1024, 1024, EPI_F32, O, 1024);
      for (int rep_ = 0; rep_ < NREP(0); ++rep_) gemm_phase(g, smem);
    } break;
    default: break;
  }
}
DI void s5_convert(const Params& P, int j, float* lds) {
  unsigned char* wt = P.ws + WS_WT;
  convert_wt(P.s5_in_w + (size_t)j * 1024 * 2048, 1024, 2048, 2048, (bf16_t*)(wt + WT_S5_IN), 0, lds);
  convert_wt(P.s5_glu_w + (size_t)j * 1024 * 2048, 1024, 2048, 2048, (bf16_t*)(wt + WT_S5_GLU), 1, lds);
  convert_wt(P.s5_out_w + (size_t)j * 1024 * 1024, 1024, 1024, 1024, (bf16_t*)(wt + WT_S5_OUT), 0, lds);
}

DI void run_phase(const Params& P, int ph, unsigned char* smem) {
  unsigned char* big = P.ws + WS_BIG;
  unsigned char* wt = P.ws + WS_WT;
  float* lds = (float*)smem;
  if (ph == 0) { for (int rep_ = 0; rep_ < NREP(6); ++rep_) { adaln_phase(P, lds); s5_convert(P, 0, lds); s5_pre_a(P, 0); } return; }
  if (ph == 1) { for (int rep_ = 0; rep_ < NREP(6); ++rep_) { adaln_reduce(P); s5_pre_b(P, 0); } return; }
  if (ph == 2) { ew_phase(P, -1, 0, nullptr, (bf16_t*)(big + 5 * UNIT)); return; }
  if (ph >= L0_BASE && ph < E1_PH) { s5_layer_phase(P, 0, ph - L0_BASE, smem); return; }
  if (ph == E1_PH) {
    ew_phase(P, 0, 1, (const float*)(big + 3 * UNIT), (bf16_t*)(big + 5 * UNIT));
    for (int rep_ = 0; rep_ < NREP(6); ++rep_) {
    convert_wt(P.gdn_in_w, 1024, 4128, 4224, (bf16_t*)(wt + WT_G_IN), 0, lds);
    convert_wt(P.gdn_out_w, 1024, 1024, 1024, (bf16_t*)(wt + WT_G_OUT), 0, lds); }
    return;
  }
  if (ph >= L1_BASE && ph < E2_PH) {
    const int sub = ph - L1_BASE;
    bf16_t* Pb = (bf16_t*)big;
    bf16_t* A = (bf16_t*)(big + 5 * UNIT);
    bf16_t* Ob = (bf16_t*)(big + 4 * UNIT);
    float* AB = (float*)(P.ws + WS_AB);
    bf16_t* Hb = (bf16_t*)(wt + WT_G_HALO);
    if (sub == 0) {
      Gemm g = gemm_plain(A, (const bf16_t*)(wt + WT_G_IN), NT, 4224, 1024, EPI_GDNIN, Pb, 4096);
      g.C2 = AB; g.C3 = Hb;
      for (int rep_ = 0; rep_ < NREP(0); ++rep_) gemm_phase(g, smem);
    } else if (sub == 1) {
      gdn_conv(P, Pb, Hb);
    } else if (sub < 3 + GDN_ROUNDS) {
      unsigned* ctr = (unsigned*)(P.ws + WS_BAR) + XCD_BAR_WORDS;
      const int rd = sub - 3;
      if (rd >= 0) { const int c_lo = rd * GDN_R, c_hi = imin(GDN_NCH, c_lo + GDN_R); gdn_chain(P, Pb, Ob, c_lo, c_hi, rd & 1, smem); }
      const int pr = rd + 1;
      if (pr < GDN_ROUNDS) { const int c_lo = pr * GDN_R, c_hi = imin(GDN_NCH, c_lo + GDN_R); gdn_prep(P, Pb, AB, Ob, c_lo, c_hi, pr & 1, ctr + pr * 16, smem); }
    } else if (sub == 3 + GDN_ROUNDS) {
      for (int rep_ = 0; rep_ < NREP(6); ++rep_) gdn_post(P, Pb, Ob, Pb, 4096);
    } else {
      Gemm g = gemm_plain(Pb, (const bf16_t*)(wt + WT_G_OUT), NT, 1024, 1024, EPI_F32, (float*)(big + 4 * UNIT), 1024);
      g.a_rs = 4096; g.a2_rs = 4096;
      for (int rep_ = 0; rep_ < NREP(0); ++rep_) gemm_phase(g, smem);
    }
    return;
  }
  if (ph == E2_PH) {
    ew_phase(P, 1, 2, (const float*)(big + 4 * UNIT), (bf16_t*)(big));
    for (int rep_ = 0; rep_ < NREP(6); ++rep_) {
    convert_wt(P.na_in_w, 1024, 4096, 4096, (bf16_t*)(wt + WT_N_IN), 0, lds);
    convert_wt(P.na_out_w, 1024, 1024, 1024, (bf16_t*)(wt + WT_N_OUT), 0, lds); }
    return;
  }
  if (ph >= L2_BASE && ph < E3_PH) {
    const int sub = ph - L2_BASE;
    bf16_t* A = (bf16_t*)big;
    bf16_t* Pb = (bf16_t*)(big + 1 * UNIT);
    bf16_t* Vt = (bf16_t*)(big + 5 * UNIT);
    bf16_t* Y1 = (bf16_t*)big;
    float* O = (float*)(big + 1 * UNIT);
    if (sub == 0) {
      Gemm g = gemm_plain(A, (const bf16_t*)(wt + WT_N_IN), NT, 4096, 1024, EPI_NAIN, Pb, 4096);
      g.C2 = Vt;
      for (int rep_ = 0; rep_ < NREP(0); ++rep_) gemm_phase(g, smem);
    } else if (sub == 1) {
      for (int rep_ = 0; rep_ < NREP(1); ++rep_) na_attn(P, Pb, Vt, Y1, smem);
    } else {
      Gemm g = gemm_plain(Y1, (const bf16_t*)(wt + WT_N_OUT), NT, 1024, 1024, EPI_F32, O, 1024);
      for (int rep_ = 0; rep_ < NREP(0); ++rep_) gemm_phase(g, smem);
    }
    return;
  }
  if (ph == E3_PH) {
    ew_phase(P, 2, 3, (const float*)(big + 1 * UNIT), (bf16_t*)(big + 5 * UNIT));
    for (int rep_ = 0; rep_ < NREP(6); ++rep_) { s5_convert(P, 1, lds); s5_pre_a(P, 1); }
    return;
  }
  if (ph == PB3_PH) { for (int rep_ = 0; rep_ < NREP(6); ++rep_) s5_pre_b(P, 1); return; }
  if (ph >= L3_BASE && ph < E4_PH) { s5_layer_phase(P, 1, ph - L3_BASE, smem); return; }
  if (ph == E4_PH) { ew_phase(P, 3, -1, (const float*)(big + 3 * UNIT), nullptr); return; }
}

#ifndef NO_MEGA
__global__ void __launch_bounds__(NTHREADS, 2) mega(Params P) {
  extern __shared__ __attribute__((aligned(16))) unsigned char smem[];
  __shared__ uint4 xb_words;
  cg::grid_group grid = cg::this_grid();
  if (threadIdx.x == 0) xb_words = make_uint4(0u, 0u, 0u, 0u);
  __syncthreads();
  XcdBarrier xb = xcd_barrier_post((unsigned*)(P.ws + WS_BAR), (volatile LAS unsigned*)&xb_words);
  if (P.ph_lo < 0) grid.sync();
  for (int ph = P.ph_lo; ph < P.ph_hi; ++ph) {
    run_phase(P, ph, smem);
    if (ph + 1 < P.ph_hi) { xcd_barrier(xb); if (DUP_MASK & 32) xcd_barrier(xb); }
  }
}

#ifndef MULTI_LAUNCH
#define MULTI_LAUNCH 0
#endif

extern "C" void kernel_launch(void* const* d_in, const int* in_sizes, int n_in, void* d_out, int out_size, void* d_ws, size_t ws_size, hipStream_t stream) {
  static int grid_blocks = 0;
  if (!grid_blocks) {
    int dev = 0, cus = 0, per_cu = 0;
    hipGetDevice(&dev);
    hipDeviceGetAttribute(&cus, hipDeviceAttributeMultiprocessorCount, dev);
    hipFuncSetAttribute((const void*)mega, hipFuncAttributeMaxDynamicSharedMemorySize, GEMM_LDS_BYTES);
    hipOccupancyMaxActiveBlocksPerMultiprocessor(&per_cu, (const void*)mega, NTHREADS, GEMM_LDS_BYTES);
    if (per_cu > 2) per_cu = 2;
    if (per_cu < 1) per_cu = 1;
    grid_blocks = cus * per_cu;
    if (ws_size < WS_END) fprintf(stderr, "kernel_launch: workspace too small: %zu < %zu\n", ws_size, (size_t)WS_END);
  }
  Params p{};
  const float** f = (const float**)&p;
  for (int i = 0; i < 29; ++i) f[i] = (const float*)d_in[i];
  p.out = (float*)d_out; p.ws = (unsigned char*)d_ws;
#if MULTI_LAUNCH
  for (int ph = 0; ph < NPHASES; ++ph) {
    p.ph_lo = ph; p.ph_hi = ph + 1;
    hipLaunchKernelGGL(mega, dim3(grid_blocks), dim3(NTHREADS), GEMM_LDS_BYTES, stream, p);
  }
#else
  p.ph_lo = 0; p.ph_hi = NPHASES;
  hipMemsetAsync((unsigned char*)d_ws + WS_BAR, 0, 16384, stream);
  void* args[] = {&p};
  hipError_t e = hipLaunchCooperativeKernel((const void*)mega, dim3(grid_blocks), dim3(NTHREADS), args, GEMM_LDS_BYTES, stream);
  if (e != hipSuccess) fprintf(stderr, "cooperative launch failed: %s (grid %d)\n", hipGetErrorString(e), grid_blocks);
#endif
}
#endif
```

```cpp
#include <hip/hip_runtime.h>
#include <hip/hip_cooperative_groups.h>
#include <cstdio>
namespace cg = cooperative_groups;

typedef unsigned short bf16_t;
typedef __attribute__((ext_vector_type(8))) short bf16x8;
typedef __attribute__((ext_vector_type(4))) short bf16x4;
typedef __attribute__((ext_vector_type(16))) float f32x16;
typedef __attribute__((ext_vector_type(4))) float f32x4;
#define DI __device__ __forceinline__
typedef __attribute__((address_space(3))) unsigned lds_u32;

constexpr int D = 1024;
constexpr int NB = 4;
constexpr int SEQ = 4096;
constexpr int CTX = 256;
constexpr int TPB = SEQ + CTX;
constexpr int NT = NB * TPB;
constexpr int NTHREADS = 256;
constexpr int GDN_R = 8;
constexpr int GDN_NCH = 68;
constexpr int GDN_ROUNDS = (GDN_NCH + GDN_R - 1) / GDN_R;

constexpr size_t MiB = 1024 * 1024;
constexpr size_t UNIT = (size_t)NT * 1024 * 2;
constexpr size_t WS_MOD = 0;
constexpr size_t WS_BAR = 245760;
constexpr size_t WS_HCTX = 262144;
constexpr size_t WS_AB = WS_HCTX + 4 * MiB;
constexpr size_t WS_SST = WS_AB + (size_t)NT * 32 * 4;
constexpr size_t WS_WT = WS_SST + 4 * MiB;
constexpr size_t WT_S5_IN = 0;
constexpr size_t WT_S5_GLU = WT_S5_IN + 4 * MiB;
constexpr size_t WT_S5_OUT = WT_S5_GLU + 4 * MiB;
constexpr size_t WT_S5_APOW = WT_S5_OUT + 2 * MiB;
constexpr size_t WT_S5_BBAR = WT_S5_APOW + 2 * 64 * 17 * 64 * 8;
constexpr size_t WT_S5_KTAB = WT_S5_BBAR + 2 * 64 * 64 * 16 * 8;
constexpr size_t WT_S5_OPT = WT_S5_KTAB + 2 * 64 * 16 * 256 * 4;
constexpr size_t WT_S5_BPT = WT_S5_OPT + (size_t)64 * 256 * 512 * 2;
constexpr size_t WT_S5_END = WT_S5_BPT + (size_t)64 * 256 * 256 * 2;
constexpr size_t WT_G_IN = 0;
constexpr size_t WT_G_OUT = WT_G_IN + (size_t)4224 * 1024 * 2;
constexpr size_t WT_G_HALO = WT_G_OUT + 2 * MiB;
constexpr size_t WT_G_W = WT_G_HALO + (size_t)272 * 4 * 3072 * 2;
constexpr size_t WT_G_AQK = WT_G_W + (size_t)2 * 64 * GDN_R * 64 * 128 * 2;
constexpr size_t WT_G_GC = WT_G_AQK + (size_t)64 * GDN_R * 64 * 64 * 2;
constexpr size_t WT_G_END = WT_G_GC + (size_t)2 * 64 * GDN_R * 64 * 4;
static_assert((size_t)64 * GDN_R * 64 * 64 * 2 <= (size_t)272 * 4 * 3072 * 2, "Aqk set 1 must fit the halo region");
constexpr size_t WT_N_IN = 0;
constexpr size_t WT_N_OUT = 8 * MiB;
constexpr size_t WT_SIZE = (WT_S5_END > WT_G_END ? WT_S5_END : WT_G_END);
constexpr size_t WS_BIG = (WS_WT + WT_SIZE + 255) / 256 * 256;
constexpr size_t WS_END = WS_BIG + 6 * UNIT;
static_assert(WS_END <= 256 * MiB, "workspace too large");

struct Params {
  const float *x, *c, *ctx, *c_ctx, *ada_w, *ada_b, *pre_g, *post_g;
  const float *s5_in_w, *s5_lam_re, *s5_lam_im, *s5_log_dt, *s5_b_re, *s5_b_im, *s5_c_re, *s5_c_im, *s5_d, *s5_glu_w, *s5_glu_b, *s5_out_w;
  const float *gdn_in_w, *gdn_conv_w, *gdn_a_log, *gdn_dt_bias, *gdn_norm_g, *gdn_out_w;
  const float *na_in_w, *na_rpb, *na_out_w;
  float* out;
  unsigned char* ws;
  int ph_lo, ph_hi;
};

DI bf16_t f2bf(float x) { return __builtin_bit_cast(unsigned short, (__bf16)x); }
typedef __attribute__((ext_vector_type(2))) __bf16 bf16v2;
typedef __attribute__((ext_vector_type(2))) float f32v2;
DI unsigned pack2bf(float lo, float hi) { f32v2 v = {lo, hi}; return __builtin_bit_cast(unsigned, __builtin_convertvector(v, bf16v2)); }
DI float bf2f(bf16_t b) { return __uint_as_float(((unsigned)b) << 16); }
DI float wsum(float v) {
#pragma unroll
  for (int o = 32; o > 0; o >>= 1) v += __shfl_xor(v, o);
  return v;
}
DI float sigmoidf_(float x) { return __builtin_amdgcn_rcpf(1.f + __expf(-x)); }
DI float siluf_(float x) { return x * __builtin_amdgcn_rcpf(1.f + __expf(-x)); }
DI float geluf_(float x) { float u = 1.5957691216057308f * (x + 0.044715f * x * x * x); return x * __builtin_amdgcn_rcpf(1.f + __expf(-u)); }
DI int crow(int i, int h) { return (i & 3) + 8 * (i >> 2) + 4 * h; }
DI void lds_barrier() { asm volatile("s_waitcnt lgkmcnt(0)" ::: "memory"); __builtin_amdgcn_s_barrier(); asm volatile("" ::: "memory"); }
DI int opaque(int v) { asm volatile("" : "+v"(v)); return v; }
DI int imin(int a, int b) { return a < b ? a : b; }
DI int imax(int a, int b) { return a > b ? a : b; }


#define XB_TMO      128
#define XB_XCNT(j)  (256  + 64 * (j))
#define XB_XSUB(j)  (1280 + 64 * (j))
#define XB_XGEN(j)  (2304 + 64 * (j))
#define XB_TOP      3328
#define XB_TOPGEN   3392
#define XCD_BAR_WORDS 3456
#define XB_SPIN_CAP (1u << 18)
#define LAS __attribute__((address_space(3)))
DI unsigned xb_ld(unsigned* p)              { return __hip_atomic_load(p, __ATOMIC_RELAXED, __HIP_MEMORY_SCOPE_AGENT); }
DI unsigned xb_add(unsigned* p, unsigned v) { return __hip_atomic_fetch_add(p, v, __ATOMIC_RELAXED, __HIP_MEMORY_SCOPE_AGENT); }
DI unsigned xb_xcc_id() { return (unsigned)__builtin_amdgcn_s_getreg((3 << 11) | 20) & 0xFu; }
#define XB_SPIN(cond, bar) do { unsigned _sp = 0; while (cond) { __builtin_amdgcn_s_sleep(1); \
    if ((++_sp & 255u) == 0u) { if (xb_ld(&(bar)[XB_TMO])) break; if (_sp > XB_SPIN_CAP) { atomicAdd(&(bar)[XB_TMO], 1u); break; } } } } while (0)
struct XcdBarrier { unsigned* bar; unsigned x; volatile LAS unsigned* st; };
DI XcdBarrier xcd_barrier_post(unsigned* bar, volatile LAS unsigned* st) {
  XcdBarrier b; b.bar = bar; b.x = xb_xcc_id(); b.st = st;
  if (threadIdx.x == 0) (void)xb_add(&bar[XB_XCNT(b.x)], 1u);
  return b;
}
DI void xcd_barrier_complete(unsigned* bar, unsigned x, unsigned& nloc, unsigned& nx) {
  const unsigned G = gridDim.x * gridDim.y * gridDim.z;
  unsigned sum, cnt, mine, sp = 0u;
  for (;;) {
    sum = 0u; cnt = 0u; mine = 0u;
#pragma unroll
    for (unsigned j = 0; j < 16; ++j) { const unsigned c = xb_ld(&bar[XB_XCNT(j)]); sum += c; cnt += (c > 0u) ? 1u : 0u; mine = (j == x) ? c : mine; }
    if (sum == G) break;
    __builtin_amdgcn_s_sleep(1);
    if ((++sp & 255u) == 0u) { if (xb_ld(&bar[XB_TMO])) break; if (sp > XB_SPIN_CAP) { atomicAdd(&bar[XB_TMO], 1u); break; } }
  }
  nloc = mine > 0u ? mine : 1u; nx = cnt > 0u ? cnt : 1u;
}
DI void xcd_barrier(const XcdBarrier& b) {
  asm volatile("s_waitcnt vmcnt(0)" ::: "memory");
  __syncthreads();
  if (threadIdx.x == 0) {
    unsigned* bar = b.bar;
    __builtin_amdgcn_s_waitcnt(0);
    unsigned nloc = b.st[0], nx = b.st[1];
    if (nloc == 0u) { xcd_barrier_complete(bar, b.x, nloc, nx); b.st[0] = nloc; b.st[1] = nx; }
    const unsigned old = xb_add(&bar[XB_XSUB(b.x)], 1u);
    const unsigned gen = old / nloc;
    if (old + 1u == (gen + 1u) * nloc) {
      __builtin_amdgcn_fence(__ATOMIC_RELEASE, "agent");
      asm volatile("s_waitcnt vmcnt(0)" ::: "memory");
      const unsigned og = xb_add(&bar[XB_TOP], 1u);
      const unsigned tg = og / nx;
      if (og + 1u == (tg + 1u) * nx) xb_add(&bar[XB_TOPGEN], 1u);
      else XB_SPIN(xb_ld(&bar[XB_TOPGEN]) == tg, bar);
      __builtin_amdgcn_fence(__ATOMIC_ACQUIRE, "agent");
      xb_add(&bar[XB_XGEN(b.x)], 1u);
      asm volatile("s_waitcnt vmcnt(0)" ::: "memory");
    } else {
      XB_SPIN(xb_ld(&bar[XB_XGEN(b.x)]) == gen, bar);
      __builtin_amdgcn_fence(__ATOMIC_ACQUIRE, "agent");
      asm volatile("s_waitcnt vmcnt(0)" ::: "memory");
    }
  }
  __syncthreads();
}

DI void convert_wt(const float* __restrict__ W, int K, int N, int Npad, bf16_t* __restrict__ Wt, int mode, float* lds) {
  const int tk = K / 64, tn = Npad / 64;
  for (int t = blockIdx.x; t < tk * tn; t += gridDim.x) {
    const int tid = opaque((int)threadIdx.x);
    const int k0 = (t % tk) * 64, n0 = (t / tk) * 64;
    __syncthreads();
#pragma unroll
    for (int p = 0; p < 4; ++p) {
      const int kk = (tid >> 4) + p * 16, n4 = (tid & 15) * 4;
      float4 v = make_float4(0.f, 0.f, 0.f, 0.f);
      if (n0 + n4 < N) v = *(const float4*)(W + (size_t)(k0 + kk) * N + n0 + n4);
      lds[(n4 + 0) * 65 + kk] = v.x; lds[(n4 + 1) * 65 + kk] = v.y; lds[(n4 + 2) * 65 + kk] = v.z; lds[(n4 + 3) * 65 + kk] = v.w;
    }
    __syncthreads();
    {
      const int nn = tid >> 2, ks = (tid & 3) * 16;
      const int n = n0 + nn; int dst = n;
      if (mode == 1) dst = (n < 1024) ? ((n >> 5) * 64 + (n & 31)) : (((n - 1024) >> 5) * 64 + 32 + ((n - 1024) & 31));
      const float* s = lds + nn * 65 + ks;
      uint4 o0, o1;
      o0.x = pack2bf(s[0], s[1]); o0.y = pack2bf(s[2], s[3]); o0.z = pack2bf(s[4], s[5]); o0.w = pack2bf(s[6], s[7]);
      o1.x = pack2bf(s[8], s[9]); o1.y = pack2bf(s[10], s[11]); o1.z = pack2bf(s[12], s[13]); o1.w = pack2bf(s[14], s[15]);
      uint4* d = (uint4*)(Wt + (size_t)dst * K + k0 + ks);
      d[0] = o0; d[1] = o1;
    }
  }
}

DI void adaln_phase(const Params& P, float* lds) {
  float* part = (float*)(P.ws + WS_BIG);
  float* sc = lds;
  float* red = lds + 5 * 1024;
  bool loaded = false;
  for (int item = blockIdx.x; item < 4 * 48 * 8; item += gridDim.x) {
    const int tid = opaque((int)threadIdx.x);
    if (!loaded) {
      for (int e = tid; e < 5 * 1024; e += 256) {
        int j = e >> 10, k = e & 1023;
        float v = (j < 4) ? P.c[j * 1024 + k] : P.c_ctx[k];
        sc[e] = siluf_(v);
      }
      loaded = true;
    }
    __syncthreads();
    const int ksl = item & 7, cg_ = (item >> 3) % 48, layer = item / (8 * 48);
    const int n0 = cg_ * 64;
    const int col = tid & 63, ks = tid >> 6;
    const int kb = ksl * 128 + ks * 32;
    const float* W = P.ada_w + (size_t)layer * 1024 * 3072 + (size_t)kb * 3072 + n0 + col;
    float wv[32];
#pragma unroll
    for (int i = 0; i < 32; ++i) wv[i] = W[(size_t)i * 3072];
    float a0 = 0, a1 = 0, a2 = 0, a3 = 0, a4 = 0;
#pragma unroll
    for (int i = 0; i < 32; ++i) {
      const int k = kb + i; const float w = wv[i];
      a0 += sc[k] * w; a1 += sc[1024 + k] * w; a2 += sc[2048 + k] * w; a3 += sc[3072 + k] * w; a4 += sc[4096 + k] * w;
    }
    red[(ks * 5 + 0) * 64 + col] = a0; red[(ks * 5 + 1) * 64 + col] = a1; red[(ks * 5 + 2) * 64 + col] = a2;
    red[(ks * 5 + 3) * 64 + col] = a3; red[(ks * 5 + 4) * 64 + col] = a4;
    __syncthreads();
    for (int e = tid; e < 5 * 64; e += 256) {
      int j = e >> 6, cc = e & 63;
      float s = red[(0 * 5 + j) * 64 + cc] + red[(1 * 5 + j) * 64 + cc] + red[(2 * 5 + j) * 64 + cc] + red[(3 * 5 + j) * 64 + cc];
      part[(size_t)ksl * 61440 + (layer * 5 + j) * 3072 + n0 + cc] = s;
    }
  }
}

DI void adaln_reduce(const Params& P) {
  float* mod = (float*)(P.ws + WS_MOD);
  const float* part = (const float*)(P.ws + WS_BIG);
  for (int id = blockIdx.x * 256 + opaque((int)threadIdx.x); id < 61440; id += gridDim.x * 256) {
    float s = P.ada_b[(id / 15360) * 3072 + (id % 3072)];
#pragma unroll
    for (int k = 0; k < 8; ++k) s += part[(size_t)k * 61440 + id];
    mod[id] = s;
  }
}

DI void ew_phase(const Params& P, int prev, int next, const float* __restrict__ O, bf16_t* __restrict__ A) {
  const float* mod = (const float*)(P.ws + WS_MOD);
  float* hctx = (float*)(P.ws + WS_HCTX);
  const int gw = blockIdx.x * 4 + (opaque((int)threadIdx.x) >> 6), nw = gridDim.x * 4;
  for (int tok = gw; tok < NT; tok += nw) {
    const int lane = opaque((int)threadIdx.x) & 63;
    const int b = tok / TPB, pos = tok % TPB;
    const bool isctx = pos < CTX;
    if (isctx && prev == 3) continue;
    const int cj = isctx ? 4 : b;
    const float* hs; float* hd;
    if (isctx) { hd = hctx + (size_t)(b * CTX + pos) * D; hs = (prev <= 0) ? P.ctx + (size_t)(b * CTX + pos) * D : hd; }
    else { hd = P.out + (size_t)(b * SEQ + pos - CTX) * D; hs = (prev <= 0) ? P.x + (size_t)(b * SEQ + pos - CTX) * D : hd; }
    float4 h[4];
#pragma unroll
    for (int j = 0; j < 4; ++j) h[j] = *(const float4*)(hs + j * 256 + lane * 4);
    if (prev >= 0) {
      float4 o[4]; float ss = 0;
#pragma unroll
      for (int j = 0; j < 4; ++j) { o[j] = *(const float4*)(O + (size_t)tok * D + j * 256 + lane * 4); ss += o[j].x * o[j].x + o[j].y * o[j].y + o[j].z * o[j].z + o[j].w * o[j].w; }
      ss = wsum(ss);
      const float rstd = rsqrtf(ss * (1.f / 1024.f) + 1e-6f);
      const float* gt = mod + (prev * 5 + cj) * 3072 + 2048;
      const float* pg = P.post_g + prev * 1024;
#pragma unroll
      for (int j = 0; j < 4; ++j) {
        float4 g4 = *(const float4*)(gt + j * 256 + lane * 4), p4 = *(const float4*)(pg + j * 256 + lane * 4);
        h[j].x += g4.x * o[j].x * rstd * p4.x; h[j].y += g4.y * o[j].y * rstd * p4.y;
        h[j].z += g4.z * o[j].z * rstd * p4.z; h[j].w += g4.w * o[j].w * rstd * p4.w;
        *(float4*)(hd + j * 256 + lane * 4) = h[j];
      }
    }
    if (next >= 0) {
      float ss = 0;
#pragma unroll
      for (int j = 0; j < 4; ++j) ss += h[j].x * h[j].x + h[j].y * h[j].y + h[j].z * h[j].z + h[j].w * h[j].w;
      ss = wsum(ss);
      const float rstd = rsqrtf(ss * (1.f / 1024.f) + 1e-6f);
      const float* sh = mod + (next * 5 + cj) * 3072;
      const float* scl = sh + 1024;
      const float* pg = P.pre_g + next * 1024;
#pragma unroll
      for (int j = 0; j < 4; ++j) {
        float4 s4 = *(const float4*)(sh + j * 256 + lane * 4), c4 = *(const float4*)(scl + j * 256 + lane * 4), p4 = *(const float4*)(pg + j * 256 + lane * 4);
        bf16x4 r;
        r[0] = (short)f2bf(h[j].x * rstd * p4.x * (1.f + c4.x) + s4.x);
        r[1] = (short)f2bf(h[j].y * rstd * p4.y * (1.f + c4.y) + s4.y);
        r[2] = (short)f2bf(h[j].z * rstd * p4.z * (1.f + c4.z) + s4.z);
        r[3] = (short)f2bf(h[j].w * rstd * p4.w * (1.f + c4.w) + s4.w);
        *(bf16x4*)(A + (size_t)tok * D + j * 256 + lane * 4) = r;
      }
    }
  }
}


DI void st_pair(bf16_t* C, size_t ldc, int row_i, int col, float vi, float vi1, int r) {
  const bool odd = (r & 1) != 0;
  const float recv = __shfl_xor(odd ? vi : vi1, 1);
  const float lo = odd ? recv : vi, hi = odd ? vi1 : recv;
  *(unsigned*)(C + (size_t)(row_i + (odd ? 1 : 0)) * ldc + (col & ~1)) = pack2bf(lo, hi);
}

enum { EPI_BF16 = 0, EPI_F32, EPI_S5Y, EPI_GLU, EPI_NAIN, EPI_GDNIN };
struct Gemm {
  const bf16_t* A; long a_rs, a_kbs, a_bs;
  const bf16_t* A2; long a2_rs, a2_kbs, a2_bs; int K1;
  const bf16_t* Bt; long b_bs;
  int M, N, K, batch, epi;
  void* C; long ldc, c_bs;
  const bf16_t* zsrc; const float* bias; void* C2; void* C3;
};
constexpr int LDS_STRIDE = 72;
constexpr int GEMM_LDS_BYTES = 2 * 2 * 128 * LDS_STRIDE * 2;

DI void gemm_epilogue(const Gemm& g, int bt, int row0, int col0, f32x16 (&acc)[2][2]) {
  const int lane = opaque((int)threadIdx.x) & 63, r = lane & 31, h = lane >> 5;
  const bool full = (g.M & 127) == 0;
  if (g.epi == EPI_BF16) {
    bf16_t* C = (bf16_t*)g.C;
#pragma unroll
    for (int mi = 0; mi < 2; ++mi)
#pragma unroll
      for (int ni = 0; ni < 2; ++ni)
#pragma unroll
        for (int i = 0; i < 16; i += 2) {
          int row = row0 + mi * 32 + crow(i, h), col = col0 + ni * 32 + r;
          if (full) st_pair(C, g.ldc, row, col, acc[mi][ni][i], acc[mi][ni][i + 1], r);
          else {
            if (row < g.M) C[(size_t)row * g.ldc + col] = f2bf(acc[mi][ni][i]);
            if (row + 1 < g.M) C[(size_t)(row + 1) * g.ldc + col] = f2bf(acc[mi][ni][i + 1]);
          }
        }
  } else if (g.epi == EPI_F32) {
    float* C = (float*)g.C + (size_t)bt * g.c_bs;
#pragma unroll
    for (int mi = 0; mi < 2; ++mi)
#pragma unroll
      for (int ni = 0; ni < 2; ++ni)
#pragma unroll
        for (int i = 0; i < 16; ++i) {
          int row = row0 + mi * 32 + crow(i, h), col = col0 + ni * 32 + r;
          if (full || row < g.M) C[(size_t)row * g.ldc + col] = acc[mi][ni][i];
        }
  } else if (g.epi == EPI_S5Y) {
    bf16_t* C = (bf16_t*)g.C;
#pragma unroll
    for (int mi = 0; mi < 2; ++mi)
#pragma unroll
      for (int ni = 0; ni < 2; ++ni)
#pragma unroll
        for (int i = 0; i < 16; ++i) {
          int row = row0 + mi * 32 + crow(i, h), col = col0 + ni * 32 + r;
          if (full || row < g.M) {
            int tok = row * 16 + (col >> 4);
            C[(size_t)tok * D + bt * 16 + (col & 15)] = f2bf(geluf_(acc[mi][ni][i]));
          }
        }
  } else if (g.epi == EPI_GLU) {
    bf16_t* C = (bf16_t*)g.C;
    const int oc = (col0 >> 6) * 32 + r;
    const float ba = g.bias[oc], bb = g.bias[1024 + oc];
#pragma unroll
    for (int mi = 0; mi < 2; ++mi)
#pragma unroll
      for (int i = 0; i < 16; i += 2) {
        const int row = row0 + mi * 32 + crow(i, h);
        float y[2];
#pragma unroll
        for (int u = 0; u < 2; ++u) {
          const float ga = acc[mi][0][i + u] + ba, gb = acc[mi][1][i + u] + bb;
          const float z = bf2f(g.zsrc[(size_t)(row + u) * 2048 + 1024 + oc]);
          y[u] = ga * sigmoidf_(gb) * siluf_(z);
        }
        st_pair(C, D, row, oc, y[0], y[1], r);
      }
  } else if (g.epi == EPI_NAIN) {
    bf16_t* C = (bf16_t*)g.C;
    bf16_t* Vt = (bf16_t*)g.C2;
#pragma unroll
    for (int ni = 0; ni < 2; ++ni) {
      const int col = col0 + ni * 32 + r;
      if (col >= 2048 && col < 3072) {
        const int hh = (col - 2048) >> 6, d = (col - 2048) & 63;
#pragma unroll
        for (int mi = 0; mi < 2; ++mi)
#pragma unroll
          for (int q = 0; q < 4; ++q) {
            int row = row0 + mi * 32 + 8 * q + 4 * h;
            int b = row / TPB, pos = row % TPB;
            bf16x4 v;
            v[0] = (short)f2bf(acc[mi][ni][q * 4 + 0]); v[1] = (short)f2bf(acc[mi][ni][q * 4 + 1]);
            v[2] = (short)f2bf(acc[mi][ni][q * 4 + 2]); v[3] = (short)f2bf(acc[mi][ni][q * 4 + 3]);
            *(bf16x4*)(Vt + ((size_t)((b * 16 + hh) * 64 + d)) * TPB + pos) = v;
          }
      } else {
        const float sc = (col < 1024) ? 0.125f : 1.f;
#pragma unroll
        for (int mi = 0; mi < 2; ++mi)
#pragma unroll
          for (int i = 0; i < 16; i += 2) {
            int row = row0 + mi * 32 + crow(i, h);
            st_pair(C, 4096, row, col, acc[mi][ni][i] * sc, acc[mi][ni][i + 1] * sc, r);
          }
      }
    }
  } else if (g.epi == EPI_GDNIN) {
    bf16_t* C = (bf16_t*)g.C;
    float* AB = (float*)g.C2;
    bf16_t* Hb = (bf16_t*)g.C3;
#pragma unroll
    for (int ni = 0; ni < 2; ++ni) {
      const int col = col0 + ni * 32 + r;
      if (col < 4096) {
#pragma unroll
        for (int mi = 0; mi < 2; ++mi)
#pragma unroll
          for (int i = 0; i < 16; i += 2) {
            const int row = row0 + mi * 32 + crow(i, h);
            st_pair(C, 4096, row, col, acc[mi][ni][i], acc[mi][ni][i + 1], r);
            if (mi == 0 && i == 0) { if (h == 0 && col < 3072) { Hb[((size_t)(row >> 6) * 4 + 0) * 3072 + col] = f2bf(acc[mi][ni][0]); Hb[((size_t)(row >> 6) * 4 + 1) * 3072 + col] = f2bf(acc[mi][ni][1]); } }
            if (mi == 1 && i == 14) { if (h == 1 && col < 3072) { Hb[((size_t)(row >> 6) * 4 + 2) * 3072 + col] = f2bf(acc[mi][ni][14]); Hb[((size_t)(row >> 6) * 4 + 3) * 3072 + col] = f2bf(acc[mi][ni][15]); } }
          }
      } else if (col < 4128) {
#pragma unroll
        for (int mi = 0; mi < 2; ++mi)
#pragma unroll
          for (int i = 0; i < 16; ++i) {
            const int row = row0 + mi * 32 + crow(i, h);
            AB[(size_t)row * 32 + col - 4096] = acc[mi][ni][i];
          }
      }
    }
  }
}

DI void gemm_phase(const Gemm& g, unsigned char* smem) {
  bf16_t* sA = (bf16_t*)smem;
  bf16_t* sB = sA + 2 * 128 * 64;
  const int ntm = (g.M + 127) / 128, ntn = g.N / 128, nk = g.K / 64;
  const int tiles = g.batch * ntm * ntn;
  const int xcd = blockIdx.x & 7, loc = blockIdx.x >> 3, nloc = gridDim.x >> 3;
  const int t_lo = (int)((long)tiles * xcd / 8), t_hi = (int)((long)tiles * (xcd + 1) / 8);
  for (int tile = t_lo + loc; tile < t_hi; tile += nloc) {
    const int tid = opaque((int)threadIdx.x), lane = tid & 63, w = tid >> 6, wm = w >> 1, wn = w & 1;
    int bt = tile / (ntm * ntn); const int rem = tile % (ntm * ntn);
    int tm = rem / ntn, tn = rem % ntn;
    if (g.batch == 1 && ntm == 136) {
      const int li = tile - t_lo;
      const int band = li / (8 * ntn), idx = li - band * 8 * ntn;
      int row, col;
      if (band < 2) {
        const int nb = ntn >> 3, fullt = nb << 6;
        if (idx < fullt) { row = (idx & 63) >> 3; col = (idx >> 6) * 8 + (idx & 7); }
        else { const int wr = ntn - 8 * nb, i2 = idx - fullt; row = i2 / wr; col = 8 * nb + i2 % wr; }
      } else { row = 0; col = idx; }
      if (band == 1) col = ntn - 1 - col;
      bt = 0; tm = xcd * 17 + band * 8 + row; tn = col;
    }
    f32x16 acc[2][2];
#pragma unroll
    for (int mi = 0; mi < 2; ++mi)
#pragma unroll
      for (int ni = 0; ni < 2; ++ni)
#pragma unroll
        for (int i = 0; i < 16; ++i) acc[mi][ni][i] = 0.f;
#define STAGE1(KT, BUF, p) { \
        const int q = p * 256 + tid; \
        const int row = q >> 3, pc = q & 7; \
        const int c = pc ^ ((row >> 1) & 7); \
        const int grow = imin(tm * 128 + row, g.M - 1); \
        const int k = (KT) * 64 + c * 8; \
        const bf16_t* pa; \
        if (k < g.K1) pa = g.A + (long)bt * g.a_bs + (long)grow * g.a_rs + (long)(k >> 4) * g.a_kbs + (k & 15); \
        else { const int k2 = k - g.K1; pa = g.A2 + (long)bt * g.a2_bs + (long)grow * g.a2_rs + (long)(k2 >> 4) * g.a2_kbs + (k2 & 15); } \
        const bf16_t* pb = g.Bt + (long)bt * g.b_bs + (long)(tn * 128 + row) * g.K + k; \
        __builtin_amdgcn_global_load_lds((const unsigned*)pa, (lds_u32*)(sA + (BUF) * 8192 + q * 8), 16, 0, 0); \
        __builtin_amdgcn_global_load_lds((const unsigned*)pb, (lds_u32*)(sB + (BUF) * 8192 + q * 8), 16, 0, 0); }
#define STAGE(KT, BUF) { STAGE1(KT, BUF, 0) STAGE1(KT, BUF, 1) STAGE1(KT, BUF, 2) STAGE1(KT, BUF, 3) }
#define COMPUTE(BUF) { \
      const int ra0_ = wm * 64 + (lane & 31), ra1_ = ra0_ + 32, rb0_ = wn * 64 + (lane & 31), rb1_ = rb0_ + 32; \
      _Pragma("unroll") for (int ks = 0; ks < 4; ++ks) { \
        const int c = ks * 2 + (lane >> 5); \
        bf16x8 af0 = *(const bf16x8*)(sA + (BUF) * 8192 + ra0_ * 64 + ((c ^ ((ra0_ >> 1) & 7)) << 3)); \
        bf16x8 af1 = *(const bf16x8*)(sA + (BUF) * 8192 + ra1_ * 64 + ((c ^ ((ra1_ >> 1) & 7)) << 3)); \
        bf16x8 bf0 = *(const bf16x8*)(sB + (BUF) * 8192 + rb0_ * 64 + ((c ^ ((rb0_ >> 1) & 7)) << 3)); \
        bf16x8 bf1 = *(const bf16x8*)(sB + (BUF) * 8192 + rb1_ * 64 + ((c ^ ((rb1_ >> 1) & 7)) << 3)); \
        acc[0][0] = __builtin_amdgcn_mfma_f32_32x32x16_bf16(af0, bf0, acc[0][0], 0, 0, 0); \
        acc[0][1] = __builtin_amdgcn_mfma_f32_32x32x16_bf16(af0, bf1, acc[0][1], 0, 0, 0); \
        acc[1][0] = __builtin_amdgcn_mfma_f32_32x32x16_bf16(af1, bf0, acc[1][0], 0, 0, 0); \
        acc[1][1] = __builtin_amdgcn_mfma_f32_32x32x16_bf16(af1, bf1, acc[1][1], 0, 0, 0); \
      } }
    lds_barrier();
    STAGE(0, 0);
    asm volatile("s_waitcnt vmcnt(0)" ::: "memory");
    lds_barrier();
    for (int kt = 0; kt < nk; kt += 2) {
      STAGE(kt + 1, 1);
      COMPUTE(0);
      asm volatile("s_waitcnt vmcnt(0)" ::: "memory");
      lds_barrier();
      if (kt + 2 < nk) STAGE(kt + 2, 0);
      COMPUTE(1);
      asm volatile("s_waitcnt vmcnt(0)" ::: "memory");
      lds_barrier();
    }
#undef STAGE
#undef STAGE1
#undef COMPUTE
    gemm_epilogue(g, bt, tm * 128 + wm * 64, tn * 128 + wn * 64, acc);
  }
}

DI Gemm gemm_plain(const bf16_t* A, const bf16_t* Bt, int M, int N, int K, int epi, void* C, long ldc) {
  Gemm g{};
  g.A = A; g.a_rs = K; g.a_kbs = 16; g.a_bs = 0; g.A2 = A; g.K1 = K; g.a2_rs = K; g.a2_kbs = 16; g.a2_bs = 0;
  g.Bt = Bt; g.b_bs = 0; g.M = M; g.N = N; g.K = K; g.batch = 1; g.epi = epi; g.C = C; g.ldc = ldc; g.c_bs = 0;
  return g;
}

DI void sincos_red(double ang, float& s, float& c) {
  const double twopi = 6.283185307179586476925286766559;
  double t = ang / twopi; t = t - rint(t);
  float x = (float)(t * twopi);
  s = sinf(x); c = cosf(x);
}
DI void s5_pre_a(const Params& P, int j) {
  float2* apow = (float2*)(P.ws + WS_WT + WT_S5_APOW);
  float2* bbar = (float2*)(P.ws + WS_WT + WT_S5_BBAR);
  for (int id = blockIdx.x * 256 + opaque((int)threadIdx.x); id < 2 * 64 * 64; id += gridDim.x * 256) {
    const int d = id >> 12, g = (id >> 6) & 63, p = id & 63;
    const int base = ((j * 2 + d) * 64 + g);
    const double lr = P.s5_lam_re[base * 64 + p], li = P.s5_lam_im[base * 64 + p];
    const double dt = (double)expf(P.s5_log_dt[base]);
    float are = 1.f, aim = 0.f;
    for (int k = 0; k <= 16; ++k) {
      float mag = expf((float)(k * lr * dt)); float s, c; sincos_red(k * li * dt, s, c);
      apow[((d * 64 + g) * 17 + k) * 64 + p] = make_float2(mag * c, mag * s);
      if (k == 1) { are = mag * c; aim = mag * s; }
    }
    const float lrf = (float)lr, lif = (float)li;
    const float den = lrf * lrf + lif * lif;
    const float fre = ((are - 1.f) * lrf + aim * lif) / den, fim = (aim * lrf - (are - 1.f) * lif) / den;
    for (int c = 0; c < 16; ++c) {
      float br = P.s5_b_re[(size_t)(base * 64 + p) * 16 + c], bi = P.s5_b_im[(size_t)(base * 64 + p) * 16 + c];
      bbar[((d * 64 + g) * 64 + p) * 16 + c] = make_float2(fre * br - fim * bi, fre * bi + fim * br);
    }
  }
}
DI void s5_pre_b(const Params& P, int j) {
  const float2* apow = (const float2*)(P.ws + WS_WT + WT_S5_APOW);
  const float2* bbar = (const float2*)(P.ws + WS_WT + WT_S5_BBAR);
  float* ktab = (float*)(P.ws + WS_WT + WT_S5_KTAB);
  bf16_t* opt = (bf16_t*)(P.ws + WS_WT + WT_S5_OPT);
  bf16_t* bpt = (bf16_t*)(P.ws + WS_WT + WT_S5_BPT);
  const int gt = blockIdx.x * 256 + opaque((int)threadIdx.x), gn = gridDim.x * 256;
  for (int id = gt; id < 2 * 64 * 16 * 16 * 2; id += gn) {
    const int c2b = (id & 1) * 8, c = (id >> 1) & 15, k = (id >> 5) & 15, g = (id >> 9) & 63, d = id >> 15;
    const int base = ((j * 2 + d) * 64 + g);
    const float* cr = P.s5_c_re + (size_t)(base * 16 + c) * 64;
    const float* ci = P.s5_c_im + (size_t)(base * 16 + c) * 64;
    const float2* ap = apow + ((d * 64 + g) * 17 + k) * 64;
    const float2* bp = bbar + ((d * 64 + g) * 64) * 16 + c2b;
    float s[8];
#pragma unroll
    for (int u = 0; u < 8; ++u) s[u] = 0.f;
#pragma unroll 4
    for (int p = 0; p < 64; ++p) {
      const float2 a = ap[p];
      const float xr = cr[p] * a.x - ci[p] * a.y, xi = cr[p] * a.y + ci[p] * a.x;
#pragma unroll
      for (int u = 0; u < 8; ++u) { const float2 b = bp[p * 16 + u]; s[u] += xr * b.x - xi * b.y; }
    }
    float* kd = ktab + ((((d * 64 + g) * 16 + k) * 16 + c) * 16) + c2b;
    *(float4*)kd = make_float4(s[0], s[1], s[2], s[3]);
    *(float4*)(kd + 4) = make_float4(s[4], s[5], s[6], s[7]);
  }
  for (int id = gt; id < 64 * 256 * 32; id += gn) {
    const int kk = (id & 31) * 8, n = (id >> 5) & 255, g = id >> 13;
    const int i = kk >> 4, c2b = kk & 15, d = n >> 7, ri = (n >> 6) & 1, p = n & 63;
    const int e = d == 0 ? 15 - i : i;
    const float2 a = apow[((d * 64 + g) * 17 + e) * 64 + p];
    const float2* bp = bbar + ((d * 64 + g) * 64 + p) * 16 + c2b;
    float v[8];
#pragma unroll
    for (int u = 0; u < 8; ++u) { const float2 b = bp[u]; v[u] = ri ? (a.x * b.y + a.y * b.x) : (a.x * b.x - a.y * b.y); }
    uint4 o; o.x = pack2bf(v[0], v[1]); o.y = pack2bf(v[2], v[3]); o.z = pack2bf(v[4], v[5]); o.w = pack2bf(v[6], v[7]);
    *(uint4*)(bpt + ((size_t)(g * 256 + n)) * 256 + kk) = o;
  }
  for (int id = gt; id < 64 * 256 * 32; id += gn) {
    const int kk = (id & 31) * 8, n = (id >> 5) & 255, g = id >> 13;
    const int jj = n >> 4, c = n & 15, d = kk >> 7, ri = (kk >> 6) & 1, p0 = kk & 63;
    const int e = d == 0 ? jj + 1 : 16 - jj;
    const int base = ((j * 2 + d) * 64 + g);
    const float2* ap = apow + ((d * 64 + g) * 17 + e) * 64 + p0;
    const float* crp = P.s5_c_re + (size_t)(base * 16 + c) * 64 + p0;
    const float* cip = P.s5_c_im + (size_t)(base * 16 + c) * 64 + p0;
    float v[8];
#pragma unroll
    for (int u = 0; u < 8; ++u) { const float2 a = ap[u]; const float cr = crp[u], ci = cip[u]; v[u] = ri ? -(cr * a.y + ci * a.x) : (cr * a.x - ci * a.y); }
    uint4 o; o.x = pack2bf(v[0], v[1]); o.y = pack2bf(v[2], v[3]); o.z = pack2bf(v[4], v[5]); o.w = pack2bf(v[6], v[7]);
    *(uint4*)(opt + ((size_t)g * 256 + n) * 512 + 256 + kk) = o;
  }
}
DI void s5_pre_c(const Params& P, int j) {
  const float* ktab = (const float*)(P.ws + WS_WT + WT_S5_KTAB);
  bf16_t* opt = (bf16_t*)(P.ws + WS_WT + WT_S5_OPT);
  for (int id = blockIdx.x * 256 + opaque((int)threadIdx.x); id < 64 * 256 * 32; id += gridDim.x * 256) {
    const int kk = (id & 31) * 8, n = (id >> 5) & 255, g = id >> 13;
    const int jj = n >> 4, c = n & 15, i = kk >> 4, c2b = kk & 15;
    float v[8];
#pragma unroll
    for (int u = 0; u < 8; ++u) v[u] = 0.f;
    if (i <= jj) {
      const float* kp = ktab + (((0 * 64 + g) * 16 + (jj - i)) * 16 + c) * 16 + c2b;
#pragma unroll
      for (int u = 0; u < 8; ++u) v[u] += kp[u];
    }
    if (i >= jj) {
      const float* kp = ktab + (((1 * 64 + g) * 16 + (i - jj)) * 16 + c) * 16 + c2b;
#pragma unroll
      for (int u = 0; u < 8; ++u) v[u] += kp[u];
    }
    if (i == jj) {
      const float dv = P.s5_d[j * 1024 + g * 16 + c];
#pragma unroll
      for (int u = 0; u < 8; ++u) if (c2b + u == c) v[u] += dv;
    }
    uint4 o; o.x = pack2bf(v[0], v[1]); o.y = pack2bf(v[2], v[3]); o.z = pack2bf(v[4], v[5]); o.w = pack2bf(v[6], v[7]);
    *(uint4*)(opt + ((size_t)g * 256 + n) * 512 + kk) = o;
  }
}
DI void s5_carry(const Params& P, const float* __restrict__ Sloc, bf16_t* __restrict__ Sin) {
  const float2* apow = (const float2*)(P.ws + WS_WT + WT_S5_APOW);
  const int wv = opaque((int)threadIdx.x) >> 6;
  for (int task = blockIdx.x + gridDim.x * wv; task < 512; task += gridDim.x * 4) {
    const int p = opaque((int)threadIdx.x) & 63;
    const int d = task & 1, b = (task >> 1) & 3, g = task >> 3;
    const float2 a = apow[((d * 64 + g) * 17 + 16) * 64 + p];
    const size_t base = ((size_t)g * 1088 + b * 272) * 256 + d * 128 + p;
    float sr = 0.f, si = 0.f;
    for (int s0 = 0; s0 < 272; s0 += 16) {
      float lr[16], li[16];
#pragma unroll
      for (int u = 0; u < 16; ++u) {
        const int step = s0 + u;
        const int q = d == 0 ? step : (step < 16 ? 15 - step : 287 - step);
        const size_t o = base + (size_t)q * 256;
        lr[u] = Sloc[o]; li[u] = Sloc[o + 64];
      }
#pragma unroll
      for (int u = 0; u < 16; ++u) {
        const int step = s0 + u;
        const int q = d == 0 ? step : (step < 16 ? 15 - step : 287 - step);
        const size_t o = base + (size_t)q * 256;
        Sin[o] = f2bf(sr); Sin[o + 64] = f2bf(si);
        const float nr = a.x * sr - a.y * si + lr[u], ni = a.x * si + a.y * sr + li[u];
        sr = nr; si = ni;
      }
    }
  }
}

template <bool WIN>
DI void na_step(const bf16_t* sK, const bf16_t* sV, const bf16x8 (&qf)[2], float& m, float& lsum, f32x4 (&O)[4],
                const float* __restrict__ rpb, int hd, int r, int r0, int step, int cs, int wq, int start, int lq, int lg) {
  constexpr int NTILE = WIN ? 4 : 8;
  f32x4 S[NTILE];
#pragma unroll
  for (int t = 0; t < NTILE; ++t) {
    const int kidx = WIN ? ((t >> 1) * 64 + cs + (t & 1) * 16 + lq) : (t * 16 + lq);
    f32x4 s = f32x4{0.f, 0.f, 0.f, 0.f};
#pragma unroll
    for (int kk = 0; kk < 2; ++kk) {
      bf16x8 kf = *(const bf16x8*)(sK + kidx * 72 + kk * 32 + lg * 8);
      s = __builtin_amdgcn_mfma_f32_16x16x32_bf16(kf, qf[kk], s, 0, 0, 0);
    }
    S[t] = s;
  }
  if (WIN) {
#pragma unroll
    for (int t = 0; t < NTILE; ++t) {
      const int ro = r0 + step * 2 + (t >> 1) - r + 7;
#pragma unroll
      for (int e = 0; e < 4; ++e) {
        const int col = cs + (t & 1) * 16 + lg * 4 + e;
        const bool valid = (col >= start) && (col < start + 16);
        const int co = imin(imax(col - wq + 15, 0), 30);
        const float bias = rpb[(hd * 15 + ro) * 31 + co];
        S[t][e] = valid ? S[t][e] + bias : -1e30f;
      }
    }
  }
  float mx = -1e30f;
#pragma unroll
  for (int t = 0; t < NTILE; ++t)
#pragma unroll
    for (int e = 0; e < 4; ++e) mx = fmaxf(mx, S[t][e]);
  mx = fmaxf(mx, __shfl_xor(mx, 16)); mx = fmaxf(mx, __shfl_xor(mx, 32));
  const float mnew = fmaxf(m, mx);
  const float alpha = __expf(m - mnew);
  float ps = 0.f;
#pragma unroll
  for (int t = 0; t < NTILE; ++t)
#pragma unroll
    for (int e = 0; e < 4; ++e) { float pv = __expf(S[t][e] - mnew); S[t][e] = pv; ps += pv; }
  lsum = lsum * alpha + ps; m = mnew;
#pragma unroll
  for (int dt = 0; dt < 4; ++dt) O[dt] *= alpha;
#pragma unroll
  for (int pr = 0; pr < NTILE / 2; ++pr) {
    bf16x8 pf;
#pragma unroll
    for (int e = 0; e < 4; ++e) { pf[e] = (short)f2bf(S[2 * pr][e]); pf[4 + e] = (short)f2bf(S[2 * pr + 1][e]); }
    const int pos0 = WIN ? (pr * 64 + cs + lg * 4) : (pr * 32 + lg * 4);
#pragma unroll
    for (int dt = 0; dt < 4; ++dt) {
      const bf16_t* vb = sV + (dt * 16 + lq) * 136;
      bf16x4 lo = *(const bf16x4*)(vb + pos0), hi = *(const bf16x4*)(vb + pos0 + 16);
      bf16x8 vf = __builtin_shufflevector(lo, hi, 0, 1, 2, 3, 4, 5, 6, 7);
      O[dt] = __builtin_amdgcn_mfma_f32_16x16x32_bf16(vf, pf, O[dt], 0, 0, 0);
    }
  }
}

DI void na_attn(const Params& P, const bf16_t* __restrict__ Pb, const bf16_t* __restrict__ Vt, bf16_t* __restrict__ Y, unsigned char* smem) {
  bf16_t* sK = (bf16_t*)smem;
  bf16_t* sV = sK + 128 * 72;
  const float* rpb = P.na_rpb;
  const int xcd_ = blockIdx.x & 7, nloc_ = gridDim.x >> 3;
  for (int job = xcd_ * 544 + (blockIdx.x >> 3); job < (xcd_ + 1) * 544; job += nloc_) {
    const int tid = opaque((int)threadIdx.x);
    const int lane = tid & 63, wv = tid >> 6;
    const int lq = lane & 15, lg = lane >> 4;
    int b, hd, r = 0, r0 = 0, cs = 0, w0 = 0, qtok, s_lo;
    if (job < 4096) { b = job >> 10; hd = (job >> 6) & 15; r = job & 63; w0 = wv * 16; r0 = imin(imax(r - 4, 0), 56); cs = imin(imax(w0 - 8, 0), 32); qtok = b * TPB + CTX + r * 64 + w0 + lq; s_lo = 0; }
    else { int jj = job - 4096; b = jj >> 6; hd = (jj >> 2) & 15; qtok = b * TPB + (jj & 3) * 64 + wv * 16 + lq; s_lo = 4; }
    bf16x8 qf[2];
#pragma unroll
    for (int kk = 0; kk < 2; ++kk) qf[kk] = *(const bf16x8*)(Pb + (size_t)qtok * 4096 + hd * 64 + kk * 32 + lg * 8);
    float m = -1e30f, lsum = 0.f;
    f32x4 O[4];
#pragma unroll
    for (int dt = 0; dt < 4; ++dt) O[dt] = f32x4{0.f, 0.f, 0.f, 0.f};
    const int wq = w0 + lq;
    const int start = imin(imax(wq - 8, 0), 48);
    uint4 rk0, rk1, rk2, rk3, rv0, rv1, rv2, rv3;
    const bf16_t* vrow = Vt + (size_t)((b * 16 + hd) * 64) * TPB;
#define NA_LOAD1(p, RK, RV, STEP) { \
      const int e = tid + p * 256; \
      const int key = e >> 3, part = e & 7; \
      const int ktok = (STEP) < 4 ? (b * TPB + CTX + (r0 + (STEP) * 2 + (key >> 6)) * 64 + (key & 63)) : (b * TPB + ((STEP) - 4) * 128 + key); \
      RK = *(const uint4*)(Pb + (size_t)ktok * 4096 + 1024 + hd * 64 + part * 8); \
      const int d = e >> 4, seg = e & 15; \
      const int vpos = (STEP) < 4 ? (CTX + (r0 + (STEP) * 2 + (seg >> 3)) * 64 + (seg & 7) * 8) : (((STEP) - 4) * 128 + seg * 8); \
      RV = *(const uint4*)(vrow + (size_t)d * TPB + vpos); }
#define NA_LOAD(STEP) { NA_LOAD1(0, rk0, rv0, STEP) NA_LOAD1(1, rk1, rv1, STEP) NA_LOAD1(2, rk2, rv2, STEP) NA_LOAD1(3, rk3, rv3, STEP) }
#define NA_STORE1(p, RK, RV) { \
      const int e = tid + p * 256; \
      *(uint4*)(sK + (e >> 3) * 72 + (e & 7) * 8) = RK; \
      *(uint4*)(sV + (e >> 4) * 136 + (e & 15) * 8) = RV; }
#define NA_STORE() { NA_STORE1(0, rk0, rv0) NA_STORE1(1, rk1, rv1) NA_STORE1(2, rk2, rv2) NA_STORE1(3, rk3, rv3) }
    NA_LOAD(s_lo);
    for (int step = s_lo; step < 6; ++step) {
      __syncthreads();
      NA_STORE();
      __syncthreads();
      if (step + 1 < 6) NA_LOAD(step + 1);
      if (step < 4) na_step<true>(sK, sV, qf, m, lsum, O, rpb, hd, r, r0, step, cs, wq, start, lq, lg);
      else na_step<false>(sK, sV, qf, m, lsum, O, rpb, hd, r, r0, step, cs, wq, start, lq, lg);
    }
#undef NA_LOAD
#undef NA_LOAD1
#undef NA_STORE
#undef NA_STORE1
    lsum += __shfl_xor(lsum, 16); lsum += __shfl_xor(lsum, 32);
    const float inv = 1.f / lsum;
#pragma unroll
    for (int dt = 0; dt < 4; ++dt) {
      const int dcol = hd * 64 + dt * 16 + lg * 4;
      bf16x4 z4 = *(const bf16x4*)(Pb + (size_t)qtok * 4096 + 3072 + dcol);
      bf16x4 o4;
#pragma unroll
      for (int e = 0; e < 4; ++e) o4[e] = (short)f2bf(O[dt][e] * inv * siluf_(bf2f((bf16_t)z4[e])));
      *(bf16x4*)(Y + (size_t)qtok * D + dcol) = o4;
    }
  }
}

DI int gdn_pos(int s, int dir) { return dir == 0 ? s : (s < CTX ? CTX - 1 - s : (TPB + CTX - 1) - s); }

DI unsigned u4c(const uint4& u, int k) { return k == 0 ? u.x : (k == 1 ? u.y : (k == 2 ? u.z : u.w)); }
DI void gdn_conv(const Params& P, bf16_t* __restrict__ Pb, const bf16_t* __restrict__ Hb) {
  for (int item = blockIdx.x; item < 272 * 6; item += gridDim.x) {
    const int tid = opaque((int)threadIdx.x), c8 = tid & 63, tq = tid >> 6;
    const int tile = item / 6, slab = item % 6;
    const int ch = slab * 512 + c8 * 8;
    const int tok0 = tile * 64;
    const int seg_first = ((tok0 % TPB) == 0) || ((tok0 % TPB) == CTX);
    const int seg_last = (((tok0 + 64) % TPB) == 0) || (((tok0 + 64) % TPB) == CTX);
    uint4 raw[20];
#pragma unroll
    for (int i = 0; i < 20; ++i) {
      const int lr = tq * 16 + i - 2;
      uint4 u = make_uint4(0u, 0u, 0u, 0u);
      if (lr >= 0 && lr < 64) u = *(const uint4*)(Pb + (size_t)(tok0 + lr) * 4096 + ch);
      else if (lr < 0) { if (!seg_first) u = *(const uint4*)(Hb + ((size_t)(tile - 1) * 4 + 2 + (lr + 2)) * 3072 + ch); }
      else { if (!seg_last) u = *(const uint4*)(Hb + ((size_t)(tile + 1) * 4 + (lr - 64)) * 3072 + ch); }
      raw[i] = u;
    }
    float w[5][8];
#pragma unroll
    for (int j = 0; j < 5; ++j) {
      const float4 a = *(const float4*)(P.gdn_conv_w + j * 3072 + ch), b = *(const float4*)(P.gdn_conv_w + j * 3072 + ch + 4);
      w[j][0] = a.x; w[j][1] = a.y; w[j][2] = a.z; w[j][3] = a.w; w[j][4] = b.x; w[j][5] = b.y; w[j][6] = b.z; w[j][7] = b.w;
    }
    __syncthreads();
#pragma unroll
    for (int i = 0; i < 16; ++i) {
      float y[8];
#pragma unroll
      for (int e = 0; e < 8; ++e) {
        float acc = 0.f;
#pragma unroll
        for (int j = 0; j < 5; ++j) {
          const unsigned d = u4c(raw[i + j], e >> 1);
          const float v = (e & 1) ? __uint_as_float(d & 0xffff0000u) : __uint_as_float(d << 16);
          acc += w[j][e] * v;
        }
        y[e] = siluf_(acc);
      }
      if (slab < 4) {
        float ss = 0.f;
#pragma unroll
        for (int e = 0; e < 8; ++e) ss += y[e] * y[e];
        ss += __shfl_xor(ss, 1); ss += __shfl_xor(ss, 2); ss += __shfl_xor(ss, 4); ss += __shfl_xor(ss, 8);
        const float rn = rsqrtf(ss + 1e-6f);
#pragma unroll
        for (int e = 0; e < 8; ++e) y[e] *= rn;
      }
      uint4 o;
      o.x = pack2bf(y[0], y[1]); o.y = pack2bf(y[2], y[3]); o.z = pack2bf(y[4], y[5]); o.w = pack2bf(y[6], y[7]);
      *(uint4*)(Pb + (size_t)(tok0 + tq * 16 + i) * 4096 + ch) = o;
    }
    __syncthreads();
  }
}

DI void gdn_prep(const Params& P, const bf16_t* __restrict__ Pb, const float* __restrict__ AB, bf16_t* __restrict__ Ob, int c_lo, int c_hi, int set, unsigned* ctr, unsigned char* smem) {
  bf16_t* sK = (bf16_t*)smem;
  bf16_t* sQ = sK + 64 * 136;
  bf16_t* sV = sQ + 64 * 136;
  float* sL = (float*)(sV + 64 * 136);
  float* sG = sL + 64 * 68;
  float* sBt = sG + 64;
  bf16_t* Wb = (bf16_t*)(P.ws + WS_WT + WT_G_W) + (size_t)set * 512 * 8192;
  bf16_t* Aq = (bf16_t*)(P.ws + WS_WT + (set ? WT_G_HALO : WT_G_AQK));
  float* Gc = (float*)(P.ws + WS_WT + WT_G_GC) + set * 512 * 64;
  int* s_item = (int*)(sBt + 64);
  const int nc = c_hi - c_lo;
  for (;;) {
    __syncthreads();
    if (threadIdx.x == 0) *s_item = (int)atomicAdd(ctr, 1u);
    __syncthreads();
    const int item = *s_item;
    if (item >= 64 * nc) break;
    const int tid = opaque((int)threadIdx.x), lane = tid & 63, w = tid >> 6;
    const int chain = item % 64, lc = item / 64;
    const int cidx = c_lo + lc;
    const int b = chain >> 4, hd = (chain >> 1) & 7, dir = chain & 1;
    const int slot = chain * GDN_R + lc;
    bf16_t* Ub = Ob + (((size_t)(dir * 32 + b * 8 + hd)) * TPB + cidx * 64) * 128;
    __syncthreads();
#pragma unroll
    for (int p = 0; p < 4; ++p) {
      const int e = tid + p * 256; const int row = e >> 4, kc = (e & 15) * 8;
      const int tok = b * TPB + gdn_pos(cidx * 64 + row, dir);
      const bf16_t* src = Pb + (size_t)tok * 4096 + hd * 128 + kc;
      *(uint4*)(sQ + row * 136 + kc) = *(const uint4*)(src);
      *(uint4*)(sK + row * 136 + kc) = *(const uint4*)(src + 1024);
      *(uint4*)(sV + row * 136 + kc) = *(const uint4*)(src + 2048);
    }
    if (tid < 64) {
      const int tok = b * TPB + gdn_pos(cidx * 64 + tid, dir);
      const float araw = AB[(size_t)tok * 32 + dir * 8 + hd] + P.gdn_dt_bias[dir * 8 + hd];
      const float sp = araw > 20.f ? araw : log1pf(__expf(araw));
      float gl = -__expf(P.gdn_a_log[dir * 8 + hd]) * sp;
      const float beta = sigmoidf_(AB[(size_t)tok * 32 + 16 + dir * 8 + hd]);
#pragma unroll
      for (int o = 1; o < 64; o <<= 1) { float t = __shfl_up(gl, o); if (lane >= o) gl += t; }
      sG[tid] = gl; sBt[tid] = beta; sBt[68 + tid] = beta * __expf(gl);
      Gc[slot * 64 + tid] = gl;
    }
    __syncthreads();
    {
      const int mi = w >> 1, ni = w & 1, r = lane & 31, h = lane >> 5;
      f32x16 kk, qk;
#pragma unroll
      for (int i = 0; i < 16; ++i) { kk[i] = 0.f; qk[i] = 0.f; }
#pragma unroll
      for (int ks = 0; ks < 8; ++ks) {
        bf16x8 ak = *(const bf16x8*)(sK + (mi * 32 + r) * 136 + ks * 16 + h * 8);
        bf16x8 aq = *(const bf16x8*)(sQ + (mi * 32 + r) * 136 + ks * 16 + h * 8);
        bf16x8 bk = *(const bf16x8*)(sK + (ni * 32 + r) * 136 + ks * 16 + h * 8);
        kk = __builtin_amdgcn_mfma_f32_32x32x16_bf16(ak, bk, kk, 0, 0, 0);
        qk = __builtin_amdgcn_mfma_f32_32x32x16_bf16(aq, bk, qk, 0, 0, 0);
      }
      const int col = ni * 32 + r;
      const float gcol = sG[col];
#pragma unroll
      for (int i = 0; i < 16; ++i) {
        const int row = mi * 32 + crow(i, h);
        const float grow = sG[row];
        const float dec = (col <= row) ? __expf(grow - gcol) : 0.f;
        sL[row * 68 + col] = (col < row) ? sBt[row] * kk[i] * dec : 0.f;
        Aq[((size_t)slot * 64 + row) * 64 + col] = f2bf(0.08838834764831845f * qk[i] * dec);
      }
    }
    __syncthreads();
    {
      float x[64];
#pragma unroll
      for (int i = 0; i < 64; ++i) x[i] = 0.f;
      const bool isv = tid < 128;
      const bf16_t* srcm = isv ? (sV + tid) : (sK + (tid - 128));
      const float* scl = isv ? sBt : (sBt + 68);
#pragma unroll
      for (int rr = 0; rr < 64; rr += 2) {
        const int ro0 = opaque(rr * 68);
        float a0 = bf2f(srcm[rr * 136]) * scl[rr];
        float a1 = bf2f(srcm[(rr + 1) * 136]) * scl[rr + 1];
        float l10 = 0.f;
#pragma unroll
        for (int c4 = 0; c4 < (rr + 4) / 4; ++c4) {
          const float4 p4 = *(const float4*)(sL + ro0 + c4 * 4);
          const float4 q4 = *(const float4*)(sL + ro0 + 68 + c4 * 4);
          a0 -= p4.x * x[c4 * 4 + 0]; a0 -= p4.y * x[c4 * 4 + 1]; a0 -= p4.z * x[c4 * 4 + 2]; a0 -= p4.w * x[c4 * 4 + 3];
          a1 -= q4.x * x[c4 * 4 + 0]; a1 -= q4.y * x[c4 * 4 + 1]; a1 -= q4.z * x[c4 * 4 + 2]; a1 -= q4.w * x[c4 * 4 + 3];
          if (c4 == rr / 4) l10 = ((rr & 3) == 0) ? q4.x : (((rr & 3) == 2) ? q4.z : 0.f);
        }
        a1 -= l10 * a0;
        asm volatile("" : "+v"(a0), "+v"(a1) :: "memory");
        x[rr] = a0; x[rr + 1] = a1;
      }
      bf16_t* dst = isv ? (Ub + tid) : (Wb + (size_t)slot * 64 * 128 + (tid - 128));
#pragma unroll
      for (int rr = 0; rr < 64; ++rr) dst[rr * 128] = f2bf(x[rr]);
    }
  }
}

struct ChainRegs { bf16x8 a1[8]; bf16x8 aq[4]; uint4 kt[4]; float g; };
DI void chain_load(ChainRegs& R, const bf16_t* __restrict__ Pb, const bf16_t* __restrict__ Wb, const bf16_t* __restrict__ Ub,
                   const bf16_t* __restrict__ Aq, const float* __restrict__ Gc, int slot, int cidx, int b, int hd, int dir, int dvb,
                   int tid, int w, int r, int h) {
  const int strip = w & 1;
  const bf16_t* arow;
  if (w < 2) arow = Wb + ((size_t)slot * 64 + strip * 32 + r) * 128;
  else { const int tok = b * TPB + gdn_pos(cidx * 64 + strip * 32 + r, dir); arow = Pb + (size_t)tok * 4096 + hd * 128; }
#pragma unroll
  for (int ks = 0; ks < 8; ++ks) R.a1[ks] = *(const bf16x8*)(arow + ks * 16 + h * 8);
  if (w < 2) {
    const bf16_t* ub = Ub + (((size_t)(dir * 32 + b * 8 + hd)) * TPB + cidx * 64) * 128 + dvb * 32 + r;
#pragma unroll
    for (int i = 0; i < 16; ++i) R.aq[i >> 3][i & 7] = (short)ub[(strip * 32 + crow(i, h)) * 128];
  } else {
    const bf16_t* aqrow = Aq + ((size_t)slot * 64 + strip * 32 + r) * 64;
#pragma unroll
    for (int ks = 0; ks < 4; ++ks) R.aq[ks] = *(const bf16x8*)(aqrow + ks * 16 + h * 8);
  }
  R.g = (tid < 64) ? Gc[slot * 64 + tid] : 0.f;
}
DI void chain_load_k(ChainRegs& R, const bf16_t* __restrict__ Pb, int cidx, int b, int hd, int dir, int tid) {
#pragma unroll
  for (int p = 0; p < 4; ++p) {
    const int e = tid + p * 256; const int row = e >> 4, kc = (e & 15) * 8;
    const int tok = b * TPB + gdn_pos(cidx * 64 + row, dir);
    R.kt[p] = *(const uint4*)(Pb + (size_t)tok * 4096 + 1024 + hd * 128 + kc);
  }
}
DI void gdn_chain(const Params& P, const bf16_t* __restrict__ Pb, bf16_t* Ob, int c_lo, int c_hi, int set, unsigned char* smem, bool save = true) {
  if (blockIdx.x >= 256) return;
  bf16_t* sSt = (bf16_t*)smem;
  bf16_t* sVn = sSt + 32 * 136;
  bf16_t* sVd = sVn + 32 * 72;
  bf16_t* sKt = sVd + 32 * 72;
  float* sG = (float*)(sKt + 64 * 136);
  const bf16_t* Wb = (const bf16_t*)(P.ws + WS_WT + WT_G_W) + (size_t)set * 512 * 8192;
  const bf16_t* Ub = Ob;
  const bf16_t* Aq = (const bf16_t*)(P.ws + WS_WT + (set ? WT_G_HALO : WT_G_AQK));
  const float* Gc = (const float*)(P.ws + WS_WT + WT_G_GC) + set * 512 * 64;
  float* Sst = (float*)(P.ws + WS_SST);
  const int tid = opaque((int)threadIdx.x), lane = tid & 63, w = tid >> 6, r = lane & 31, h = lane >> 5;
  const int chain = blockIdx.x >> 2, dvb = blockIdx.x & 3;
  const int b = chain >> 4, hd = (chain >> 1) & 7, dir = chain & 1;
  const int strip = w & 1;
  f32x16 S;
  if (c_lo == 0) {
#pragma unroll
    for (int i = 0; i < 16; ++i) S[i] = 0.f;
  } else {
#pragma unroll
    for (int i = 0; i < 16; ++i) S[i] = Sst[((size_t)blockIdx.x * 16 + i) * 256 + tid];
  }
  ChainRegs cur, nxt;
  chain_load(cur, Pb, Wb, Ub, Aq, Gc, chain * GDN_R, c_lo, b, hd, dir, dvb, tid, w, r, h);
  chain_load_k(cur, Pb, c_lo, b, hd, dir, tid);
  nxt = cur;
  const int tid0 = tid;
  for (int cidx = c_lo; cidx < c_hi; ++cidx) {
    const int tid = opaque(tid0), lane = tid & 63, w = tid >> 6, r = lane & 31, h = lane >> 5, strip = w & 1;
    const int slot = chain * GDN_R + (cidx - c_lo);
    __syncthreads();
#pragma unroll
    for (int q = 0; q < 4; ++q) {
      bf16x4 v;
#pragma unroll
      for (int e = 0; e < 4; ++e) v[e] = (short)f2bf(S[q * 4 + e]);
      *(bf16x4*)(sSt + r * 136 + w * 32 + 8 * q + 4 * h) = v;
    }
    if (tid < 64) {
      const float g63w = __shfl(cur.g, 63);
      sG[tid] = __expf(g63w - cur.g);
      sG[64 + tid] = 0.08838834764831845f * __expf(cur.g);
      if (tid == 63) sG[128] = __expf(cur.g);
    }
#pragma unroll
    for (int p = 0; p < 4; ++p) {
      const int e = tid + p * 256; const int row = e >> 4, kc = (e & 15) * 8;
      *(uint4*)(sKt + row * 136 + kc) = cur.kt[p];
    }
    if (cidx + 1 < c_hi) chain_load(nxt, Pb, Wb, Ub, Aq, Gc, slot + 1, cidx + 1, b, hd, dir, dvb, tid, w, r, h);
    __syncthreads();
    f32x16 acc1, acc1b;
#pragma unroll
    for (int i = 0; i < 16; ++i) { acc1[i] = 0.f; acc1b[i] = 0.f; }
#pragma unroll
    for (int ks = 0; ks < 8; ks += 2) {
      bf16x8 bfr0 = *(const bf16x8*)(sSt + r * 136 + ks * 16 + h * 8);
      bf16x8 bfr1 = *(const bf16x8*)(sSt + r * 136 + (ks + 1) * 16 + h * 8);
      acc1 = __builtin_amdgcn_mfma_f32_32x32x16_bf16(cur.a1[ks], bfr0, acc1, 0, 0, 0);
      acc1b = __builtin_amdgcn_mfma_f32_32x32x16_bf16(cur.a1[ks + 1], bfr1, acc1b, 0, 0, 0);
    }
#pragma unroll
    for (int i = 0; i < 16; ++i) acc1[i] += acc1b[i];
    if (w < 2) {
#pragma unroll
      for (int q = 0; q < 4; ++q) {
        bf16x4 vn, vd;
#pragma unroll
        for (int e = 0; e < 4; ++e) {
          const int row = strip * 32 + 8 * q + 4 * h + e;
          const float v = bf2f((bf16_t)cur.aq[(q * 4 + e) >> 3][(q * 4 + e) & 7]) - acc1[q * 4 + e];
          vn[e] = (short)f2bf(v);
          vd[e] = (short)f2bf(v * sG[row]);
        }
        *(bf16x4*)(sVn + r * 72 + strip * 32 + 8 * q + 4 * h) = vn;
        *(bf16x4*)(sVd + r * 72 + strip * 32 + 8 * q + 4 * h) = vd;
      }
    }
    __syncthreads();
    if (cidx + 1 < c_hi) chain_load_k(nxt, Pb, cidx + 1, b, hd, dir, tid);
    if (w >= 2) {
      f32x16 av;
#pragma unroll
      for (int i = 0; i < 16; ++i) av[i] = 0.f;
#pragma unroll
      for (int ks = 0; ks < 4; ++ks) {
        bf16x8 bfr = *(const bf16x8*)(sVn + r * 72 + ks * 16 + h * 8);
        av = __builtin_amdgcn_mfma_f32_32x32x16_bf16(cur.aq[ks], bfr, av, 0, 0, 0);
      }
      bf16_t* ob = Ob + (((size_t)(dir * 32 + b * 8 + hd)) * TPB + cidx * 64) * 128 + dvb * 32 + r;
#pragma unroll
      for (int i = 0; i < 16; ++i) {
        const int row = strip * 32 + crow(i, h);
        const float o = sG[64 + row] * acc1[i] + av[i];
        ob[(size_t)row * 128] = f2bf(o);
      }
    }
    {
      const float eg = sG[128];
      f32x16 d0, d1;
#pragma unroll
      for (int i = 0; i < 16; ++i) { d0[i] = 0.f; d1[i] = 0.f; }
#pragma unroll
      for (int ks = 0; ks < 4; ++ks) {
        bf16x8 af;
#pragma unroll
        for (int j = 0; j < 8; ++j) af[j] = (short)sKt[(ks * 16 + h * 8 + j) * 136 + w * 32 + r];
        bf16x8 bfr = *(const bf16x8*)(sVd + r * 72 + ks * 16 + h * 8);
        if (ks & 1) d1 = __builtin_amdgcn_mfma_f32_32x32x16_bf16(af, bfr, d1, 0, 0, 0);
        else d0 = __builtin_amdgcn_mfma_f32_32x32x16_bf16(af, bfr, d0, 0, 0, 0);
      }
#pragma unroll
      for (int i = 0; i < 16; ++i) S[i] = S[i] * eg + (d0[i] + d1[i]);
    }
    cur = nxt;
  }
  if (save) {
#pragma unroll
    for (int i = 0; i < 16; ++i) Sst[((size_t)blockIdx.x * 16 + i) * 256 + tid] = S[i];
  }
}

DI void gdn_post(const Params& P, const bf16_t* Pb, const bf16_t* __restrict__ Ob, bf16_t* Y, int ldy) {
  const int gw = blockIdx.x * 4 + (opaque((int)threadIdx.x) >> 6), nw = gridDim.x * 4;
  for (int tok = gw; tok < NT; tok += nw) {
    const int lane = opaque((int)threadIdx.x) & 63;
    const int l16 = lane & 15, hq = lane >> 4;
    const float4 ga = *(const float4*)(P.gdn_norm_g + l16 * 8), gb = *(const float4*)(P.gdn_norm_g + l16 * 8 + 4);
    const float gn[8] = {ga.x, ga.y, ga.z, ga.w, gb.x, gb.y, gb.z, gb.w};
    const int b = tok / TPB, pos = tok % TPB;
    const int sf = pos, sr = pos < CTX ? CTX - 1 - pos : (TPB + CTX - 1) - pos;
#pragma unroll
    for (int it = 0; it < 2; ++it) {
      const int hd = it * 4 + hq;
      const uint4 uf = *(const uint4*)(Ob + (((size_t)(0 * 32 + b * 8 + hd)) * TPB + sf) * 128 + l16 * 8);
      const uint4 ur = *(const uint4*)(Ob + (((size_t)(1 * 32 + b * 8 + hd)) * TPB + sr) * 128 + l16 * 8);
      const uint4 uz = *(const uint4*)(Pb + (size_t)tok * 4096 + 3072 + hd * 128 + l16 * 8);
      float o[8], z[8];
#pragma unroll
      for (int k = 0; k < 4; ++k) {
        const unsigned f = u4c(uf, k), r = u4c(ur, k), zz = u4c(uz, k);
        o[2 * k] = __uint_as_float(f << 16) + __uint_as_float(r << 16);
        o[2 * k + 1] = __uint_as_float(f & 0xffff0000u) + __uint_as_float(r & 0xffff0000u);
        z[2 * k] = __uint_as_float(zz << 16); z[2 * k + 1] = __uint_as_float(zz & 0xffff0000u);
      }
      float ss = 0.f;
#pragma unroll
      for (int e = 0; e < 8; ++e) ss += o[e] * o[e];
      ss += __shfl_xor(ss, 1); ss += __shfl_xor(ss, 2); ss += __shfl_xor(ss, 4); ss += __shfl_xor(ss, 8);
      const float rstd = rsqrtf(ss * (1.f / 128.f) + 1e-6f);
      float y[8];
#pragma unroll
      for (int e = 0; e < 8; ++e) y[e] = o[e] * rstd * gn[e] * siluf_(z[e]);
      uint4 ov;
      ov.x = pack2bf(y[0], y[1]); ov.y = pack2bf(y[2], y[3]); ov.z = pack2bf(y[4], y[5]); ov.w = pack2bf(y[6], y[7]);
      *(uint4*)(Y + (size_t)tok * ldy + hd * 128 + l16 * 8) = ov;
    }
  }
}

#ifndef DUP_MASK
#define DUP_MASK 0
#endif
#define NREP(cat) (((DUP_MASK >> (cat)) & 1) ? 2 : 1)
constexpr int PH_S5 = 6;
constexpr int PH_GDN = 5 + GDN_ROUNDS;
constexpr int PH_NA = 3;
constexpr int L0_BASE = 3;
constexpr int E1_PH = L0_BASE + PH_S5;
constexpr int L1_BASE = E1_PH + 1;
constexpr int E2_PH = L1_BASE + PH_GDN;
constexpr int L2_BASE = E2_PH + 1;
constexpr int E3_PH = L2_BASE + PH_NA;
constexpr int PB3_PH = E3_PH + 1;
constexpr int L3_BASE = PB3_PH + 1;
constexpr int E4_PH = L3_BASE + PH_S5;
constexpr int NPHASES = E4_PH + 1;

DI void s5_layer_phase(const Params& P, int j, int sub, unsigned char* smem) {
  unsigned char* big = P.ws + WS_BIG;
  bf16_t* Pb = (bf16_t*)(big);
  bf16_t* A = (bf16_t*)(big + 5 * UNIT);
  float* Sloc = (float*)(big + 2 * UNIT);
  bf16_t* Sin = (bf16_t*)(big + 4 * UNIT);
  bf16_t* Y1 = (bf16_t*)(big + 5 * UNIT);
  bf16_t* Y2 = (bf16_t*)(big + 2 * UNIT);
  float* O = (float*)(big + 3 * UNIT);
  unsigned char* wt = P.ws + WS_WT;
  switch (sub) {
    case 0: {
      for (int rep_ = 0; rep_ < NREP(6); ++rep_) s5_pre_c(P, j);
      Gemm g = gemm_plain(A, (const bf16_t*)(wt + WT_S5_IN), NT, 2048, 1024, EPI_BF16, Pb, 2048);
      for (int rep_ = 0; rep_ < NREP(0); ++rep_) gemm_phase(g, smem);
    } break;
    case 1: {
      Gemm g{};
      g.A = Pb; g.a_rs = 16 * 2048; g.a_kbs = 2048; g.a_bs = 16; g.A2 = Pb; g.a2_rs = g.a_rs; g.a2_kbs = g.a_kbs; g.a2_bs = 16; g.K1 = 256;
      g.Bt = (const bf16_t*)(wt + WT_S5_BPT); g.b_bs = 256 * 256; g.M = 1088; g.N = 256; g.K = 256; g.batch = 64; g.epi = EPI_F32;
      g.C = Sloc; g.ldc = 256; g.c_bs = 1088 * 256;
      for (int rep_ = 0; rep_ < NREP(0); ++rep_) gemm_phase(g, smem);
    } break;
    case 2: for (int rep_ = 0; rep_ < NREP(3); ++rep_) s5_carry(P, Sloc, Sin); break;
    case 3: {
      Gemm g{};
      g.A = Pb; g.a_rs = 16 * 2048; g.a_kbs = 2048; g.a_bs = 16; g.K1 = 256;
      g.A2 = Sin; g.a2_rs = 256; g.a2_kbs = 16; g.a2_bs = 1088 * 256;
      g.Bt = (const bf16_t*)(wt + WT_S5_OPT); g.b_bs = 256 * 512; g.M = 1088; g.N = 256; g.K = 512; g.batch = 64; g.epi = EPI_S5Y;
      g.C = Y1;
      for (int rep_ = 0; rep_ < NREP(0); ++rep_) gemm_phase(g, smem);
    } break;
    case 4: {
      Gemm g = gemm_plain(Y1, (const bf16_t*)(wt + WT_S5_GLU), NT, 2048, 1024, EPI_GLU, Y2, 1024);
      g.zsrc = Pb; g.bias = P.s5_glu_b + j * 2048;
      for (int rep_ = 0; rep_ < NREP(0); ++rep_) gemm_phase(g, smem);
    } break;
    case 5: {
      Gemm g = gemm_plain(Y2, (const bf16_t*)(wt + WT_S5_OUT), NT, 1024, 1024, EPI_F32, O, 1024);
      for (int rep_ = 0; rep_ < NREP(0); ++rep_) gemm_phase(g, smem);
    } break;
    default: break;
  }
}
DI void s5_convert(const Params& P, int j, float* lds) {
  unsigned char* wt = P.ws + WS_WT;
  convert_wt(P.s5_in_w + (size_t)j * 1024 * 2048, 1024, 2048, 2048, (bf16_t*)(wt + WT_S5_IN), 0, lds);
  convert_wt(P.s5_glu_w + (size_t)j * 1024 * 2048, 1024, 2048, 2048, (bf16_t*)(wt + WT_S5_GLU), 1, lds);
  convert_wt(P.s5_out_w + (size_t)j * 1024 * 1024, 1024, 1024, 1024, (bf16_t*)(wt + WT_S5_OUT), 0, lds);
}

DI void run_phase(const Params& P, int ph, unsigned char* smem) {
  unsigned char* big = P.ws + WS_BIG;
  unsigned char* wt = P.ws + WS_WT;
  float* lds = (float*)smem;
  if (ph == 0) { for (int rep_ = 0; rep_ < NREP(6); ++rep_) { adaln_phase(P, lds); s5_convert(P, 0, lds); s5_pre_a(P, 0); } return; }
  if (ph == 1) { for (int rep_ = 0; rep_ < NREP(6); ++rep_) { adaln_reduce(P); s5_pre_b(P, 0); } return; }
  if (ph == 2) { ew_phase(P, -1, 0, nullptr, (bf16_t*)(big + 5 * UNIT)); return; }
  if (ph >= L0_BASE && ph < E1_PH) { s5_layer_phase(P, 0, ph - L0_BASE, smem); return; }
  if (ph == E1_PH) {
    ew_phase(P, 0, 1, (const float*)(big + 3 * UNIT), (bf16_t*)(big + 5 * UNIT));
    for (int rep_ = 0; rep_ < NREP(6); ++rep_) {
    convert_wt(P.gdn_in_w, 1024, 4128, 4224, (bf16_t*)(wt + WT_G_IN), 0, lds);
    convert_wt(P.gdn_out_w, 1024, 1024, 1024, (bf16_t*)(wt + WT_G_OUT), 0, lds); }
    return;
  }
  if (ph >= L1_BASE && ph < E2_PH) {
    const int sub = ph - L1_BASE;
    bf16_t* Pb = (bf16_t*)big;
    bf16_t* A = (bf16_t*)(big + 5 * UNIT);
    bf16_t* Ob = (bf16_t*)(big + 4 * UNIT);
    float* AB = (float*)(P.ws + WS_AB);
    bf16_t* Hb = (bf16_t*)(wt + WT_G_HALO);
    if (sub == 0) {
      Gemm g = gemm_plain(A, (const bf16_t*)(wt + WT_G_IN), NT, 4224, 1024, EPI_GDNIN, Pb, 4096);
      g.C2 = AB; g.C3 = Hb;
      for (int rep_ = 0; rep_ < NREP(0); ++rep_) gemm_phase(g, smem);
    } else if (sub == 1) {
      gdn_conv(P, Pb, Hb);
    } else if (sub < 3 + GDN_ROUNDS) {
      unsigned* ctr = (unsigned*)(P.ws + WS_BAR) + XCD_BAR_WORDS;
      const int rd = sub - 3;
      if (rd >= 0) { const int c_lo = rd * GDN_R, c_hi = imin(GDN_NCH, c_lo + GDN_R); gdn_chain(P, Pb, Ob, c_lo, c_hi, rd & 1, smem); }
      const int pr = rd + 1;
      if (pr < GDN_ROUNDS) { const int c_lo = pr * GDN_R, c_hi = imin(GDN_NCH, c_lo + GDN_R); gdn_prep(P, Pb, AB, Ob, c_lo, c_hi, pr & 1, ctr + pr * 16, smem); }
    } else if (sub == 3 + GDN_ROUNDS) {
      for (int rep_ = 0; rep_ < NREP(6); ++rep_) gdn_post(P, Pb, Ob, Pb, 4096);
    } else {
      Gemm g = gemm_plain(Pb, (const bf16_t*)(wt + WT_G_OUT), NT, 1024, 1024, EPI_F32, (float*)(big + 4 * UNIT), 1024);
      g.a_rs = 4096; g.a2_rs = 4096;
      for (int rep_ = 0; rep_ < NREP(0); ++rep_) gemm_phase(g, smem);
    }
    return;
  }
  if (ph == E2_PH) {
    ew_phase(P, 1, 2, (const float*)(big + 4 * UNIT), (bf16_t*)(big));
    for (int rep_ = 0; rep_ < NREP(6); ++rep_) {
    convert_wt(P.na_in_w, 1024, 4096, 4096, (bf16_t*)(wt + WT_N_IN), 0, lds);
    convert_wt(P.na_out_w, 1024, 1024, 1024, (bf16_t*)(wt + WT_N_OUT), 0, lds); }
    return;
  }
  if (ph >= L2_BASE && ph < E3_PH) {
    const int sub = ph - L2_BASE;
    bf16_t* A = (bf16_t*)big;
    bf16_t* Pb = (bf16_t*)(big + 1 * UNIT);
    bf16_t* Vt = (bf16_t*)(big + 5 * UNIT);
    bf16_t* Y1 = (bf16_t*)big;
    float* O = (float*)(big + 1 * UNIT);
    if (sub == 0) {
      Gemm g = gemm_plain(A, (const bf16_t*)(wt + WT_N_IN), NT, 4096, 1024, EPI_NAIN, Pb, 4096);
      g.C2 = Vt;
      for (int rep_ = 0; rep_ < NREP(0); ++rep_) gemm_phase(g, smem);
    } else if (sub == 1) {
      for (int rep_ = 0; rep_ < NREP(1); ++rep_) na_attn(P, Pb, Vt, Y1, smem);
    } else {
      Gemm g = gemm_plain(Y1, (const bf16_t*)(wt + WT_N_OUT), NT, 1024, 1024, EPI_F32, O, 1024);
      for (int rep_ = 0; rep_ < NREP(0); ++rep_) gemm_phase(g, smem);
    }
    return;
  }
  if (ph == E3_PH) {
    ew_phase(P, 2, 3, (const float*)(big + 1 * UNIT), (bf16_t*)(big + 5 * UNIT));
    for (int rep_ = 0; rep_ < NREP(6); ++rep_) { s5_convert(P, 1, lds); s5_pre_a(P, 1); }
    return;
  }
  if (ph == PB3_PH) { for (int rep_ = 0; rep_ < NREP(6); ++rep_) s5_pre_b(P, 1); return; }
  if (ph >= L3_BASE && ph < E4_PH) { s5_layer_phase(P, 1, ph - L3_BASE, smem); return; }
  if (ph == E4_PH) { ew_phase(P, 3, -1, (const float*)(big + 3 * UNIT), nullptr); return; }
}

#ifndef NO_MEGA
__global__ void __launch_bounds__(NTHREADS, 2) mega(Params P) {
  extern __shared__ __attribute__((aligned(16))) unsigned char smem[];
  __shared__ uint4 xb_words;
  cg::grid_group grid = cg::this_grid();
  if (threadIdx.x == 0) xb_words = make_uint4(0u, 0u, 0u, 0u);
  __syncthreads();
  XcdBarrier xb = xcd_barrier_post((unsigned*)(P.ws + WS_BAR), (volatile LAS unsigned*)&xb_words);
  if (P.ph_lo < 0) grid.sync();
  for (int ph = P.ph_lo; ph < P.ph_hi; ++ph) {
    run_phase(P, ph, smem);
    if (ph + 1 < P.ph_hi) { xcd_barrier(xb); if (DUP_MASK & 32) xcd_barrier(xb); }
  }
}

#ifndef MULTI_LAUNCH
#define MULTI_LAUNCH 0
#endif

extern "C" void kernel_launch(void* const* d_in, const int* in_sizes, int n_in, void* d_out, int out_size, void* d_ws, size_t ws_size, hipStream_t stream) {
  static int grid_blocks = 0;
  if (!grid_blocks) {
    int dev = 0, cus = 0, per_cu = 0;
    hipGetDevice(&dev);
    hipDeviceGetAttribute(&cus, hipDeviceAttributeMultiprocessorCount, dev);
    hipFuncSetAttribute((const void*)mega, hipFuncAttributeMaxDynamicSharedMemorySize, GEMM_LDS_BYTES);
    hipOccupancyMaxActiveBlocksPerMultiprocessor(&per_cu, (const void*)mega, NTHREADS, GEMM_LDS_BYTES);
    if (per_cu > 2) per_cu = 2;
    if (per_cu < 1) per_cu = 1;
    grid_blocks = cus * per_cu;
    if (ws_size < WS_END) fprintf(stderr, "kernel_launch: workspace too small: %zu < %zu\n", ws_size, (size_t)WS_END);
  }
  Params p{};
  const float** f = (const float**)&p;
  for (int i = 0; i < 29; ++i) f[i] = (const float*)d_in[i];
  p.out = (float*)d_out; p.ws = (unsigned char*)d_ws;
#if MULTI_LAUNCH
  for (int ph = 0; ph < NPHASES; ++ph) {
    p.ph_lo = ph; p.ph_hi = ph + 1;
    hipLaunchKernelGGL(mega, dim3(grid_blocks), dim3(NTHREADS), GEMM_LDS_BYTES, stream, p);
  }
#else
  p.ph_lo = 0; p.ph_hi = NPHASES;
  hipMemsetAsync((unsigned char*)d_ws + WS_BAR, 0, 16384, stream);
  void* args[] = {&p};
  hipError_t e = hipLaunchCooperativeKernel((const void*)mega, dim3(grid_blocks), dim3(NTHREADS), args, GEMM_LDS_BYTES, stream);
  if (e != hipSuccess) fprintf(stderr, "cooperative launch failed: %s (grid %d)\n", hipGetErrorString(e), grid_blocks);
#endif
}
#endif
```

```cpp
#include <hip/hip_runtime.h>
#include <hip/hip_cooperative_groups.h>
#include <cstdio>
namespace cg = cooperative_groups;

typedef unsigned short bf16_t;
typedef __attribute__((ext_vector_type(8))) short bf16x8;
typedef __attribute__((ext_vector_type(4))) short bf16x4;
typedef __attribute__((ext_vector_type(16))) float f32x16;
typedef __attribute__((ext_vector_type(4))) float f32x4;
#define DI __device__ __forceinline__
typedef __attribute__((address_space(3))) unsigned lds_u32;

constexpr int D = 1024;
constexpr int NB = 4;
constexpr int SEQ = 4096;
constexpr int CTX = 256;
constexpr int TPB = SEQ + CTX;
constexpr int NT = NB * TPB;
constexpr int NTHREADS = 256;
constexpr int GDN_R = 8;
constexpr int GDN_NCH = 68;
constexpr int GDN_ROUNDS = (GDN_NCH + GDN_R - 1) / GDN_R;

constexpr size_t MiB = 1024 * 1024;
constexpr size_t UNIT = (size_t)NT * 1024 * 2;
constexpr size_t WS_MOD = 0;
constexpr size_t WS_BAR = 245760;
constexpr size_t WS_HCTX = 262144;
constexpr size_t WS_AB = WS_HCTX + 4 * MiB;
constexpr size_t WS_SST = WS_AB + (size_t)NT * 32 * 4;
constexpr size_t WS_WT = WS_SST + 4 * MiB;
constexpr size_t WT_S5_IN = 0;
constexpr size_t WT_S5_GLU = WT_S5_IN + 4 * MiB;
constexpr size_t WT_S5_OUT = WT_S5_GLU + 4 * MiB;
constexpr size_t WT_S5_APOW = WT_S5_OUT + 2 * MiB;
constexpr size_t WT_S5_BBAR = WT_S5_APOW + 2 * 64 * 17 * 64 * 8;
constexpr size_t WT_S5_KTAB = WT_S5_BBAR + 2 * 64 * 64 * 16 * 8;
constexpr size_t WT_S5_OPT = WT_S5_KTAB + 2 * 64 * 16 * 256 * 4;
constexpr size_t WT_S5_BPT = WT_S5_OPT + (size_t)64 * 256 * 512 * 2;
constexpr size_t WT_S5_END = WT_S5_BPT + (size_t)64 * 256 * 256 * 2;
constexpr size_t WT_G_IN = 0;
constexpr size_t WT_G_OUT = WT_G_IN + (size_t)4224 * 1024 * 2;
constexpr size_t WT_G_HALO = WT_G_OUT + 2 * MiB;
constexpr size_t WT_G_W = WT_G_HALO + (size_t)272 * 4 * 3072 * 2;
constexpr size_t WT_G_AQK = WT_G_W + (size_t)2 * 64 * GDN_R * 64 * 128 * 2;
constexpr size_t WT_G_GC = WT_G_AQK + (size_t)64 * GDN_R * 64 * 64 * 2;
constexpr size_t WT_G_END = WT_G_GC + (size_t)2 * 64 * GDN_R * 64 * 4;
static_assert((size_t)64 * GDN_R * 64 * 64 * 2 <= (size_t)272 * 4 * 3072 * 2, "Aqk set 1 must fit the halo region");
constexpr size_t WT_N_IN = 0;
constexpr size_t WT_N_OUT = 8 * MiB;
constexpr size_t WT_SIZE = (WT_S5_END > WT_G_END ? WT_S5_END : WT_G_END);
constexpr size_t WS_BIG = (WS_WT + WT_SIZE + 255) / 256 * 256;
constexpr size_t WS_END = WS_BIG + 6 * UNIT;
static_assert(WS_END <= 256 * MiB, "workspace too large");

struct Params {
  const float *x, *c, *ctx, *c_ctx, *ada_w, *ada_b, *pre_g, *post_g;
  const float *s5_in_w, *s5_lam_re, *s5_lam_im, *s5_log_dt, *s5_b_re, *s5_b_im, *s5_c_re, *s5_c_im, *s5_d, *s5_glu_w, *s5_glu_b, *s5_out_w;
  const float *gdn_in_w, *gdn_conv_w, *gdn_a_log, *gdn_dt_bias, *gdn_norm_g, *gdn_out_w;
  const float *na_in_w, *na_rpb, *na_out_w;
  float* out;
  unsigned char* ws;
  int ph_lo, ph_hi;
};

DI bf16_t f2bf(float x) { return __builtin_bit_cast(unsigned short, (__bf16)x); }
typedef __attribute__((ext_vector_type(2))) __bf16 bf16v2;
typedef __attribute__((ext_vector_type(2))) float f32v2;
DI unsigned pack2bf(float lo, float hi) { f32v2 v = {lo, hi}; return __builtin_bit_cast(unsigned, __builtin_convertvector(v, bf16v2)); }
DI float bf2f(bf16_t b) { return __uint_as_float(((unsigned)b) << 16); }
DI float wsum(float v) {
#pragma unroll
  for (int o = 32; o > 0; o >>= 1) v += __shfl_xor(v, o);
  return v;
}
DI float sigmoidf_(float x) { return __builtin_amdgcn_rcpf(1.f + __expf(-x)); }
DI float siluf_(float x) { return x * __builtin_amdgcn_rcpf(1.f + __expf(-x)); }
DI float geluf_(float x) { float u = 1.5957691216057308f * (x + 0.044715f * x * x * x); return x * __builtin_amdgcn_rcpf(1.f + __expf(-u)); }
DI int crow(int i, int h) { return (i & 3) + 8 * (i >> 2) + 4 * h; }
DI void lds_barrier() { asm volatile("s_waitcnt lgkmcnt(0)" ::: "memory"); __builtin_amdgcn_s_barrier(); asm volatile("" ::: "memory"); }
DI int opaque(int v) { asm volatile("" : "+v"(v)); return v; }
DI int imin(int a, int b) { return a < b ? a : b; }
DI int imax(int a, int b) { return a > b ? a : b; }


#define XB_TMO      128
#define XB_XCNT(j)  (256  + 64 * (j))
#define XB_XSUB(j)  (1280 + 64 * (j))
#define XB_XGEN(j)  (2304 + 64 * (j))
#define XB_TOP      3328
#define XB_TOPGEN   3392
#define XCD_BAR_WORDS 3456
#define XB_SPIN_CAP (1u << 18)
#define LAS __attribute__((address_space(3)))
DI unsigned xb_ld(unsigned* p)              { return __hip_atomic_load(p, __ATOMIC_RELAXED, __HIP_MEMORY_SCOPE_AGENT); }
DI unsigned xb_add(unsigned* p, unsigned v) { return __hip_atomic_fetch_add(p, v, __ATOMIC_RELAXED, __HIP_MEMORY_SCOPE_AGENT); }
DI unsigned xb_xcc_id() { return (unsigned)__builtin_amdgcn_s_getreg((3 << 11) | 20) & 0xFu; }
#define XB_SPIN(cond, bar) do { unsigned _sp = 0; while (cond) { __builtin_amdgcn_s_sleep(1); \
    if ((++_sp & 255u) == 0u) { if (xb_ld(&(bar)[XB_TMO])) break; if (_sp > XB_SPIN_CAP) { atomicAdd(&(bar)[XB_TMO], 1u); break; } } } } while (0)
struct XcdBarrier { unsigned* bar; unsigned x; volatile LAS unsigned* st; };
DI XcdBarrier xcd_barrier_post(unsigned* bar, volatile LAS unsigned* st) {
  XcdBarrier b; b.bar = bar; b.x = xb_xcc_id(); b.st = st;
  if (threadIdx.x == 0) (void)xb_add(&bar[XB_XCNT(b.x)], 1u);
  return b;
}
DI void xcd_barrier_complete(unsigned* bar, unsigned x, unsigned& nloc, unsigned& nx) {
  const unsigned G = gridDim.x * gridDim.y * gridDim.z;
  unsigned sum, cnt, mine, sp = 0u;
  for (;;) {
    sum = 0u; cnt = 0u; mine = 0u;
#pragma unroll
    for (unsigned j = 0; j < 16; ++j) { const unsigned c = xb_ld(&bar[XB_XCNT(j)]); sum += c; cnt += (c > 0u) ? 1u : 0u; mine = (j == x) ? c : mine; }
    if (sum == G) break;
    __builtin_amdgcn_s_sleep(1);
    if ((++sp & 255u) == 0u) { if (xb_ld(&bar[XB_TMO])) break; if (sp > XB_SPIN_CAP) { atomicAdd(&bar[XB_TMO], 1u); break; } }
  }
  nloc = mine > 0u ? mine : 1u; nx = cnt > 0u ? cnt : 1u;
}
DI void xcd_barrier(const XcdBarrier& b) {
  asm volatile("s_waitcnt vmcnt(0)" ::: "memory");
  __syncthreads();
  if (threadIdx.x == 0) {
    unsigned* bar = b.bar;
    __builtin_amdgcn_s_waitcnt(0);
    unsigned nloc = b.st[0], nx = b.st[1];
    if (nloc == 0u) { xcd_barrier_complete(bar, b.x, nloc, nx); b.st[0] = nloc; b.st[1] = nx; }
    const unsigned old = xb_add(&bar[XB_XSUB(b.x)], 1u);
    const unsigned gen = old / nloc;
    if (old + 1u == (gen + 1u) * nloc) {
      __builtin_amdgcn_fence(__ATOMIC_RELEASE, "agent");
      asm volatile("s_waitcnt vmcnt(0)" ::: "memory");
      const unsigned og = xb_add(&bar[XB_TOP], 1u);
      const unsigned tg = og / nx;
      if (og + 1u == (tg + 1u) * nx) xb_add(&bar[XB_TOPGEN], 1u);
      else XB_SPIN(xb_ld(&bar[XB_TOPGEN]) == tg, bar);
      __builtin_amdgcn_fence(__ATOMIC_ACQUIRE, "agent");
      xb_add(&bar[XB_XGEN(b.x)], 1u);
      asm volatile("s_waitcnt vmcnt(0)" ::: "memory");
    } else {
      XB_SPIN(xb_ld(&bar[XB_XGEN(b.x)]) == gen, bar);
      __builtin_amdgcn_fence(__ATOMIC_ACQUIRE, "agent");
      asm volatile("s_waitcnt vmcnt(0)" ::: "memory");
    }
  }
  __syncthreads();
}

DI void convert_wt(const float* __restrict__ W, int K, int N, int Npad, bf16_t* __restrict__ Wt, int mode, float* lds) {
  const int tk = K / 64, tn = Npad / 64;
  for (int t = blockIdx.x; t < tk * tn; t += gridDim.x) {
    const int tid = opaque((int)threadIdx.x);
    const int k0 = (t % tk) * 64, n0 = (t / tk) * 64;
    __syncthreads();
#pragma unroll
    for (int p = 0; p < 4; ++p) {
      const int kk = (tid >> 4) + p * 16, n4 = (tid & 15) * 4;
      float4 v = make_float4(0.f, 0.f, 0.f, 0.f);
      if (n0 + n4 < N) v = *(const float4*)(W + (size_t)(k0 + kk) * N + n0 + n4);
      lds[(n4 + 0) * 65 + kk] = v.x; lds[(n4 + 1) * 65 + kk] = v.y; lds[(n4 + 2) * 65 + kk] = v.z; lds[(n4 + 3) * 65 + kk] = v.w;
    }
    __syncthreads();
    {
      const int nn = tid >> 2, ks = (tid & 3) * 16;
      const int n = n0 + nn; int dst = n;
      if (mode == 1) dst = (n < 1024) ? ((n >> 5) * 64 + (n & 31)) : (((n - 1024) >> 5) * 64 + 32 + ((n - 1024) & 31));
      const float* s = lds + nn * 65 + ks;
      uint4 o0, o1;
      o0.x = pack2bf(s[0], s[1]); o0.y = pack2bf(s[2], s[3]); o0.z = pack2bf(s[4], s[5]); o0.w = pack2bf(s[6], s[7]);
      o1.x = pack2bf(s[8], s[9]); o1.y = pack2bf(s[10], s[11]); o1.z = pack2bf(s[12], s[13]); o1.w = pack2bf(s[14], s[15]);
      uint4* d = (uint4*)(Wt + (size_t)dst * K + k0 + ks);
      d[0] = o0; d[1] = o1;
    }
  }
}

DI void adaln_phase(const Params& P, float* lds) {
  float* part = (float*)(P.ws + WS_BIG);
  float* sc = lds;
  float* red = lds + 5 * 1024;
  bool loaded = false;
  for (int item = blockIdx.x; item < 4 * 48 * 8; item += gridDim.x) {
    const int tid = opaque((int)threadIdx.x);
    if (!loaded) {
      for (int e = tid; e < 5 * 1024; e += 256) {
        int j = e >> 10, k = e & 1023;
        float v = (j < 4) ? P.c[j * 1024 + k] : P.c_ctx[k];
        sc[e] = siluf_(v);
      }
      loaded = true;
    }
    __syncthreads();
    const int ksl = item & 7, cg_ = (item >> 3) % 48, layer = item / (8 * 48);
    const int n0 = cg_ * 64;
    const int col = tid & 63, ks = tid >> 6;
    const int kb = ksl * 128 + ks * 32;
    const float* W = P.ada_w + (size_t)layer * 1024 * 3072 + (size_t)kb * 3072 + n0 + col;
    float wv[32];
#pragma unroll
    for (int i = 0; i < 32; ++i) wv[i] = W[(size_t)i * 3072];
    float a0 = 0, a1 = 0, a2 = 0, a3 = 0, a4 = 0;
#pragma unroll
    for (int i = 0; i < 32; ++i) {
      const int k = kb + i; const float w = wv[i];
      a0 += sc[k] * w; a1 += sc[1024 + k] * w; a2 += sc[2048 + k] * w; a3 += sc[3072 + k] * w; a4 += sc[4096 + k] * w;
    }
    red[(ks * 5 + 0) * 64 + col] = a0; red[(ks * 5 + 1) * 64 + col] = a1; red[(ks * 5 + 2) * 64 + col] = a2;
    red[(ks * 5 + 3) * 64 + col] = a3; red[(ks * 5 + 4) * 64 + col] = a4;
    __syncthreads();
    for (int e = tid; e < 5 * 64; e += 256) {
      int j = e >> 6, cc = e & 63;
      float s = red[(0 * 5 + j) * 64 + cc] + red[(1 * 5 + j) * 64 + cc] + red[(2 * 5 + j) * 64 + cc] + red[(3 * 5 + j) * 64 + cc];
      part[(size_t)ksl * 61440 + (layer * 5 + j) * 3072 + n0 + cc] = s;
    }
  }
}

DI void adaln_reduce(const Params& P) {
  float* mod = (float*)(P.ws + WS_MOD);
  const float* part = (const float*)(P.ws + WS_BIG);
  for (int id = blockIdx.x * 256 + opaque((int)threadIdx.x); id < 61440; id += gridDim.x * 256) {
    float s = P.ada_b[(id / 15360) * 3072 + (id % 3072)];
#pragma unroll
    for (int k = 0; k < 8; ++k) s += part[(size_t)k * 61440 + id];
    mod[id] = s;
  }
}

DI void ew_phase(const Params& P, int prev, int next, const float* __restrict__ O, bf16_t* __restrict__ A) {
  const float* mod = (const float*)(P.ws + WS_MOD);
  float* hctx = (float*)(P.ws + WS_HCTX);
  const int gw = blockIdx.x * 4 + (opaque((int)threadIdx.x) >> 6), nw = gridDim.x * 4;
  for (int tok = gw; tok < NT; tok += nw) {
    const int lane = opaque((int)threadIdx.x) & 63;
    const int b = tok / TPB, pos = tok % TPB;
    const bool isctx = pos < CTX;
    if (isctx && prev == 3) continue;
    const int cj = isctx ? 4 : b;
    const float* hs; float* hd;
    if (isctx) { hd = hctx + (size_t)(b * CTX + pos) * D; hs = (prev <= 0) ? P.ctx + (size_t)(b * CTX + pos) * D : hd; }
    else { hd = P.out + (size_t)(b * SEQ + pos - CTX) * D; hs = (prev <= 0) ? P.x + (size_t)(b * SEQ + pos - CTX) * D : hd; }
    float4 h[4];
#pragma unroll
    for (int j = 0; j < 4; ++j) h[j] = *(const float4*)(hs + j * 256 + lane * 4);
    if (prev >= 0) {
      float4 o[4]; float ss = 0;
#pragma unroll
      for (int j = 0; j < 4; ++j) { o[j] = *(const float4*)(O + (size_t)tok * D + j * 256 + lane * 4); ss += o[j].x * o[j].x + o[j].y * o[j].y + o[j].z * o[j].z + o[j].w * o[j].w; }
      ss = wsum(ss);
      const float rstd = rsqrtf(ss * (1.f / 1024.f) + 1e-6f);
      const float* gt = mod + (prev * 5 + cj) * 3072 + 2048;
      const float* pg = P.post_g + prev * 1024;
#pragma unroll
      for (int j = 0; j < 4; ++j) {
        float4 g4 = *(const float4*)(gt + j * 256 + lane * 4), p4 = *(const float4*)(pg + j * 256 + lane * 4);
        h[j].x += g4.x * o[j].x * rstd * p4.x; h[j].y += g4.y * o[j].y * rstd * p4.y;
        h[j].z += g4.z * o[j].z * rstd * p4.z; h[j].w += g4.w * o[j].w * rstd * p4.w;
        *(float4*)(hd + j * 256 + lane * 4) = h[j];
      }
    }
    if (next >= 0) {
      float ss = 0;
#pragma unroll
      for (int j = 0; j < 4; ++j) ss += h[j].x * h[j].x + h[j].y * h[j].y + h[j].z * h[j].z + h[j].w * h[j].w;
      ss = wsum(ss);
      const float rstd = rsqrtf(ss * (1.f / 1024.f) + 1e-6f);
      const float* sh = mod + (next * 5 + cj) * 3072;
      const float* scl = sh + 1024;
      const float* pg = P.pre_g + next * 1024;
#pragma unroll
      for (int j = 0; j < 4; ++j) {
        float4 s4 = *(const float4*)(sh + j * 256 + lane * 4), c4 = *(const float4*)(scl + j * 256 + lane * 4), p4 = *(const float4*)(pg + j * 256 + lane * 4);
        bf16x4 r;
        r[0] = (short)f2bf(h[j].x * rstd * p4.x * (1.f + c4.x) + s4.x);
        r[1] = (short)f2bf(h[j].y * rstd * p4.y * (1.f + c4.y) + s4.y);
        r[2] = (short)f2bf(h[j].z * rstd * p4.z * (1.f + c4.z) + s4.z);
        r[3] = (short)f2bf(h[j].w * rstd * p4.w * (1.f + c4.w) + s4.w);
        *(bf16x4*)(A + (size_t)tok * D + j * 256 + lane * 4) = r;
      }
    }
  }
}


DI void st_pair(bf16_t* C, size_t ldc, int row_i, int col, float vi, float vi1, int r) {
  const bool odd = (r & 1) != 0;
  const float recv = __shfl_xor(odd ? vi : vi1, 1);
  const float lo = odd ? recv : vi, hi = odd ? vi1 : recv;
  *(unsigned*)(C + (size_t)(row_i + (odd ? 1 : 0)) * ldc + (col & ~1)) = pack2bf(lo, hi);
}

enum { EPI_BF16 = 0, EPI_F32, EPI_S5Y, EPI_GLU, EPI_NAIN, EPI_GDNIN };
struct Gemm {
  const bf16_t* A; long a_rs, a_kbs, a_bs;
  const bf16_t* A2; long a2_rs, a2_kbs, a2_bs; int K1;
  const bf16_t* Bt; long b_bs;
  int M, N, K, batch, epi;
  void* C; long ldc, c_bs;
  const bf16_t* zsrc; const float* bias; void* C2; void* C3;
};
constexpr int LDS_STRIDE = 72;
constexpr int GEMM_LDS_BYTES = 2 * 2 * 128 * LDS_STRIDE * 2;

DI void gemm_epilogue(const Gemm& g, int bt, int row0, int col0, f32x16 (&acc)[2][2]) {
  const int lane = opaque((int)threadIdx.x) & 63, r = lane & 31, h = lane >> 5;
  const bool full = (g.M & 127) == 0;
  if (g.epi == EPI_BF16) {
    bf16_t* C = (bf16_t*)g.C;
#pragma unroll
    for (int mi = 0; mi < 2; ++mi)
#pragma unroll
      for (int ni = 0; ni < 2; ++ni)
#pragma unroll
        for (int i = 0; i < 16; i += 2) {
          int row = row0 + mi * 32 + crow(i, h), col = col0 + ni * 32 + r;
          if (full) st_pair(C, g.ldc, row, col, acc[mi][ni][i], acc[mi][ni][i + 1], r);
          else {
            if (row < g.M) C[(size_t)row * g.ldc + col] = f2bf(acc[mi][ni][i]);
            if (row + 1 < g.M) C[(size_t)(row + 1) * g.ldc + col] = f2bf(acc[mi][ni][i + 1]);
          }
        }
  } else if (g.epi == EPI_F32) {
    float* C = (float*)g.C + (size_t)bt * g.c_bs;
#pragma unroll
    for (int mi = 0; mi < 2; ++mi)
#pragma unroll
      for (int ni = 0; ni < 2; ++ni)
#pragma unroll
        for (int i = 0; i < 16; ++i) {
          int row = row0 + mi * 32 + crow(i, h), col = col0 + ni * 32 + r;
          if (full || row < g.M) C[(size_t)row * g.ldc + col] = acc[mi][ni][i];
        }
  } else if (g.epi == EPI_S5Y) {
    bf16_t* C = (bf16_t*)g.C;
#pragma unroll
    for (int mi = 0; mi < 2; ++mi)
#pragma unroll
      for (int ni = 0; ni < 2; ++ni)
#pragma unroll
        for (int i = 0; i < 16; ++i) {
          int row = row0 + mi * 32 + crow(i, h), col = col0 + ni * 32 + r;
          if (full || row < g.M) {
            int tok = row * 16 + (col >> 4);
            C[(size_t)tok * D + bt * 16 + (col & 15)] = f2bf(geluf_(acc[mi][ni][i]));
          }
        }
  } else if (g.epi == EPI_GLU) {
    bf16_t* C = (bf16_t*)g.C;
    const int oc = (col0 >> 6) * 32 + r;
    const float ba = g.bias[oc], bb = g.bias[1024 + oc];
#pragma unroll
    for (int mi = 0; mi < 2; ++mi)
#pragma unroll
      for (int i = 0; i < 16; i += 2) {
        const int row = row0 + mi * 32 + crow(i, h);
        float y[2];
#pragma unroll
        for (int u = 0; u < 2; ++u) {
          const float ga = acc[mi][0][i + u] + ba, gb = acc[mi][1][i + u] + bb;
          const float z = bf2f(g.zsrc[(size_t)(row + u) * 2048 + 1024 + oc]);
          y[u] = ga * sigmoidf_(gb) * siluf_(z);
        }
        st_pair(C, D, row, oc, y[0], y[1], r);
      }
  } else if (g.epi == EPI_NAIN) {
    bf16_t* C = (bf16_t*)g.C;
    bf16_t* Vt = (bf16_t*)g.C2;
#pragma unroll
    for (int ni = 0; ni < 2; ++ni) {
      const int col = col0 + ni * 32 + r;
      if (col >= 2048 && col < 3072) {
        const int hh = (col - 2048) >> 6, d = (col - 2048) & 63;
#pragma unroll
        for (int mi = 0; mi < 2; ++mi)
#pragma unroll
          for (int q = 0; q < 4; ++q) {
            int row = row0 + mi * 32 + 8 * q + 4 * h;
            int b = row / TPB, pos = row % TPB;
            bf16x4 v;
            v[0] = (short)f2bf(acc[mi][ni][q * 4 + 0]); v[1] = (short)f2bf(acc[mi][ni][q * 4 + 1]);
            v[2] = (short)f2bf(acc[mi][ni][q * 4 + 2]); v[3] = (short)f2bf(acc[mi][ni][q * 4 + 3]);
            *(bf16x4*)(Vt + ((size_t)((b * 16 + hh) * 64 + d)) * TPB + pos) = v;
          }
      } else {
        const float sc = (col < 1024) ? 0.125f : 1.f;
#pragma unroll
        for (int mi = 0; mi < 2; ++mi)
#pragma unroll
          for (int i = 0; i < 16; i += 2) {
            int row = row0 + mi * 32 + crow(i, h);
            st_pair(C, 4096, row, col, acc[mi][ni][i] * sc, acc[mi][ni][i + 1] * sc, r);
          }
      }
    }
  } else if (g.epi == EPI_GDNIN) {
    bf16_t* C = (bf16_t*)g.C;
    float* AB = (float*)g.C2;
    bf16_t* Hb = (bf16_t*)g.C3;
#pragma unroll
    for (int ni = 0; ni < 2; ++ni) {
      const int col = col0 + ni * 32 + r;
      if (col < 4096) {
#pragma unroll
        for (int mi = 0; mi < 2; ++mi)
#pragma unroll
          for (int i = 0; i < 16; i += 2) {
            const int row = row0 + mi * 32 + crow(i, h);
            st_pair(C, 4096, row, col, acc[mi][ni][i], acc[mi][ni][i + 1], r);
            if (mi == 0 && i == 0) { if (h == 0 && col < 3072) { Hb[((size_t)(row >> 6) * 4 + 0) * 3072 + col] = f2bf(acc[mi][ni][0]); Hb[((size_t)(row >> 6) * 4 + 1) * 3072 + col] = f2bf(acc[mi][ni][1]); } }
            if (mi == 1 && i == 14) { if (h == 1 && col < 3072) { Hb[((size_t)(row >> 6) * 4 + 2) * 3072 + col] = f2bf(acc[mi][ni][14]); Hb[((size_t)(row >> 6) * 4 + 3) * 3072 + col] = f2bf(acc[mi][ni][15]); } }
          }
      } else if (col < 4128) {
#pragma unroll
        for (int mi = 0; mi < 2; ++mi)
#pragma unroll
          for (int i = 0; i < 16; ++i) {
            const int row = row0 + mi * 32 + crow(i, h);
            AB[(size_t)row * 32 + col - 4096] = acc[mi][ni][i];
          }
      }
    }
  }
}

DI void gemm_phase(const Gemm& g, unsigned char* smem) {
  bf16_t* sA = (bf16_t*)smem;
  bf16_t* sB = sA + 2 * 128 * 64;
  const int ntm = (g.M + 127) / 128, ntn = g.N / 128, nk = g.K / 64;
  const int tiles = g.batch * ntm * ntn;
  const int xcd = blockIdx.x & 7, loc = blockIdx.x >> 3, nloc = gridDim.x >> 3;
  const int t_lo = (int)((long)tiles * xcd / 8), t_hi = (int)((long)tiles * (xcd + 1) / 8);
  for (int tile = t_lo + loc; tile < t_hi; tile += nloc) {
    const int tid = opaque((int)threadIdx.x), lane = tid & 63, w = tid >> 6, wm = w >> 1, wn = w & 1;
    int bt = tile / (ntm * ntn); const int rem = tile % (ntm * ntn);
    int tm = rem / ntn, tn = rem % ntn;
    if (g.batch == 1 && ntm == 136) {
      const int li = tile - t_lo;
      const int band = li / (8 * ntn), idx = li - band * 8 * ntn;
      int row, col;
      if (band < 2) {
        const int nb = ntn >> 3, fullt = nb << 6;
        if (idx < fullt) { row = (idx & 63) >> 3; col = (idx >> 6) * 8 + (idx & 7); }
        else { const int wr = ntn - 8 * nb, i2 = idx - fullt; row = i2 / wr; col = 8 * nb + i2 % wr; }
      } else { row = 0; col = idx; }
      if (band == 1) col = ntn - 1 - col;
      bt = 0; tm = xcd * 17 + band * 8 + row; tn = col;
    }
    f32x16 acc[2][2];
#pragma unroll
    for (int mi = 0; mi < 2; ++mi)
#pragma unroll
      for (int ni = 0; ni < 2; ++ni)
#pragma unroll
        for (int i = 0; i < 16; ++i) acc[mi][ni][i] = 0.f;
#define STAGE1(KT, BUF, p) { \
        const int q = p * 256 + tid; \
        const int row = q >> 3, pc = q & 7; \
        const int c = pc ^ ((row >> 1) & 7); \
        const int grow = imin(tm * 128 + row, g.M - 1); \
        const int k = (KT) * 64 + c * 8; \
        const bf16_t* pa; \
        if (k < g.K1) pa = g.A + (long)bt * g.a_bs + (long)grow * g.a_rs + (long)(k >> 4) * g.a_kbs + (k & 15); \
        else { const int k2 = k - g.K1; pa = g.A2 + (long)bt * g.a2_bs + (long)grow * g.a2_rs + (long)(k2 >> 4) * g.a2_kbs + (k2 & 15); } \
        const bf16_t* pb = g.Bt + (long)bt * g.b_bs + (long)(tn * 128 + row) * g.K + k; \
        __builtin_amdgcn_global_load_lds((const unsigned*)pa, (lds_u32*)(sA + (BUF) * 8192 + q * 8), 16, 0, 0); \
        __builtin_amdgcn_global_load_lds((const unsigned*)pb, (lds_u32*)(sB + (BUF) * 8192 + q * 8), 16, 0, 0); }
#define STAGE(KT, BUF) { STAGE1(KT, BUF, 0) STAGE1(KT, BUF, 1) STAGE1(KT, BUF, 2) STAGE1(KT, BUF, 3) }
#define COMPUTE(BUF) { \
      const int ra0_ = wm * 64 + (lane & 31), ra1_ = ra0_ + 32, rb0_ = wn * 64 + (lane & 31), rb1_ = rb0_ + 32; \
      _Pragma("unroll") for (int ks = 0; ks < 4; ++ks) { \
        const int c = ks * 2 + (lane >> 5); \
        bf16x8 af0 = *(const bf16x8*)(sA + (BUF) * 8192 + ra0_ * 64 + ((c ^ ((ra0_ >> 1) & 7)) << 3)); \
        bf16x8 af1 = *(const bf16x8*)(sA + (BUF) * 8192 + ra1_ * 64 + ((c ^ ((ra1_ >> 1) & 7)) << 3)); \
        bf16x8 bf0 = *(const bf16x8*)(sB + (BUF) * 8192 + rb0_ * 64 + ((c ^ ((rb0_ >> 1) & 7)) << 3)); \
        bf16x8 bf1 = *(const bf16x8*)(sB + (BUF) * 8192 + rb1_ * 64 + ((c ^ ((rb1_ >> 1) & 7)) << 3)); \
        acc[0][0] = __builtin_amdgcn_mfma_f32_32x32x16_bf16(af0, bf0, acc[0][0], 0, 0, 0); \
        acc[0][1] = __builtin_amdgcn_mfma_f32_32x32x16_bf16(af0, bf1, acc[0][1], 0, 0, 0); \
        acc[1][0] = __builtin_amdgcn_mfma_f32_32x32x16_bf16(af1, bf0, acc[1][0], 0, 0, 0); \
        acc[1][1] = __builtin_amdgcn_mfma_f32_32x32x16_bf16(af1, bf1, acc[1][1], 0, 0, 0); \
      } }
    lds_barrier();
    STAGE(0, 0);
    asm volatile("s_waitcnt vmcnt(0)" ::: "memory");
    lds_barrier();
    for (int kt = 0; kt < nk; kt += 2) {
      STAGE(kt + 1, 1);
      COMPUTE(0);
      asm volatile("s_waitcnt vmcnt(0)" ::: "memory");
      lds_barrier();
      if (kt + 2 < nk) STAGE(kt + 2, 0);
      COMPUTE(1);
      asm volatile("s_waitcnt vmcnt(0)" ::: "memory");
      lds_barrier();
    }
#undef STAGE
#undef STAGE1
#undef COMPUTE
    gemm_epilogue(g, bt, tm * 128 + wm * 64, tn * 128 + wn * 64, acc);
  }
}

DI Gemm gemm_plain(const bf16_t* A, const bf16_t* Bt, int M, int N, int K, int epi, void* C, long ldc) {
  Gemm g{};
  g.A = A; g.a_rs = K; g.a_kbs = 16; g.a_bs = 0; g.A2 = A; g.K1 = K; g.a2_rs = K; g.a2_kbs = 16; g.a2_bs = 0;
  g.Bt = Bt; g.b_bs = 0; g.M = M; g.N = N; g.K = K; g.batch = 1; g.epi = epi; g.C = C; g.ldc = ldc; g.c_bs = 0;
  return g;
}

DI void sincos_red(double ang, float& s, float& c) {
  const double twopi = 6.283185307179586476925286766559;
  double t = ang / twopi; t = t - rint(t);
  float x = (float)(t * twopi);
  s = sinf(x); c = cosf(x);
}
DI void s5_pre_a(const Params& P, int j) {
  float2* apow = (float2*)(P.ws + WS_WT + WT_S5_APOW);
  float2* bbar = (float2*)(P.ws + WS_WT + WT_S5_BBAR);
  const int gt = blockIdx.x * 256 + opaque((int)threadIdx.x), gn = gridDim.x * 256;
  for (int id = gt; id < 8192 * 17; id += gn) {
    const int k = id >> 13, rest = id & 8191;
    const int d = rest >> 12, g = (rest >> 6) & 63, p = rest & 63;
    const int base = ((j * 2 + d) * 64 + g);
    const double lr = P.s5_lam_re[base * 64 + p], li = P.s5_lam_im[base * 64 + p];
    const double dt = (double)expf(P.s5_log_dt[base]);
    const float mag = expf((float)(k * lr * dt)); float s, c; sincos_red(k * li * dt, s, c);
    apow[((d * 64 + g) * 17 + k) * 64 + p] = make_float2(mag * c, mag * s);
  }
  for (int id = gt; id < 8192 * 16; id += gn) {
    const int c = id & 15, rest = id >> 4;
    const int d = rest >> 12, g = (rest >> 6) & 63, p = rest & 63;
    const int base = ((j * 2 + d) * 64 + g);
    const double lr = P.s5_lam_re[base * 64 + p], li = P.s5_lam_im[base * 64 + p];
    const double dt = (double)expf(P.s5_log_dt[base]);
    const float mag = expf((float)(lr * dt)); float s, co; sincos_red(li * dt, s, co);
    const float are = mag * co, aim = mag * s;
    const float lrf = (float)lr, lif = (float)li;
    const float den = lrf * lrf + lif * lif;
    const float fre = ((are - 1.f) * lrf + aim * lif) / den, fim = (aim * lrf - (are - 1.f) * lif) / den;
    const float br = P.s5_b_re[(size_t)(base * 64 + p) * 16 + c], bi = P.s5_b_im[(size_t)(base * 64 + p) * 16 + c];
    bbar[((d * 64 + g) * 64 + p) * 16 + c] = make_float2(fre * br - fim * bi, fre * bi + fim * br);
  }
}
DI void s5_pre_b(const Params& P, int j) {
  const float2* apow = (const float2*)(P.ws + WS_WT + WT_S5_APOW);
  const float2* bbar = (const float2*)(P.ws + WS_WT + WT_S5_BBAR);
  float* ktab = (float*)(P.ws + WS_WT + WT_S5_KTAB);
  bf16_t* opt = (bf16_t*)(P.ws + WS_WT + WT_S5_OPT);
  bf16_t* bpt = (bf16_t*)(P.ws + WS_WT + WT_S5_BPT);
  const int gt = blockIdx.x * 256 + opaque((int)threadIdx.x), gn = gridDim.x * 256;
  for (int id = gt; id < 2 * 64 * 16 * 16 * 2; id += gn) {
    const int c2b = (id & 1) * 8, c = (id >> 1) & 15, k = (id >> 5) & 15, g = (id >> 9) & 63, d = id >> 15;
    const int base = ((j * 2 + d) * 64 + g);
    const float* cr = P.s5_c_re + (size_t)(base * 16 + c) * 64;
    const float* ci = P.s5_c_im + (size_t)(base * 16 + c) * 64;
    const float2* ap = apow + ((d * 64 + g) * 17 + k) * 64;
    const float2* bp = bbar + ((d * 64 + g) * 64) * 16 + c2b;
    float s[8];
#pragma unroll
    for (int u = 0; u < 8; ++u) s[u] = 0.f;
#pragma unroll 4
    for (int p = 0; p < 64; ++p) {
      const float2 a = ap[p];
      const float xr = cr[p] * a.x - ci[p] * a.y, xi = cr[p] * a.y + ci[p] * a.x;
#pragma unroll
      for (int u = 0; u < 8; ++u) { const float2 b = bp[p * 16 + u]; s[u] += xr * b.x - xi * b.y; }
    }
    float* kd = ktab + ((((d * 64 + g) * 16 + k) * 16 + c) * 16) + c2b;
    *(float4*)kd = make_float4(s[0], s[1], s[2], s[3]);
    *(float4*)(kd + 4) = make_float4(s[4], s[5], s[6], s[7]);
  }
  for (int id = gt; id < 64 * 256 * 32; id += gn) {
    const int kk = (id & 31) * 8, n = (id >> 5) & 255, g = id >> 13;
    const int i = kk >> 4, c2b = kk & 15, d = n >> 7, ri = (n >> 6) & 1, p = n & 63;
    const int e = d == 0 ? 15 - i : i;
    const float2 a = apow[((d * 64 + g) * 17 + e) * 64 + p];
    const float2* bp = bbar + ((d * 64 + g) * 64 + p) * 16 + c2b;
    float v[8];
#pragma unroll
    for (int u = 0; u < 8; ++u) { const float2 b = bp[u]; v[u] = ri ? (a.x * b.y + a.y * b.x) : (a.x * b.x - a.y * b.y); }
    uint4 o; o.x = pack2bf(v[0], v[1]); o.y = pack2bf(v[2], v[3]); o.z = pack2bf(v[4], v[5]); o.w = pack2bf(v[6], v[7]);
    *(uint4*)(bpt + ((size_t)(g * 256 + n)) * 256 + kk) = o;
  }
  for (int id = gt; id < 64 * 256 * 32; id += gn) {
    const int kk = (id & 31) * 8, n = (id >> 5) & 255, g = id >> 13;
    const int jj = n >> 4, c = n & 15, d = kk >> 7, ri = (kk >> 6) & 1, p0 = kk & 63;
    const int e = d == 0 ? jj + 1 : 16 - jj;
    const int base = ((j * 2 + d) * 64 + g);
    const float2* ap = apow + ((d * 64 + g) * 17 + e) * 64 + p0;
    const float* crp = P.s5_c_re + (size_t)(base * 16 + c) * 64 + p0;
    const float* cip = P.s5_c_im + (size_t)(base * 16 + c) * 64 + p0;
    float v[8];
#pragma unroll
    for (int u = 0; u < 8; ++u) { const float2 a = ap[u]; const float cr = crp[u], ci = cip[u]; v[u] = ri ? -(cr * a.y + ci * a.x) : (cr * a.x - ci * a.y); }
    uint4 o; o.x = pack2bf(v[0], v[1]); o.y = pack2bf(v[2], v[3]); o.z = pack2bf(v[4], v[5]); o.w = pack2bf(v[6], v[7]);
    *(uint4*)(opt + ((size_t)g * 256 + n) * 512 + 256 + kk) = o;
  }
}
DI void s5_pre_c(const Params& P, int j) {
  const float* ktab = (const float*)(P.ws + WS_WT + WT_S5_KTAB);
  bf16_t* opt = (bf16_t*)(P.ws + WS_WT + WT_S5_OPT);
  for (int id = blockIdx.x * 256 + opaque((int)threadIdx.x); id < 64 * 256 * 32; id += gridDim.x * 256) {
    const int kk = (id & 31) * 8, n = (id >> 5) & 255, g = id >> 13;
    const int jj = n >> 4, c = n & 15, i = kk >> 4, c2b = kk & 15;
    float v[8];
#pragma unroll
    for (int u = 0; u < 8; ++u) v[u] = 0.f;
    if (i <= jj) {
      const float* kp = ktab + (((0 * 64 + g) * 16 + (jj - i)) * 16 + c) * 16 + c2b;
#pragma unroll
      for (int u = 0; u < 8; ++u) v[u] += kp[u];
    }
    if (i >= jj) {
      const float* kp = ktab + (((1 * 64 + g) * 16 + (i - jj)) * 16 + c) * 16 + c2b;
#pragma unroll
      for (int u = 0; u < 8; ++u) v[u] += kp[u];
    }
    if (i == jj) {
      const float dv = P.s5_d[j * 1024 + g * 16 + c];
#pragma unroll
      for (int u = 0; u < 8; ++u) if (c2b + u == c) v[u] += dv;
    }
    uint4 o; o.x = pack2bf(v[0], v[1]); o.y = pack2bf(v[2], v[3]); o.z = pack2bf(v[4], v[5]); o.w = pack2bf(v[6], v[7]);
    *(uint4*)(opt + ((size_t)g * 256 + n) * 512 + kk) = o;
  }
}
DI void s5_carry(const Params& P, const float* __restrict__ Sloc, bf16_t* __restrict__ Sin) {
  const float2* apow = (const float2*)(P.ws + WS_WT + WT_S5_APOW);
  const int wv = opaque((int)threadIdx.x) >> 6;
  for (int task = blockIdx.x + gridDim.x * wv; task < 512; task += gridDim.x * 4) {
    const int p = opaque((int)threadIdx.x) & 63;
    const int d = task & 1, b = (task >> 1) & 3, g = task >> 3;
    const float2 a = apow[((d * 64 + g) * 17 + 16) * 64 + p];
    const size_t base = ((size_t)g * 1088 + b * 272) * 256 + d * 128 + p;
    float sr = 0.f, si = 0.f;
    for (int s0 = 0; s0 < 272; s0 += 16) {
      float lr[16], li[16];
#pragma unroll
      for (int u = 0; u < 16; ++u) {
        const int step = s0 + u;
        const int q = d == 0 ? step : (step < 16 ? 15 - step : 287 - step);
        const size_t o = base + (size_t)q * 256;
        lr[u] = Sloc[o]; li[u] = Sloc[o + 64];
      }
#pragma unroll
      for (int u = 0; u < 16; ++u) {
        const int step = s0 + u;
        const int q = d == 0 ? step : (step < 16 ? 15 - step : 287 - step);
        const size_t o = base + (size_t)q * 256;
        Sin[o] = f2bf(sr); Sin[o + 64] = f2bf(si);
        const float nr = a.x * sr - a.y * si + lr[u], ni = a.x * si + a.y * sr + li[u];
        sr = nr; si = ni;
      }
    }
  }
}

template <bool WIN>
DI void na_step(const bf16_t* sK, const bf16_t* sV, const bf16x8 (&qf)[2], float& m, float& lsum, f32x4 (&O)[4],
                const float* __restrict__ rpb, int hd, int r, int r0, int step, int cs, int wq, int start, int lq, int lg) {
  constexpr int NTILE = WIN ? 4 : 8;
  f32x4 S[NTILE];
#pragma unroll
  for (int t = 0; t < NTILE; ++t) {
    const int kidx = WIN ? ((t >> 1) * 64 + cs + (t & 1) * 16 + lq) : (t * 16 + lq);
    f32x4 s = f32x4{0.f, 0.f, 0.f, 0.f};
#pragma unroll
    for (int kk = 0; kk < 2; ++kk) {
      bf16x8 kf = *(const bf16x8*)(sK + kidx * 72 + kk * 32 + lg * 8);
      s = __builtin_amdgcn_mfma_f32_16x16x32_bf16(kf, qf[kk], s, 0, 0, 0);
    }
    S[t] = s;
  }
  if (WIN) {
#pragma unroll
    for (int t = 0; t < NTILE; ++t) {
      const int ro = r0 + step * 2 + (t >> 1) - r + 7;
#pragma unroll
      for (int e = 0; e < 4; ++e) {
        const int col = cs + (t & 1) * 16 + lg * 4 + e;
        const bool valid = (col >= start) && (col < start + 16);
        const int co = imin(imax(col - wq + 15, 0), 30);
        const float bias = rpb[(hd * 15 + ro) * 31 + co];
        S[t][e] = valid ? S[t][e] + bias : -1e30f;
      }
    }
  }
  float mx = -1e30f;
#pragma unroll
  for (int t = 0; t < NTILE; ++t)
#pragma unroll
    for (int e = 0; e < 4; ++e) mx = fmaxf(mx, S[t][e]);
  mx = fmaxf(mx, __shfl_xor(mx, 16)); mx = fmaxf(mx, __shfl_xor(mx, 32));
  const float mnew = fmaxf(m, mx);
  const float alpha = __expf(m - mnew);
  float ps = 0.f;
#pragma unroll
  for (int t = 0; t < NTILE; ++t)
#pragma unroll
    for (int e = 0; e < 4; ++e) { float pv = __expf(S[t][e] - mnew); S[t][e] = pv; ps += pv; }
  lsum = lsum * alpha + ps; m = mnew;
#pragma unroll
  for (int dt = 0; dt < 4; ++dt) O[dt] *= alpha;
#pragma unroll
  for (int pr = 0; pr < NTILE / 2; ++pr) {
    bf16x8 pf;
#pragma unroll
    for (int e = 0; e < 4; ++e) { pf[e] = (short)f2bf(S[2 * pr][e]); pf[4 + e] = (short)f2bf(S[2 * pr + 1][e]); }
    const int pos0 = WIN ? (pr * 64 + cs + lg * 4) : (pr * 32 + lg * 4);
#pragma unroll
    for (int dt = 0; dt < 4; ++dt) {
      const bf16_t* vb = sV + (dt * 16 + lq) * 136;
      bf16x4 lo = *(const bf16x4*)(vb + pos0), hi = *(const bf16x4*)(vb + pos0 + 16);
      bf16x8 vf = __builtin_shufflevector(lo, hi, 0, 1, 2, 3, 4, 5, 6, 7);
      O[dt] = __builtin_amdgcn_mfma_f32_16x16x32_bf16(vf, pf, O[dt], 0, 0, 0);
    }
  }
}

DI void na_attn(const Params& P, const bf16_t* __restrict__ Pb, const bf16_t* __restrict__ Vt, bf16_t* __restrict__ Y, unsigned char* smem) {
  bf16_t* sK = (bf16_t*)smem;
  bf16_t* sV = sK + 128 * 72;
  const float* rpb = P.na_rpb;
  const int xcd_ = blockIdx.x & 7, nloc_ = gridDim.x >> 3;
  for (int job = xcd_ * 544 + (blockIdx.x >> 3); job < (xcd_ + 1) * 544; job += nloc_) {
    const int tid = opaque((int)threadIdx.x);
    const int lane = tid & 63, wv = tid >> 6;
    const int lq = lane & 15, lg = lane >> 4;
    int b, hd, r = 0, r0 = 0, cs = 0, w0 = 0, qtok, s_lo;
    if (job < 4096) { b = job >> 10; hd = (job >> 6) & 15; r = job & 63; w0 = wv * 16; r0 = imin(imax(r - 4, 0), 56); cs = imin(imax(w0 - 8, 0), 32); qtok = b * TPB + CTX + r * 64 + w0 + lq; s_lo = 0; }
    else { int jj = job - 4096; b = jj >> 6; hd = (jj >> 2) & 15; qtok = b * TPB + (jj & 3) * 64 + wv * 16 + lq; s_lo = 4; }
    bf16x8 qf[2];
#pragma unroll
    for (int kk = 0; kk < 2; ++kk) qf[kk] = *(const bf16x8*)(Pb + (size_t)qtok * 4096 + hd * 64 + kk * 32 + lg * 8);
    float m = -1e30f, lsum = 0.f;
    f32x4 O[4];
#pragma unroll
    for (int dt = 0; dt < 4; ++dt) O[dt] = f32x4{0.f, 0.f, 0.f, 0.f};
    const int wq = w0 + lq;
    const int start = imin(imax(wq - 8, 0), 48);
    uint4 rk0, rk1, rk2, rk3, rv0, rv1, rv2, rv3;
    const bf16_t* vrow = Vt + (size_t)((b * 16 + hd) * 64) * TPB;
#define NA_LOAD1(p, RK, RV, STEP) { \
      const int e = tid + p * 256; \
      const int key = e >> 3, part = e & 7; \
      const int ktok = (STEP) < 4 ? (b * TPB + CTX + (r0 + (STEP) * 2 + (key >> 6)) * 64 + (key & 63)) : (b * TPB + ((STEP) - 4) * 128 + key); \
      RK = *(const uint4*)(Pb + (size_t)ktok * 4096 + 1024 + hd * 64 + part * 8); \
      const int d = e >> 4, seg = e & 15; \
      const int vpos = (STEP) < 4 ? (CTX + (r0 + (STEP) * 2 + (seg >> 3)) * 64 + (seg & 7) * 8) : (((STEP) - 4) * 128 + seg * 8); \
      RV = *(const uint4*)(vrow + (size_t)d * TPB + vpos); }
#define NA_LOAD(STEP) { NA_LOAD1(0, rk0, rv0, STEP) NA_LOAD1(1, rk1, rv1, STEP) NA_LOAD1(2, rk2, rv2, STEP) NA_LOAD1(3, rk3, rv3, STEP) }
#define NA_STORE1(p, RK, RV) { \
      const int e = tid + p * 256; \
      *(uint4*)(sK + (e >> 3) * 72 + (e & 7) * 8) = RK; \
      *(uint4*)(sV + (e >> 4) * 136 + (e & 15) * 8) = RV; }
#define NA_STORE() { NA_STORE1(0, rk0, rv0) NA_STORE1(1, rk1, rv1) NA_STORE1(2, rk2, rv2) NA_STORE1(3, rk3, rv3) }
    NA_LOAD(s_lo);
    for (int step = s_lo; step < 6; ++step) {
      __syncthreads();
      NA_STORE();
      __syncthreads();
      if (step + 1 < 6) NA_LOAD(step + 1);
      if (step < 4) na_step<true>(sK, sV, qf, m, lsum, O, rpb, hd, r, r0, step, cs, wq, start, lq, lg);
      else na_step<false>(sK, sV, qf, m, lsum, O, rpb, hd, r, r0, step, cs, wq, start, lq, lg);
    }
#undef NA_LOAD
#undef NA_LOAD1
#undef NA_STORE
#undef NA_STORE1
    lsum += __shfl_xor(lsum, 16); lsum += __shfl_xor(lsum, 32);
    const float inv = 1.f / lsum;
#pragma unroll
    for (int dt = 0; dt < 4; ++dt) {
      const int dcol = hd * 64 + dt * 16 + lg * 4;
      bf16x4 z4 = *(const bf16x4*)(Pb + (size_t)qtok * 4096 + 3072 + dcol);
      bf16x4 o4;
#pragma unroll
      for (int e = 0; e < 4; ++e) o4[e] = (short)f2bf(O[dt][e] * inv * siluf_(bf2f((bf16_t)z4[e])));
      *(bf16x4*)(Y + (size_t)qtok * D + dcol) = o4;
    }
  }
}

DI int gdn_pos(int s, int dir) { return dir == 0 ? s : (s < CTX ? CTX - 1 - s : (TPB + CTX - 1) - s); }

DI unsigned u4c(const uint4& u, int k) { return k == 0 ? u.x : (k == 1 ? u.y : (k == 2 ? u.z : u.w)); }
DI void gdn_conv(const Params& P, bf16_t* __restrict__ Pb, const bf16_t* __restrict__ Hb) {
  for (int item = blockIdx.x; item < 272 * 6; item += gridDim.x) {
    const int tid = opaque((int)threadIdx.x), c8 = tid & 63, tq = tid >> 6;
    const int tile = item / 6, slab = item % 6;
    const int ch = slab * 512 + c8 * 8;
    const int tok0 = tile * 64;
    const int seg_first = ((tok0 % TPB) == 0) || ((tok0 % TPB) == CTX);
    const int seg_last = (((tok0 + 64) % TPB) == 0) || (((tok0 + 64) % TPB) == CTX);
    uint4 raw[20];
#pragma unroll
    for (int i = 0; i < 20; ++i) {
      const int lr = tq * 16 + i - 2;
      uint4 u = make_uint4(0u, 0u, 0u, 0u);
      if (lr >= 0 && lr < 64) u = *(const uint4*)(Pb + (size_t)(tok0 + lr) * 4096 + ch);
      else if (lr < 0) { if (!seg_first) u = *(const uint4*)(Hb + ((size_t)(tile - 1) * 4 + 2 + (lr + 2)) * 3072 + ch); }
      else { if (!seg_last) u = *(const uint4*)(Hb + ((size_t)(tile + 1) * 4 + (lr - 64)) * 3072 + ch); }
      raw[i] = u;
    }
    float w[5][8];
#pragma unroll
    for (int j = 0; j < 5; ++j) {
      const float4 a = *(const float4*)(P.gdn_conv_w + j * 3072 + ch), b = *(const float4*)(P.gdn_conv_w + j * 3072 + ch + 4);
      w[j][0] = a.x; w[j][1] = a.y; w[j][2] = a.z; w[j][3] = a.w; w[j][4] = b.x; w[j][5] = b.y; w[j][6] = b.z; w[j][7] = b.w;
    }
    __syncthreads();
#pragma unroll
    for (int i = 0; i < 16; ++i) {
      float y[8];
#pragma unroll
      for (int e = 0; e < 8; ++e) {
        float acc = 0.f;
#pragma unroll
        for (int j = 0; j < 5; ++j) {
          const unsigned d = u4c(raw[i + j], e >> 1);
          const float v = (e & 1) ? __uint_as_float(d & 0xffff0000u) : __uint_as_float(d << 16);
          acc += w[j][e] * v;
        }
        y[e] = siluf_(acc);
      }
      if (slab < 4) {
        float ss = 0.f;
#pragma unroll
        for (int e = 0; e < 8; ++e) ss += y[e] * y[e];
        ss += __shfl_xor(ss, 1); ss += __shfl_xor(ss, 2); ss += __shfl_xor(ss, 4); ss += __shfl_xor(ss, 8);
        const float rn = rsqrtf(ss + 1e-6f);
#pragma unroll
        for (int e = 0; e < 8; ++e) y[e] *= rn;
      }
      uint4 o;
      o.x = pack2bf(y[0], y[1]); o.y = pack2bf(y[2], y[3]); o.z = pack2bf(y[4], y[5]); o.w = pack2bf(y[6], y[7]);
      *(uint4*)(Pb + (size_t)(tok0 + tq * 16 + i) * 4096 + ch) = o;
    }
    __syncthreads();
  }
}

DI void gdn_prep(const Params& P, const bf16_t* __restrict__ Pb, const float* __restrict__ AB, bf16_t* __restrict__ Ob, int c_lo, int c_hi, int set, unsigned* ctr, unsigned char* smem) {
  bf16_t* sK = (bf16_t*)smem;
  bf16_t* sQ = sK + 64 * 136;
  bf16_t* sV = sQ + 64 * 136;
  float* sL = (float*)(sV + 64 * 136);
  float* sG = sL + 64 * 68;
  float* sBt = sG + 64;
  bf16_t* Wb = (bf16_t*)(P.ws + WS_WT + WT_G_W) + (size_t)set * 512 * 8192;
  bf16_t* Aq = (bf16_t*)(P.ws + WS_WT + (set ? WT_G_HALO : WT_G_AQK));
  float* Gc = (float*)(P.ws + WS_WT + WT_G_GC) + set * 512 * 64;
  int* s_item = (int*)(sBt + 64);
  const int nc = c_hi - c_lo;
  for (;;) {
    __syncthreads();
    if (threadIdx.x == 0) *s_item = (int)atomicAdd(ctr, 1u);
    __syncthreads();
    const int item = *s_item;
    if (item >= 64 * nc) break;
    const int tid = opaque((int)threadIdx.x), lane = tid & 63, w = tid >> 6;
    const int chain = item % 64, lc = item / 64;
    const int cidx = c_lo + lc;
    const int b = chain >> 4, hd = (chain >> 1) & 7, dir = chain & 1;
    const int slot = chain * GDN_R + lc;
    bf16_t* Ub = Ob + (((size_t)(dir * 32 + b * 8 + hd)) * TPB + cidx * 64) * 128;
    __syncthreads();
#pragma unroll
    for (int p = 0; p < 4; ++p) {
      const int e = tid + p * 256; const int row = e >> 4, kc = (e & 15) * 8;
      const int tok = b * TPB + gdn_pos(cidx * 64 + row, dir);
      const bf16_t* src = Pb + (size_t)tok * 4096 + hd * 128 + kc;
      *(uint4*)(sQ + row * 136 + kc) = *(const uint4*)(src);
      *(uint4*)(sK + row * 136 + kc) = *(const uint4*)(src + 1024);
      *(uint4*)(sV + row * 136 + kc) = *(const uint4*)(src + 2048);
    }
    if (tid < 64) {
      const int tok = b * TPB + gdn_pos(cidx * 64 + tid, dir);
      const float araw = AB[(size_t)tok * 32 + dir * 8 + hd] + P.gdn_dt_bias[dir * 8 + hd];
      const float sp = araw > 20.f ? araw : log1pf(__expf(araw));
      float gl = -__expf(P.gdn_a_log[dir * 8 + hd]) * sp;
      const float beta = sigmoidf_(AB[(size_t)tok * 32 + 16 + dir * 8 + hd]);
#pragma unroll
      for (int o = 1; o < 64; o <<= 1) { float t = __shfl_up(gl, o); if (lane >= o) gl += t; }
      sG[tid] = gl; sBt[tid] = beta; sBt[68 + tid] = beta * __expf(gl);
      Gc[slot * 64 + tid] = gl;
    }
    __syncthreads();
    {
      const int mi = w >> 1, ni = w & 1, r = lane & 31, h = lane >> 5;
      f32x16 kk, qk;
#pragma unroll
      for (int i = 0; i < 16; ++i) { kk[i] = 0.f; qk[i] = 0.f; }
#pragma unroll
      for (int ks = 0; ks < 8; ++ks) {
        bf16x8 ak = *(const bf16x8*)(sK + (mi * 32 + r) * 136 + ks * 16 + h * 8);
        bf16x8 aq = *(const bf16x8*)(sQ + (mi * 32 + r) * 136 + ks * 16 + h * 8);
        bf16x8 bk = *(const bf16x8*)(sK + (ni * 32 + r) * 136 + ks * 16 + h * 8);
        kk = __builtin_amdgcn_mfma_f32_32x32x16_bf16(ak, bk, kk, 0, 0, 0);
        qk = __builtin_amdgcn_mfma_f32_32x32x16_bf16(aq, bk, qk, 0, 0, 0);
      }
      const int col = ni * 32 + r;
      const float gcol = sG[col];
#pragma unroll
      for (int i = 0; i < 16; ++i) {
        const int row = mi * 32 + crow(i, h);
        const float grow = sG[row];
        const float dec = (col <= row) ? __expf(grow - gcol) : 0.f;
        sL[row * 68 + col] = (col < row) ? sBt[row] * kk[i] * dec : 0.f;
        Aq[((size_t)slot * 64 + row) * 64 + col] = f2bf(0.08838834764831845f * qk[i] * dec);
      }
    }
    __syncthreads();
    {
      float x[64];
#pragma unroll
      for (int i = 0; i < 64; ++i) x[i] = 0.f;
      const bool isv = tid < 128;
      const bf16_t* srcm = isv ? (sV + tid) : (sK + (tid - 128));
      const float* scl = isv ? sBt : (sBt + 68);
#pragma unroll
      for (int rr = 0; rr < 64; rr += 2) {
        const int ro0 = opaque(rr * 68);
        float a0 = bf2f(srcm[rr * 136]) * scl[rr];
        float a1 = bf2f(srcm[(rr + 1) * 136]) * scl[rr + 1];
        float l10 = 0.f;
#pragma unroll
        for (int c4 = 0; c4 < (rr + 4) / 4; ++c4) {
          const float4 p4 = *(const float4*)(sL + ro0 + c4 * 4);
          const float4 q4 = *(const float4*)(sL + ro0 + 68 + c4 * 4);
          a0 -= p4.x * x[c4 * 4 + 0]; a0 -= p4.y * x[c4 * 4 + 1]; a0 -= p4.z * x[c4 * 4 + 2]; a0 -= p4.w * x[c4 * 4 + 3];
          a1 -= q4.x * x[c4 * 4 + 0]; a1 -= q4.y * x[c4 * 4 + 1]; a1 -= q4.z * x[c4 * 4 + 2]; a1 -= q4.w * x[c4 * 4 + 3];
          if (c4 == rr / 4) l10 = ((rr & 3) == 0) ? q4.x : (((rr & 3) == 2) ? q4.z : 0.f);
        }
        a1 -= l10 * a0;
        asm volatile("" : "+v"(a0), "+v"(a1) :: "memory");
        x[rr] = a0; x[rr + 1] = a1;
      }
      bf16_t* dst = isv ? (Ub + tid) : (Wb + (size_t)slot * 64 * 128 + (tid - 128));
#pragma unroll
      for (int rr = 0; rr < 64; ++rr) dst[rr * 128] = f2bf(x[rr]);
    }
  }
}

struct ChainRegs { bf16x8 a1[8]; bf16x8 aq[4]; uint4 kt[4]; float g; };
DI void chain_load(ChainRegs& R, const bf16_t* __restrict__ Pb, const bf16_t* __restrict__ Wb, const bf16_t* __restrict__ Ub,
                   const bf16_t* __restrict__ Aq, const float* __restrict__ Gc, int slot, int cidx, int b, int hd, int dir, int dvb,
                   int tid, int w, int r, int h) {
  const int strip = w & 1;
  const bf16_t* arow;
  if (w < 2) arow = Wb + ((size_t)slot * 64 + strip * 32 + r) * 128;
  else { const int tok = b * TPB + gdn_pos(cidx * 64 + strip * 32 + r, dir); arow = Pb + (size_t)tok * 4096 + hd * 128; }
#pragma unroll
  for (int ks = 0; ks < 8; ++ks) R.a1[ks] = *(const bf16x8*)(arow + ks * 16 + h * 8);
  if (w < 2) {
    const bf16_t* ub = Ub + (((size_t)(dir * 32 + b * 8 + hd)) * TPB + cidx * 64) * 128 + dvb * 32 + r;
#pragma unroll
    for (int i = 0; i < 16; ++i) R.aq[i >> 3][i & 7] = (short)ub[(strip * 32 + crow(i, h)) * 128];
  } else {
    const bf16_t* aqrow = Aq + ((size_t)slot * 64 + strip * 32 + r) * 64;
#pragma unroll
    for (int ks = 0; ks < 4; ++ks) R.aq[ks] = *(const bf16x8*)(aqrow + ks * 16 + h * 8);
  }
  R.g = (tid < 64) ? Gc[slot * 64 + tid] : 0.f;
}
DI void chain_load_k(ChainRegs& R, const bf16_t* __restrict__ Pb, int cidx, int b, int hd, int dir, int tid) {
#pragma unroll
  for (int p = 0; p < 4; ++p) {
    const int e = tid + p * 256; const int row = e >> 4, kc = (e & 15) * 8;
    const int tok = b * TPB + gdn_pos(cidx * 64 + row, dir);
    R.kt[p] = *(const uint4*)(Pb + (size_t)tok * 4096 + 1024 + hd * 128 + kc);
  }
}
DI void gdn_chain(const Params& P, const bf16_t* __restrict__ Pb, bf16_t* Ob, int c_lo, int c_hi, int set, unsigned char* smem, bool save = true) {
  if (blockIdx.x >= 256) return;
  bf16_t* sSt = (bf16_t*)smem;
  bf16_t* sVn = sSt + 32 * 136;
  bf16_t* sVd = sVn + 32 * 72;
  bf16_t* sKt = sVd + 32 * 72;
  float* sG = (float*)(sKt + 64 * 136);
  const bf16_t* Wb = (const bf16_t*)(P.ws + WS_WT + WT_G_W) + (size_t)set * 512 * 8192;
  const bf16_t* Ub = Ob;
  const bf16_t* Aq = (const bf16_t*)(P.ws + WS_WT + (set ? WT_G_HALO : WT_G_AQK));
  const float* Gc = (const float*)(P.ws + WS_WT + WT_G_GC) + set * 512 * 64;
  float* Sst = (float*)(P.ws + WS_SST);
  const int tid = opaque((int)threadIdx.x), lane = tid & 63, w = tid >> 6, r = lane & 31, h = lane >> 5;
  const int chain = blockIdx.x >> 2, dvb = blockIdx.x & 3;
  const int b = chain >> 4, hd = (chain >> 1) & 7, dir = chain & 1;
  const int strip = w & 1;
  f32x16 S;
  if (c_lo == 0) {
#pragma unroll
    for (int i = 0; i < 16; ++i) S[i] = 0.f;
  } else {
#pragma unroll
    for (int i = 0; i < 16; ++i) S[i] = Sst[((size_t)blockIdx.x * 16 + i) * 256 + tid];
  }
  ChainRegs cur, nxt;
  chain_load(cur, Pb, Wb, Ub, Aq, Gc, chain * GDN_R, c_lo, b, hd, dir, dvb, tid, w, r, h);
  chain_load_k(cur, Pb, c_lo, b, hd, dir, tid);
  nxt = cur;
  const int tid0 = tid;
  for (int cidx = c_lo; cidx < c_hi; ++cidx) {
    const int tid = opaque(tid0), lane = tid & 63, w = tid >> 6, r = lane & 31, h = lane >> 5, strip = w & 1;
    const int slot = chain * GDN_R + (cidx - c_lo);
    __syncthreads();
#pragma unroll
    for (int q = 0; q < 4; ++q) {
      bf16x4 v;
#pragma unroll
      for (int e = 0; e < 4; ++e) v[e] = (short)f2bf(S[q * 4 + e]);
      *(bf16x4*)(sSt + r * 136 + w * 32 + 8 * q + 4 * h) = v;
    }
    if (tid < 64) {
      const float g63w = __shfl(cur.g, 63);
      sG[tid] = __expf(g63w - cur.g);
      sG[64 + tid] = 0.08838834764831845f * __expf(cur.g);
      if (tid == 63) sG[128] = __expf(cur.g);
    }
#pragma unroll
    for (int p = 0; p < 4; ++p) {
      const int e = tid + p * 256; const int row = e >> 4, kc = (e & 15) * 8;
      *(uint4*)(sKt + row * 136 + kc) = cur.kt[p];
    }
    if (cidx + 1 < c_hi) chain_load(nxt, Pb, Wb, Ub, Aq, Gc, slot + 1, cidx + 1, b, hd, dir, dvb, tid, w, r, h);
    __syncthreads();
    f32x16 acc1, acc1b;
#pragma unroll
    for (int i = 0; i < 16; ++i) { acc1[i] = 0.f; acc1b[i] = 0.f; }
#pragma unroll
    for (int ks = 0; ks < 8; ks += 2) {
      bf16x8 bfr0 = *(const bf16x8*)(sSt + r * 136 + ks * 16 + h * 8);
      bf16x8 bfr1 = *(const bf16x8*)(sSt + r * 136 + (ks + 1) * 16 + h * 8);
      acc1 = __builtin_amdgcn_mfma_f32_32x32x16_bf16(cur.a1[ks], bfr0, acc1, 0, 0, 0);
      acc1b = __builtin_amdgcn_mfma_f32_32x32x16_bf16(cur.a1[ks + 1], bfr1, acc1b, 0, 0, 0);
    }
#pragma unroll
    for (int i = 0; i < 16; ++i) acc1[i] += acc1b[i];
    if (w < 2) {
#pragma unroll
      for (int q = 0; q < 4; ++q) {
        bf16x4 vn, vd;
#pragma unroll
        for (int e = 0; e < 4; ++e) {
          const int row = strip * 32 + 8 * q + 4 * h + e;
          const float v = bf2f((bf16_t)cur.aq[(q * 4 + e) >> 3][(q * 4 + e) & 7]) - acc1[q * 4 + e];
          vn[e] = (short)f2bf(v);
          vd[e] = (short)f2bf(v * sG[row]);
        }
        *(bf16x4*)(sVn + r * 72 + strip * 32 + 8 * q + 4 * h) = vn;
        *(bf16x4*)(sVd + r * 72 + strip * 32 + 8 * q + 4 * h) = vd;
      }
    }
    __syncthreads();
    if (cidx + 1 < c_hi) chain_load_k(nxt, Pb, cidx + 1, b, hd, dir, tid);
    if (w >= 2) {
      f32x16 av;
#pragma unroll
      for (int i = 0; i < 16; ++i) av[i] = 0.f;
#pragma unroll
      for (int ks = 0; ks < 4; ++ks) {
        bf16x8 bfr = *(const bf16x8*)(sVn + r * 72 + ks * 16 + h * 8);
        av = __builtin_amdgcn_mfma_f32_32x32x16_bf16(cur.aq[ks], bfr, av, 0, 0, 0);
      }
      bf16_t* ob = Ob + (((size_t)(dir * 32 + b * 8 + hd)) * TPB + cidx * 64) * 128 + dvb * 32 + r;
#pragma unroll
      for (int i = 0; i < 16; ++i) {
        const int row = strip * 32 + crow(i, h);
        const float o = sG[64 + row] * acc1[i] + av[i];
        ob[(size_t)row * 128] = f2bf(o);
      }
    }
    {
      const float eg = sG[128];
      f32x16 d0, d1;
#pragma unroll
      for (int i = 0; i < 16; ++i) { d0[i] = 0.f; d1[i] = 0.f; }
#pragma unroll
      for (int ks = 0; ks < 4; ++ks) {
        bf16x8 af;
#pragma unroll
        for (int j = 0; j < 8; ++j) af[j] = (short)sKt[(ks * 16 + h * 8 + j) * 136 + w * 32 + r];
        bf16x8 bfr = *(const bf16x8*)(sVd + r * 72 + ks * 16 + h * 8);
        if (ks & 1) d1 = __builtin_amdgcn_mfma_f32_32x32x16_bf16(af, bfr, d1, 0, 0, 0);
        else d0 = __builtin_amdgcn_mfma_f32_32x32x16_bf16(af, bfr, d0, 0, 0, 0);
      }
#pragma unroll
      for (int i = 0; i < 16; ++i) S[i] = S[i] * eg + (d0[i] + d1[i]);
    }
    cur = nxt;
  }
  if (save) {
#pragma unroll
    for (int i = 0; i < 16; ++i) Sst[((size_t)blockIdx.x * 16 + i) * 256 + tid] = S[i];
  }
}

DI void gdn_post(const Params& P, const bf16_t* Pb, const bf16_t* __restrict__ Ob, bf16_t* Y, int ldy) {
  const int gw = blockIdx.x * 4 + (opaque((int)threadIdx.x) >> 6), nw = gridDim.x * 4;
  for (int tok = gw; tok < NT; tok += nw) {
    const int lane = opaque((int)threadIdx.x) & 63;
    const int l16 = lane & 15, hq = lane >> 4;
    const float4 ga = *(const float4*)(P.gdn_norm_g + l16 * 8), gb = *(const float4*)(P.gdn_norm_g + l16 * 8 + 4);
    const float gn[8] = {ga.x, ga.y, ga.z, ga.w, gb.x, gb.y, gb.z, gb.w};
    const int b = tok / TPB, pos = tok % TPB;
    const int sf = pos, sr = pos < CTX ? CTX - 1 - pos : (TPB + CTX - 1) - pos;
#pragma unroll
    for (int it = 0; it < 2; ++it) {
      const int hd = it * 4 + hq;
      const uint4 uf = *(const uint4*)(Ob + (((size_t)(0 * 32 + b * 8 + hd)) * TPB + sf) * 128 + l16 * 8);
      const uint4 ur = *(const uint4*)(Ob + (((size_t)(1 * 32 + b * 8 + hd)) * TPB + sr) * 128 + l16 * 8);
      const uint4 uz = *(const uint4*)(Pb + (size_t)tok * 4096 + 3072 + hd * 128 + l16 * 8);
      float o[8], z[8];
#pragma unroll
      for (int k = 0; k < 4; ++k) {
        const unsigned f = u4c(uf, k), r = u4c(ur, k), zz = u4c(uz, k);
        o[2 * k] = __uint_as_float(f << 16) + __uint_as_float(r << 16);
        o[2 * k + 1] = __uint_as_float(f & 0xffff0000u) + __uint_as_float(r & 0xffff0000u);
        z[2 * k] = __uint_as_float(zz << 16); z[2 * k + 1] = __uint_as_float(zz & 0xffff0000u);
      }
      float ss = 0.f;
#pragma unroll
      for (int e = 0; e < 8; ++e) ss += o[e] * o[e];
      ss += __shfl_xor(ss, 1); ss += __shfl_xor(ss, 2); ss += __shfl_xor(ss, 4); ss += __shfl_xor(ss, 8);
      const float rstd = rsqrtf(ss * (1.f / 128.f) + 1e-6f);
      float y[8];
#pragma unroll
      for (int e = 0; e < 8; ++e) y[e] = o[e] * rstd * gn[e] * siluf_(z[e]);
      uint4 ov;
      ov.x = pack2bf(y[0], y[1]); ov.y = pack2bf(y[2], y[3]); ov.z = pack2bf(y[4], y[5]); ov.w = pack2bf(y[6], y[7]);
      *(uint4*)(Y + (size_t)tok * ldy + hd * 128 + l16 * 8) = ov;
    }
  }
}

#ifndef DUP_MASK
#define DUP_MASK 0
#endif
#define NREP(cat) (((DUP_MASK >> (cat)) & 1) ? 2 : 1)
constexpr int PH_S5 = 6;
constexpr int PH_GDN = 5 + GDN_ROUNDS;
constexpr int PH_NA = 3;
constexpr int L0_BASE = 3;
constexpr int E1_PH = L0_BASE + PH_S5;
constexpr int L1_BASE = E1_PH + 1;
constexpr int E2_PH = L1_BASE + PH_GDN;
constexpr int L2_BASE = E2_PH + 1;
constexpr int E3_PH = L2_BASE + PH_NA;
constexpr int PB3_PH = E3_PH + 1;
constexpr int L3_BASE = PB3_PH + 1;
constexpr int E4_PH = L3_BASE + PH_S5;
constexpr int NPHASES = E4_PH + 1;

DI void s5_layer_phase(const Params& P, int j, int sub, unsigned char* smem) {
  unsigned char* big = P.ws + WS_BIG;
  bf16_t* Pb = (bf16_t*)(big);
  bf16_t* A = (bf16_t*)(big + 5 * UNIT);
  float* Sloc = (float*)(big + 2 * UNIT);
  bf16_t* Sin = (bf16_t*)(big + 4 * UNIT);
  bf16_t* Y1 = (bf16_t*)(big + 5 * UNIT);
  bf16_t* Y2 = (bf16_t*)(big + 2 * UNIT);
  float* O = (float*)(big + 3 * UNIT);
  unsigned char* wt = P.ws + WS_WT;
  switch (sub) {
    case 0: {
      for (int rep_ = 0; rep_ < NREP(6); ++rep_) s5_pre_c(P, j);
      Gemm g = gemm_plain(A, (const bf16_t*)(wt + WT_S5_IN), NT, 2048, 1024, EPI_BF16, Pb, 2048);
      for (int rep_ = 0; rep_ < NREP(0); ++rep_) gemm_phase(g, smem);
    } break;
    case 1: {
      Gemm g{};
      g.A = Pb; g.a_rs = 16 * 2048; g.a_kbs = 2048; g.a_bs = 16; g.A2 = Pb; g.a2_rs = g.a_rs; g.a2_kbs = g.a_kbs; g.a2_bs = 16; g.K1 = 256;
      g.Bt = (const bf16_t*)(wt + WT_S5_BPT); g.b_bs = 256 * 256; g.M = 1088; g.N = 256; g.K = 256; g.batch = 64; g.epi = EPI_F32;
      g.C = Sloc; g.ldc = 256; g.c_bs = 1088 * 256;
      for (int rep_ = 0; rep_ < NREP(0); ++rep_) gemm_phase(g, smem);
    } break;
    case 2: for (int rep_ = 0; rep_ < NREP(3); ++rep_) s5_carry(P, Sloc, Sin); break;
    case 3: {
      Gemm g{};
      g.A = Pb; g.a_rs = 16 * 2048; g.a_kbs = 2048; g.a_bs = 16; g.K1 = 256;
      g.A2 = Sin; g.a2_rs = 256; g.a2_kbs = 16; g.a2_bs = 1088 * 256;
      g.Bt = (const bf16_t*)(wt + WT_S5_OPT); g.b_bs = 256 * 512; g.M = 1088; g.N = 256; g.K = 512; g.batch = 64; g.epi = EPI_S5Y;
      g.C = Y1;
      for (int rep_ = 0; rep_ < NREP(0); ++rep_) gemm_phase(g, smem);
    } break;
    case 4: {
      Gemm g = gemm_plain(Y1, (const bf16_t*)(wt + WT_S5_GLU), NT, 2048, 1024, EPI_GLU, Y2, 1024);
      g.zsrc = Pb; g.bias = P.s5_glu_b + j * 2048;
      for (int rep_ = 0; rep_ < NREP(0); ++rep_) gemm_phase(g, smem);
    } break;
    case 5: {
      Gemm g = gemm_plain(Y2, (const bf16_t*)(wt + WT_S5_OUT), NT, 1024, 1024, EPI_F32, O, 1024);
      for (int rep_ = 0; rep_ < NREP(0); ++rep_) gemm_phase(g, smem);
    } break;
    default: break;
  }
}
DI void s5_convert(const Params& P, int j, float* lds) {
  unsigned char* wt = P.ws + WS_WT;
  convert_wt(P.s5_in_w + (size_t)j * 1024 * 2048, 1024, 2048, 2048, (bf16_t*)(wt + WT_S5_IN), 0, lds);
  convert_wt(P.s5_glu_w + (size_t)j * 1024 * 2048, 1024, 2048, 2048, (bf16_t*)(wt + WT_S5_GLU), 1, lds);
  convert_wt(P.s5_out_w + (size_t)j * 1024 * 1024, 1024, 1024, 1024, (bf16_t*)(wt + WT_S5_OUT), 0, lds);
}

DI void run_phase(const Params& P, int ph, unsigned char* smem) {
  unsigned char* big = P.ws + WS_BIG;
  unsigned char* wt = P.ws + WS_WT;
  float* lds = (float*)smem;
  if (ph == 0) { for (int rep_ = 0; rep_ < NREP(6); ++rep_) { adaln_phase(P, lds); s5_convert(P, 0, lds); s5_pre_a(P, 0); } return; }
  if (ph == 1) { for (int rep_ = 0; rep_ < NREP(6); ++rep_) { adaln_reduce(P); s5_pre_b(P, 0); } return; }
  if (ph == 2) { ew_phase(P, -1, 0, nullptr, (bf16_t*)(big + 5 * UNIT)); return; }
  if (ph >= L0_BASE && ph < E1_PH) { s5_layer_phase(P, 0, ph - L0_BASE, smem); return; }
  if (ph == E1_PH) {
    ew_phase(P, 0, 1, (const float*)(big + 3 * UNIT), (bf16_t*)(big + 5 * UNIT));
    for (int rep_ = 0; rep_ < NREP(6); ++rep_) {
    convert_wt(P.gdn_in_w, 1024, 4128, 4224, (bf16_t*)(wt + WT_G_IN), 0, lds);
    convert_wt(P.gdn_out_w, 1024, 1024, 1024, (bf16_t*)(wt + WT_G_OUT), 0, lds); }
    return;
  }
  if (ph >= L1_BASE && ph < E2_PH) {
    const int sub = ph - L1_BASE;
    bf16_t* Pb = (bf16_t*)big;
    bf16_t* A = (bf16_t*)(big + 5 * UNIT);
    bf16_t* Ob = (bf16_t*)(big + 4 * UNIT);
    float* AB = (float*)(P.ws + WS_AB);
    bf16_t* Hb = (bf16_t*)(wt + WT_G_HALO);
    if (sub == 0) {
      Gemm g = gemm_plain(A, (const bf16_t*)(wt + WT_G_IN), NT, 4224, 1024, EPI_GDNIN, Pb, 4096);
      g.C2 = AB; g.C3 = Hb;
      for (int rep_ = 0; rep_ < NREP(0); ++rep_) gemm_phase(g, smem);
    } else if (sub == 1) {
      gdn_conv(P, Pb, Hb);
    } else if (sub < 3 + GDN_ROUNDS) {
      unsigned* ctr = (unsigned*)(P.ws + WS_BAR) + XCD_BAR_WORDS;
      const int rd = sub - 3;
      if (rd >= 0) { const int c_lo = rd * GDN_R, c_hi = imin(GDN_NCH, c_lo + GDN_R); gdn_chain(P, Pb, Ob, c_lo, c_hi, rd & 1, smem); }
      const int pr = rd + 1;
      if (pr < GDN_ROUNDS) { const int c_lo = pr * GDN_R, c_hi = imin(GDN_NCH, c_lo + GDN_R); gdn_prep(P, Pb, AB, Ob, c_lo, c_hi, pr & 1, ctr + pr * 16, smem); }
    } else if (sub == 3 + GDN_ROUNDS) {
      for (int rep_ = 0; rep_ < NREP(6); ++rep_) gdn_post(P, Pb, Ob, Pb, 4096);
    } else {
      Gemm g = gemm_plain(Pb, (const bf16_t*)(wt + WT_G_OUT), NT, 1024, 1024, EPI_F32, (float*)(big + 4 * UNIT), 1024);
      g.a_rs = 4096; g.a2_rs = 4096;
      for (int rep_ = 0; rep_ < NREP(0); ++rep_) gemm_phase(g, smem);
    }
    return;
  }
  if (ph == E2_PH) {
    ew_phase(P, 1, 2, (const float*)(big + 4 * UNIT), (bf16_t*)(big));
    for (int rep_ = 0; rep_ < NREP(6); ++rep_) {
    convert_wt(P.na_in_w, 1024, 4096, 4096, (bf16_t*)(wt + WT_N_IN), 0, lds);
    convert_wt(P.na_out_w, 1024, 1024, 1024, (bf16_t*)(wt + WT_N_OUT), 0, lds); }
    return;
  }
  if (ph >= L2_BASE && ph < E3_PH) {
    const int sub = ph - L2_BASE;
    bf16_t* A = (bf16_t*)big;
    bf16_t* Pb = (bf16_t*)(big + 1 * UNIT);
    bf16_t* Vt = (bf16_t*)(big + 5 * UNIT);
    bf16_t* Y1 = (bf16_t*)big;
    float* O = (float*)(big + 1 * UNIT);
    if (sub == 0) {
      Gemm g = gemm_plain(A, (const bf16_t*)(wt + WT_N_IN), NT, 4096, 1024, EPI_NAIN, Pb, 4096);
      g.C2 = Vt;
      for (int rep_ = 0; rep_ < NREP(0); ++rep_) gemm_phase(g, smem);
    } else if (sub == 1) {
      for (int rep_ = 0; rep_ < NREP(1); ++rep_) na_attn(P, Pb, Vt, Y1, smem);
    } else {
      Gemm g = gemm_plain(Y1, (const bf16_t*)(wt + WT_N_OUT), NT, 1024, 1024, EPI_F32, O, 1024);
      for (int rep_ = 0; rep_ < NREP(0); ++rep_) gemm_phase(g, smem);
    }
    return;
  }
  if (ph == E3_PH) {
    ew_phase(P, 2, 3, (const float*)(big + 1 * UNIT), (bf16_t*)(big + 5 * UNIT));
    for (int rep_ = 0; rep_ < NREP(6); ++rep_) { s5_convert(P, 1, lds); s5_pre_a(P, 1); }
    return;
  }
  if (ph == PB3_PH) { for (int rep_ = 0; rep_ < NREP(6); ++rep_) s5_pre_b(P, 1); return; }
  if (ph >= L3_BASE && ph < E4_PH) { s5_layer_phase(P, 1, ph - L3_BASE, smem); return; }
  if (ph == E4_PH) { ew_phase(P, 3, -1, (const float*)(big + 3 * UNIT), nullptr); return; }
}

#ifndef NO_MEGA
__global__ void __launch_bounds__(NTHREADS, 2) mega(Params P) {
  extern __shared__ __attribute__((aligned(16))) unsigned char smem[];
  __shared__ uint4 xb_words;
  cg::grid_group grid = cg::this_grid();
  if (threadIdx.x == 0) xb_words = make_uint4(0u, 0u, 0u, 0u);
  __syncthreads();
  XcdBarrier xb = xcd_barrier_post((unsigned*)(P.ws + WS_BAR), (volatile LAS unsigned*)&xb_words);
  if (P.ph_lo < 0) grid.sync();
  for (int ph = P.ph_lo; ph < P.ph_hi; ++ph) {
    run_phase(P, ph, smem);
    if (ph + 1 < P.ph_hi) { xcd_barrier(xb); if (DUP_MASK & 32) xcd_barrier(xb); }
  }
}

#ifndef MULTI_LAUNCH
#define MULTI_LAUNCH 0
#endif

extern "C" void kernel_launch(void* const* d_in, const int* in_sizes, int n_in, void* d_out, int out_size, void* d_ws, size_t ws_size, hipStream_t stream) {
  static int grid_blocks = 0;
  if (!grid_blocks) {
    int dev = 0, cus = 0, per_cu = 0;
    hipGetDevice(&dev);
    hipDeviceGetAttribute(&cus, hipDeviceAttributeMultiprocessorCount, dev);
    hipFuncSetAttribute((const void*)mega, hipFuncAttributeMaxDynamicSharedMemorySize, GEMM_LDS_BYTES);
    hipOccupancyMaxActiveBlocksPerMultiprocessor(&per_cu, (const void*)mega, NTHREADS, GEMM_LDS_BYTES);
    if (per_cu > 2) per_cu = 2;
    if (per_cu < 1) per_cu = 1;
    grid_blocks = cus * per_cu;
    if (ws_size < WS_END) fprintf(stderr, "kernel_launch: workspace too small: %zu < %zu\n", ws_size, (size_t)WS_END);
  }
  Params p{};
  const float** f = (const float**)&p;
  for (int i = 0; i < 29; ++i) f[i] = (const float*)d_in[i];
  p.out = (float*)d_out; p.ws = (unsigned char*)d_ws;
#if MULTI_LAUNCH
  for (int ph = 0; ph < NPHASES; ++ph) {
    p.ph_lo = ph; p.ph_hi = ph + 1;
    hipLaunchKernelGGL(mega, dim3(grid_blocks), dim3(NTHREADS), GEMM_LDS_BYTES, stream, p);
  }
#else
  p.ph_lo = 0; p.ph_hi = NPHASES;
  hipMemsetAsync((unsigned char*)d_ws + WS_BAR, 0, 16384, stream);
  void* args[] = {&p};
  hipError_t e = hipLaunchCooperativeKernel((const void*)mega, dim3(grid_blocks), dim3(NTHREADS), args, GEMM_LDS_BYTES, stream);
  if (e != hipSuccess) fprintf(stderr, "cooperative launch failed: %s (grid %d)\n", hipGetErrorString(e), grid_blocks);
#endif
}
#endif
```
